# Optimizing an MI355X kernel written in HIP

```python
import math
import jax, jax.numpy as jnp
from jax import lax
import numpy as np

D_MODEL = 1024
BATCH = 16
SEQ = 2048
DEPTH = 2

LRU_WIDTH = D_MODEL
LRU_BLOCKS = 8
LRU_BLOCK = LRU_WIDTH // LRU_BLOCKS
CONV_WIDTH = 4
LRU_C = 8.0
HEAD_DIM = 64
N_Q_HEADS = D_MODEL // HEAD_DIM
N_KV_HEADS = 2
GQA_GROUP = N_Q_HEADS // N_KV_HEADS
ATTN_WIDTH = N_Q_HEADS * HEAD_DIM
KV_WIDTH = N_KV_HEADS * HEAD_DIM
WINDOW = 128
REL_BUCKETS = 32
REL_MAX_DIST = 128
CHUNK = 128
GMLP_WIDTH = 2 * D_MODEL
GMLP_GROUPS = 8
GMLP_GROUP_DIM = GMLP_WIDTH // GMLP_GROUPS

EPS = 1e-6
N_EVEN = (DEPTH + 1) // 2
N_ODD = DEPTH // 2

IN_A_SPLITS = (LRU_WIDTH, LRU_WIDTH, ATTN_WIDTH, KV_WIDTH, KV_WIDTH, ATTN_WIDTH)
IN_A_WIDTH = sum(IN_A_SPLITS)
OUT_A_WIDTH = LRU_WIDTH + ATTN_WIDTH
IN_C_WIDTH = 3 * GMLP_WIDTH

kernel_name = "hybrid_rglru_swa_sink_chunked_gmlp"


def rms_norm(x, g):
    xf = x.astype(jnp.float32)
    y = xf * lax.rsqrt(jnp.mean(xf * xf, axis=-1, keepdims=True) + EPS)
    return (y * g.astype(jnp.float32)).astype(x.dtype)


def layer_norm(x, g, b):
    xf = x.astype(jnp.float32)
    mu = jnp.mean(xf, axis=-1, keepdims=True)
    xc = xf - mu
    y = xc * lax.rsqrt(jnp.mean(xc * xc, axis=-1, keepdims=True) + EPS)
    return (y * g.astype(jnp.float32) + b.astype(jnp.float32)).astype(x.dtype)


def split_cols(z, sizes):
    idx = list(np.cumsum(sizes)[:-1])
    return jnp.split(z, idx, axis=-1)


def causal_depthwise_conv(x, w, b):
    c = x.shape[-1]
    y = lax.conv_general_dilated(
        x, w[:, None, :].astype(x.dtype), window_strides=(1,),
        padding=[(CONV_WIDTH - 1, 0)],
        dimension_numbers=("NWC", "WIO", "NWC"), feature_group_count=c)
    return y + b


def block_diag_linear(x, w, b):
    bsz, s, _ = x.shape
    xb = x.reshape(bsz, s, LRU_BLOCKS, LRU_BLOCK)
    y = jnp.einsum("bsnk,nkj->bsnj", xb, w)
    return y.reshape(bsz, s, LRU_WIDTH) + b


def rg_lru(x, gate_a_w, gate_a_b, gate_x_w, gate_x_b, lam):
    r = jax.nn.sigmoid(block_diag_linear(x, gate_a_w, gate_a_b).astype(jnp.float32))
    i = jax.nn.sigmoid(block_diag_linear(x, gate_x_w, gate_x_b).astype(jnp.float32))
    log_a = -LRU_C * r * jax.nn.softplus(-lam.astype(jnp.float32))
    a = jnp.exp(log_a)
    mult = jnp.sqrt(-jnp.expm1(2.0 * log_a))
    bterm = mult * i * x.astype(jnp.float32)

    def combine(e1, e2):
        a1, b1 = e1
        a2, b2 = e2
        return a1 * a2, a2 * b1 + b2

    _, h = lax.associative_scan(combine, (a, bterm), axis=1)
    return h.astype(x.dtype)


def t5_causal_bucket(dist):
    max_exact = REL_BUCKETS // 2
    is_small = dist < max_exact
    df = jnp.maximum(dist, 1).astype(jnp.float32)
    large = max_exact + (jnp.log(df / max_exact) / math.log(REL_MAX_DIST / max_exact)
                         * (REL_BUCKETS - max_exact)).astype(jnp.int32)
    large = jnp.minimum(large, REL_BUCKETS - 1)
    return jnp.where(is_small, dist, large)


def sliding_window_gqa(q, k, v, q_g, k_g, sinks, rel_bias):
    bsz, s, _, _ = q.shape
    nblk = s // WINDOW
    q = rms_norm(q, q_g)
    k = rms_norm(k, k_g)
    scale = HEAD_DIM ** -0.5
    qb = q.reshape(bsz, nblk, WINDOW, N_KV_HEADS, GQA_GROUP, HEAD_DIM)
    kb = k.reshape(bsz, nblk, WINDOW, N_KV_HEADS, HEAD_DIM)
    vb = v.reshape(bsz, nblk, WINDOW, N_KV_HEADS, HEAD_DIM)
    shift = lambda t: jnp.concatenate([jnp.zeros_like(t[:, :1]), t[:, :-1]], axis=1)
    kw = jnp.concatenate([shift(kb), kb], axis=2)
    vw = jnp.concatenate([shift(vb), vb], axis=2)

    qi = jnp.arange(WINDOW)[:, None]
    kj = jnp.arange(2 * WINDOW)[None, :]
    dist = WINDOW + qi - kj
    in_window = (dist >= 0) & (dist < WINDOW)
    bucket = t5_causal_bucket(jnp.maximum(dist, 0))
    bias = rel_bias.astype(jnp.float32)[bucket]
    bias = jnp.transpose(bias, (2, 0, 1)).reshape(N_KV_HEADS, GQA_GROUP, WINDOW, 2 * WINDOW)
    sink = sinks.astype(jnp.float32).reshape(N_KV_HEADS, GQA_GROUP)[None, :, :, None, None]

    def one_block(args):
        qblk, kblk, vblk, blk = args
        sc = jnp.einsum("bqkgd,bskd->bkgqs", qblk, kblk).astype(jnp.float32) * scale + bias
        key_ok = (blk * WINDOW - WINDOW + jnp.arange(2 * WINDOW)) >= 0
        mask = in_window & key_ok[None, :]
        sc = jnp.where(mask, sc, -jnp.inf)
        m = jnp.maximum(jnp.max(sc, axis=-1, keepdims=True), sink)
        p = jnp.exp(sc - m)
        denom = jnp.sum(p, axis=-1, keepdims=True) + jnp.exp(sink - m)
        out = jnp.einsum("bkgqs,bskd->bqkgd", (p / denom).astype(vblk.dtype), vblk)
        return out.reshape(bsz, WINDOW, ATTN_WIDTH)

    xs = (jnp.moveaxis(qb, 1, 0), jnp.moveaxis(kw, 1, 0), jnp.moveaxis(vw, 1, 0),
          jnp.arange(nblk))
    out = lax.map(one_block, xs)
    return jnp.moveaxis(out, 0, 1).reshape(bsz, s, ATTN_WIDTH)


def chunked_spatial_gating(v, w_s, b_s):
    bsz, s, _ = v.shape
    nch = s // CHUNK
    vc = v.reshape(bsz, nch, CHUNK, GMLP_GROUPS, GMLP_GROUP_DIM)
    causal = jnp.tril(jnp.ones((CHUNK, CHUNK), dtype=w_s.dtype))
    y = jnp.einsum("gts,bcsgd->bctgd", w_s * causal, vc)
    y = y + jnp.transpose(b_s)[None, None, :, :, None]
    return y.reshape(bsz, s, GMLP_WIDTH)


def setup_inputs(seed: int = 0) -> dict:
    key = jax.random.key(seed)
    ks = jax.random.split(key, 26)
    nrm = lambda k, shape, scale: jax.random.normal(k, shape, jnp.float32) * scale
    x = nrm(ks[0], (BATCH, SEQ, D_MODEL), 1.0)
    norm_a = 1.0 + nrm(ks[1], (N_EVEN, D_MODEL), 0.02)
    w_in_a = nrm(ks[2], (N_EVEN, D_MODEL, IN_A_WIDTH), D_MODEL ** -0.5)
    conv_w = nrm(ks[3], (N_EVEN, CONV_WIDTH, LRU_WIDTH), CONV_WIDTH ** -0.5)
    conv_b = nrm(ks[4], (N_EVEN, LRU_WIDTH), 0.02)
    gate_a_w = nrm(ks[5], (N_EVEN, LRU_BLOCKS, LRU_BLOCK, LRU_BLOCK), LRU_BLOCK ** -0.5)
    gate_a_b = nrm(ks[6], (N_EVEN, LRU_WIDTH), 0.02)
    gate_x_w = nrm(ks[7], (N_EVEN, LRU_BLOCKS, LRU_BLOCK, LRU_BLOCK), LRU_BLOCK ** -0.5)
    gate_x_b = nrm(ks[8], (N_EVEN, LRU_WIDTH), 0.02)
    u = jax.random.uniform(ks[9], (N_EVEN, LRU_WIDTH), jnp.float32, 0.9, 0.999)
    a0 = u ** (1.0 / LRU_C)
    lru_lambda = jnp.log(a0) - jnp.log1p(-a0)
    q_norm_g = 1.0 + nrm(ks[10], (N_EVEN, HEAD_DIM), 0.02)
    k_norm_g = 1.0 + nrm(ks[11], (N_EVEN, HEAD_DIM), 0.02)
    sinks = nrm(ks[12], (N_EVEN, N_Q_HEADS), 0.5)
    w_out_a = nrm(ks[13], (N_EVEN, OUT_A_WIDTH, D_MODEL), OUT_A_WIDTH ** -0.5)
    rel_bias = nrm(ks[14], (REL_BUCKETS, N_Q_HEADS), 0.5)
    norm_c = 1.0 + nrm(ks[15], (N_ODD, D_MODEL), 0.02)
    w_in_c = nrm(ks[16], (N_ODD, D_MODEL, IN_C_WIDTH), D_MODEL ** -0.5)
    ln_v_g = 1.0 + nrm(ks[17], (N_ODD, GMLP_WIDTH), 0.02)
    ln_v_b = nrm(ks[18], (N_ODD, GMLP_WIDTH), 0.02)
    spatial_w = nrm(ks[19], (N_ODD, GMLP_GROUPS, CHUNK, CHUNK), CHUNK ** -0.5)
    spatial_b = 1.0 + nrm(ks[20], (N_ODD, GMLP_GROUPS, CHUNK), 0.02)
    w_out_c = nrm(ks[21], (N_ODD, GMLP_WIDTH, D_MODEL), GMLP_WIDTH ** -0.5)
    return {"x": x, "norm_a": norm_a, "w_in_a": w_in_a, "conv_w": conv_w,
            "conv_b": conv_b, "gate_a_w": gate_a_w, "gate_a_b": gate_a_b,
            "gate_x_w": gate_x_w, "gate_x_b": gate_x_b, "lru_lambda": lru_lambda,
            "q_norm_g": q_norm_g, "k_norm_g": k_norm_g, "sinks": sinks,
            "w_out_a": w_out_a, "rel_bias": rel_bias, "norm_c": norm_c,
            "w_in_c": w_in_c, "ln_v_g": ln_v_g, "ln_v_b": ln_v_b,
            "spatial_w": spatial_w, "spatial_b": spatial_b, "w_out_c": w_out_c}


def reference(x, norm_a, w_in_a, conv_w, conv_b, gate_a_w, gate_a_b, gate_x_w,
              gate_x_b, lru_lambda, q_norm_g, k_norm_g, sinks, w_out_a, rel_bias,
              norm_c, w_in_c, ln_v_g, ln_v_b, spatial_w, spatial_b, w_out_c):
    bsz, s, _ = x.shape
    for layer in range(DEPTH):
        j = layer // 2
        if layer % 2 == 0:
            h = rms_norm(x, norm_a[j])
            z = h @ w_in_a[j]
            za, ga, zq, zk, zv, gb = split_cols(z, IN_A_SPLITS)
            xa = causal_depthwise_conv(za, conv_w[j], conv_b[j])
            ya = rg_lru(xa, gate_a_w[j], gate_a_b[j], gate_x_w[j], gate_x_b[j], lru_lambda[j])
            q = zq.reshape(bsz, s, N_Q_HEADS, HEAD_DIM)
            k = zk.reshape(bsz, s, N_KV_HEADS, HEAD_DIM)
            v = zv.reshape(bsz, s, N_KV_HEADS, HEAD_DIM)
            yb = sliding_window_gqa(q, k, v, q_norm_g[j], k_norm_g[j], sinks[j], rel_bias)
            y = jnp.concatenate([ya * jax.nn.silu(ga), yb * jax.nn.silu(gb)], axis=-1)
            x = x + y @ w_out_a[j]
        else:
            h = rms_norm(x, norm_c[j])
            z = h @ w_in_c[j]
            u, v, g = split_cols(z, (GMLP_WIDTH, GMLP_WIDTH, GMLP_WIDTH))
            v = layer_norm(v, ln_v_g[j], ln_v_b[j])
            sg = chunked_spatial_gating(v, spatial_w[j], spatial_b[j])
            y = u * sg * jax.nn.silu(g)
            x = x + y @ w_out_c[j]
    return x
```

```cpp
#include <hip/hip_runtime.h>
#include <cstdint>
#include <cstdio>

typedef unsigned short bf16;
constexpr int D = 1024, NB = 16, S = 2048, M = NB * S;
constexpr int NA = 4352, NC = 6144, GW = 2048;
constexpr float EPS = 1e-6f;
constexpr size_t MiB = 1u << 20;
constexpr size_t WS_CTL = 0;
constexpr size_t WS_BIAS = 1 * MiB;
constexpr size_t WS_WAT = 2 * MiB;
constexpr size_t WS_WOAT = 11 * MiB;
constexpr size_t WS_WCT = 15 * MiB;
constexpr size_t WS_WOCT = 27 * MiB;
constexpr size_t WS_WG = 31 * MiB;
constexpr size_t WS_SSQ = 32 * MiB;
constexpr size_t WS_VST = 34 * MiB;
constexpr size_t WS_Z0 = 48 * MiB;
constexpr size_t WS_Y0 = 320 * MiB;
constexpr size_t WS_X1B = 448 * MiB;
constexpr size_t WS_U = 48 * MiB, WS_V = 176 * MiB, WS_G = 304 * MiB;
constexpr size_t WS_END = 512 * MiB;

__device__ __forceinline__ unsigned f2bf(float f) { unsigned u = __builtin_bit_cast(unsigned, f); return (u + 0x7fffu + ((u >> 16) & 1u)) >> 16; }
__device__ __forceinline__ float bf2f(unsigned h) { return __builtin_bit_cast(float, h << 16); }
__device__ __forceinline__ float bfr(float f) { return bf2f(f2bf(f)); }
__device__ __forceinline__ float sigmoidf_(float x) { return 1.f / (1.f + __expf(-x)); }
__device__ __forceinline__ float siluf_(float x) { return x / (1.f + __expf(-x)); }

__global__ void k_transpose(const float* __restrict__ W, const float* __restrict__ scale, bf16* __restrict__ Wt, int K, int N) {
    __shared__ float t[32][33];
    const int k0 = blockIdx.y * 32, n0 = blockIdx.x * 32, tx = threadIdx.x & 31, ty = threadIdx.x >> 5;
    for (int i = ty; i < 32; i += 8) t[i][tx] = W[(size_t)(k0 + i) * N + n0 + tx] * (scale ? scale[k0 + i] : 1.f);
    __syncthreads();
    for (int i = ty; i < 32; i += 8) Wt[(size_t)(n0 + i) * K + k0 + tx] = (bf16)f2bf(t[tx][i]);
}
__global__ void k_gatew(const float* __restrict__ wa, const float* __restrict__ wx, bf16* __restrict__ WG) {
    const int idx = blockIdx.x * 256 + threadIdx.x;
    const int k = idx & 127, c = (idx >> 7) & 127, g = (idx >> 14) & 1, n = idx >> 15;
    const float* w = g ? wx : wa;
    WG[idx] = (bf16)f2bf(w[(size_t)n * 16384 + k * 128 + c]);
}
__global__ void k_biastab(const float* __restrict__ rel_bias, float* __restrict__ tab) {
    const int idx = blockIdx.x * 256 + threadIdx.x;
    const int d = idx & 127, h = idx >> 7;
    int bk;
    if (d < 16) bk = d; else { bk = 16 + (int)(logf((float)d / 16.f) / logf(8.f) * 16.f); if (bk > 31) bk = 31; }
    tab[idx] = rel_bias[bk * 16 + h];
}
__global__ void k_rms_h0(const float* __restrict__ x, const float* __restrict__ g, bf16* __restrict__ h0) {
    const int row = blockIdx.x * 4 + (threadIdx.x >> 6), lane = threadIdx.x & 63;
    const float* xr = x + (size_t)row * D;
    float v[16], s = 0.f;
#pragma unroll
    for (int j = 0; j < 16; ++j) { v[j] = xr[lane + 64 * j]; s += v[j] * v[j]; }
#pragma unroll
    for (int o = 1; o < 64; o <<= 1) s += __shfl_xor(s, o);
    const float rstd = rsqrtf(s / D + EPS);
#pragma unroll
    for (int j = 0; j < 16; ++j) h0[(size_t)row * D + lane + 64 * j] = (bf16)f2bf(v[j] * rstd * g[lane + 64 * j]);
}
__global__ void k_ssq(const float* __restrict__ x1, float* __restrict__ ssq) {
    const int row = blockIdx.x * 4 + (threadIdx.x >> 6), lane = threadIdx.x & 63;
    const float* xr = x1 + (size_t)row * D;
    float s = 0.f;
#pragma unroll
    for (int j = 0; j < 16; ++j) { const float v = xr[lane + 64 * j]; s += v * v; }
#pragma unroll
    for (int o = 1; o < 64; o <<= 1) s += __shfl_xor(s, o);
    if (lane < 16) ssq[(size_t)row * 16 + lane] = lane == 0 ? s : 0.f;
}
__global__ void k_vstats(const bf16* __restrict__ V, float* __restrict__ vst) {
    const int row = blockIdx.x * 4 + (threadIdx.x >> 6), lane = threadIdx.x & 63;
    const bf16* vr = V + (size_t)row * GW;
    float s = 0.f, q = 0.f;
#pragma unroll
    for (int j = 0; j < 32; ++j) { const float v = bf2f(vr[lane + 64 * j]); s += v; q += v * v; }
#pragma unroll
    for (int o = 1; o < 64; o <<= 1) { s += __shfl_xor(s, o); q += __shfl_xor(q, o); }
    const float mean = s / GW, var = q / GW - mean * mean;
    if (lane == 0) { vst[row * 2] = mean; vst[row * 2 + 1] = rsqrtf(var + EPS); }
}

struct GemmArgs {
    const bf16* A; int lda; const bf16* Bt; int N, K;
    bf16* C0; int ldc;
    const float* resid; float* out; bf16* x1b;
    const float* ssq; bf16* U; bf16* V; bf16* G;
};
template <int MODE> __global__ void __launch_bounds__(256) k_gemm(GemmArgs g) {
    __shared__ float As[32][65], Bs[32][65];
    const int tid = threadIdx.x, tx = tid & 15, ty = tid >> 4;
    const int m0 = blockIdx.y * 64, n0 = blockIdx.x * 64;
    float acc[4][4];
#pragma unroll
    for (int i = 0; i < 4; ++i)
#pragma unroll
        for (int j = 0; j < 4; ++j) acc[i][j] = 0.f;
    for (int k0 = 0; k0 < g.K; k0 += 32) {
        for (int i = tid; i < 64 * 32; i += 256) { const int r = i >> 5, c = i & 31;
            As[c][r] = bf2f(g.A[(size_t)(m0 + r) * g.lda + k0 + c]); Bs[c][r] = bf2f(g.Bt[(size_t)(n0 + r) * g.K + k0 + c]); }
        __syncthreads();
#pragma unroll 8
        for (int kk = 0; kk < 32; ++kk) {
            float a[4], b[4];
#pragma unroll
            for (int i = 0; i < 4; ++i) { a[i] = As[kk][ty * 4 + i]; b[i] = Bs[kk][tx * 4 + i]; }
#pragma unroll
            for (int i = 0; i < 4; ++i)
#pragma unroll
                for (int j = 0; j < 4; ++j) acc[i][j] += a[i] * b[j];
        }
        __syncthreads();
    }
#pragma unroll
    for (int i = 0; i < 4; ++i) {
        const int row = m0 + ty * 4 + i;
        float rstd = 1.f;
        if (MODE == 2) { float s = 0.f; for (int j = 0; j < 16; ++j) s += g.ssq[(size_t)row * 16 + j]; rstd = rsqrtf(s / D + EPS); }
#pragma unroll
        for (int j = 0; j < 4; ++j) {
            const int col = n0 + tx * 4 + j; const float v = acc[i][j];
            if (MODE == 0) g.C0[(size_t)row * g.ldc + col] = (bf16)f2bf(v);
            if (MODE == 1) { const float x1 = g.resid[(size_t)row * D + col] + v; g.out[(size_t)row * D + col] = x1; g.x1b[(size_t)row * D + col] = (bf16)f2bf(x1); }
            if (MODE == 2) { bf16* dst = col < GW ? g.U : (col < 2 * GW ? g.V : g.G); dst[(size_t)row * GW + (col % GW)] = (bf16)f2bf(v * rstd); }
            if (MODE == 3) g.out[(size_t)row * D + col] += v;
        }
    }
}

__global__ void __launch_bounds__(128) k_lru(const bf16* __restrict__ z0, const float* __restrict__ conv_w, const float* __restrict__ conv_b, const bf16* __restrict__ WG,
                                             const float* __restrict__ ba, const float* __restrict__ bx, const float* __restrict__ lam, bf16* __restrict__ y0) {
    __shared__ float xs[128];
    const int b = blockIdx.x >> 3, n = blockIdx.x & 7, c = threadIdx.x, ch = n * 128 + c;
    const float w0 = conv_w[ch], w1 = conv_w[1024 + ch], w2 = conv_w[2048 + ch], w3 = conv_w[3072 + ch], cb = conv_b[ch];
    const float bac = ba[ch], bxc = bx[ch];
    const float sp = log1pf(expf(-lam[ch]));
    const bf16* wa = WG + ((size_t)(n * 2 + 0) * 128 + c) * 128;
    const bf16* wx = WG + ((size_t)(n * 2 + 1) * 128 + c) * 128;
    float z1 = 0.f, z2 = 0.f, z3 = 0.f, h = 0.f;
    for (int t = 0; t < S; ++t) {
        const size_t row = (size_t)b * S + t;
        const float zt = bf2f(z0[row * NA + ch]);
        const float xa = w0 * z3 + w1 * z2 + w2 * z1 + w3 * zt + cb;
        z3 = z2; z2 = z1; z1 = zt;
        __syncthreads();
        xs[c] = bfr(xa);
        __syncthreads();
        float ra = 0.f, rx = 0.f;
        for (int k = 0; k < 128; ++k) { const float xv = xs[k]; ra += xv * bf2f(wa[k]); rx += xv * bf2f(wx[k]); }
        const float r = sigmoidf_(ra + bac), ig = sigmoidf_(rx + bxc);
        const float log_a = -8.f * r * sp;
        const float a = expf(log_a), mult = sqrtf(-expm1f(2.f * log_a));
        h = a * h + mult * ig * xa;
        const float ga = bf2f(z0[row * NA + 1024 + ch]);
        y0[row * GW + ch] = (bf16)f2bf(h * siluf_(ga));
    }
}

__global__ void __launch_bounds__(64) k_attn(const bf16* __restrict__ z0, const float* __restrict__ qg, const float* __restrict__ kg, const float* __restrict__ sinks,
                                             const float* __restrict__ btab, bf16* __restrict__ y0) {
    const int idx = blockIdx.x * 64 + threadIdx.x;
    const int hq = idx & 15, row = idx >> 4, t = row & (S - 1), kh = hq >> 3;
    const bf16* qp = z0 + (size_t)row * NA + 2048 + hq * 64;
    float q[64], ss = 0.f;
#pragma unroll
    for (int d = 0; d < 64; ++d) { q[d] = bf2f(qp[d]); ss += q[d] * q[d]; }
    const float rq = rsqrtf(ss / 64.f + EPS);
#pragma unroll
    for (int d = 0; d < 64; ++d) q[d] = bfr(q[d] * rq * qg[d]);
    float acc[64];
#pragma unroll
    for (int d = 0; d < 64; ++d) acc[d] = 0.f;
    float m = sinks[hq], l = 1.f;
    const int j0 = t - 127 < 0 ? 0 : t - 127;
    for (int j = j0; j <= t; ++j) {
        const size_t krow = (size_t)(row - t + j);
        const bf16* kp = z0 + krow * NA + 3072 + kh * 64;
        const bf16* vp = z0 + krow * NA + 3200 + kh * 64;
        float ks = 0.f;
#pragma unroll
        for (int d = 0; d < 64; ++d) { const float kv = bf2f(kp[d]); ks += kv * kv; }
        const float rk = rsqrtf(ks / 64.f + EPS);
        float dp = 0.f;
#pragma unroll
        for (int d = 0; d < 64; ++d) dp += q[d] * bfr(bf2f(kp[d]) * rk * kg[d]);
        const float sc = dp * 0.125f + btab[hq * 128 + (t - j)];
        const float mn = fmaxf(m, sc), f = __expf(m - mn), p = __expf(sc - mn);
        l = l * f + p; m = mn;
#pragma unroll
        for (int d = 0; d < 64; ++d) acc[d] = acc[d] * f + p * bf2f(vp[d]);
    }
    const float il = 1.f / l;
    const bf16* gp = z0 + (size_t)row * NA + 3328 + hq * 64;
    bf16* op = y0 + (size_t)row * GW + 1024 + hq * 64;
#pragma unroll
    for (int d = 0; d < 64; ++d) op[d] = (bf16)f2bf(acc[d] * il * siluf_(bf2f(gp[d])));
}

__global__ void __launch_bounds__(256) k_gate(bf16* __restrict__ U, const bf16* __restrict__ V, const bf16* __restrict__ G, const float* __restrict__ vst,
                                              const float* __restrict__ lg, const float* __restrict__ lb, const float* __restrict__ sw, const float* __restrict__ sb) {
    const int row = blockIdx.y, c = blockIdx.x * 256 + threadIdx.x, grp = c >> 8, tt = row & 127, r0 = row - tt;
    const float gam = lg[c], bet = lb[c];
    const float* w = sw + ((size_t)grp * 128 + tt) * 128;
    float acc = 0.f;
    for (int s = 0; s <= tt; ++s) {
        const float v = bf2f(V[(size_t)(r0 + s) * GW + c]);
        const float ln = (v - vst[(r0 + s) * 2]) * vst[(r0 + s) * 2 + 1] * gam + bet;
        acc += w[s] * ln;
    }
    const float sg = acc + sb[grp * 128 + tt];
    const size_t o = (size_t)row * GW + c;
    U[o] = (bf16)f2bf(bf2f(U[o]) * sg * siluf_(bf2f(G[o])));
}

extern "C" void kernel_launch(void* const* d_in, const int* in_sizes, int n_in, void* d_out, int out_size, void* d_ws, size_t ws_size, hipStream_t stream) {
    if (n_in != 22 || in_sizes[0] != M * D || out_size != M * D || ws_size < WS_END) {
        fprintf(stderr, "kernel_launch: unexpected shapes: n_in %d in0 %d out %d ws %zu\n", n_in, n_in > 0 ? in_sizes[0] : -1, out_size, ws_size); return; }
    const float* x = (const float*)d_in[0]; const float* norm_a = (const float*)d_in[1]; const float* w_in_a = (const float*)d_in[2];
    const float* conv_w = (const float*)d_in[3]; const float* conv_b = (const float*)d_in[4]; const float* gate_a_w = (const float*)d_in[5];
    const float* gate_a_b = (const float*)d_in[6]; const float* gate_x_w = (const float*)d_in[7]; const float* gate_x_b = (const float*)d_in[8];
    const float* lru_lambda = (const float*)d_in[9]; const float* q_norm_g = (const float*)d_in[10]; const float* k_norm_g = (const float*)d_in[11];
    const float* sinks = (const float*)d_in[12]; const float* w_out_a = (const float*)d_in[13]; const float* rel_bias = (const float*)d_in[14];
    const float* norm_c = (const float*)d_in[15]; const float* w_in_c = (const float*)d_in[16]; const float* ln_v_g = (const float*)d_in[17];
    const float* ln_v_b = (const float*)d_in[18]; const float* spatial_w = (const float*)d_in[19]; const float* spatial_b = (const float*)d_in[20];
    const float* w_out_c = (const float*)d_in[21];
    unsigned char* ws = (unsigned char*)d_ws; float* out = (float*)d_out;
    float* btab = (float*)(ws + WS_BIAS); bf16* WaT = (bf16*)(ws + WS_WAT); bf16* WoaT = (bf16*)(ws + WS_WOAT); bf16* WcT = (bf16*)(ws + WS_WCT); bf16* WocT = (bf16*)(ws + WS_WOCT);
    bf16* WG = (bf16*)(ws + WS_WG); float* ssq = (float*)(ws + WS_SSQ); float* vst = (float*)(ws + WS_VST);
    bf16* z0 = (bf16*)(ws + WS_Z0); bf16* y0 = (bf16*)(ws + WS_Y0); bf16* x1b = (bf16*)(ws + WS_X1B);
    bf16* U = (bf16*)(ws + WS_U); bf16* V = (bf16*)(ws + WS_V); bf16* G = (bf16*)(ws + WS_G);
    bf16* h0 = (bf16*)d_out;

    k_transpose<<<dim3(NA / 32, D / 32), 256, 0, stream>>>(w_in_a, nullptr, WaT, D, NA);
    k_transpose<<<dim3(D / 32, GW / 32), 256, 0, stream>>>(w_out_a, nullptr, WoaT, GW, D);
    k_transpose<<<dim3(NC / 32, D / 32), 256, 0, stream>>>(w_in_c, norm_c, WcT, D, NC);
    k_transpose<<<dim3(D / 32, GW / 32), 256, 0, stream>>>(w_out_c, nullptr, WocT, GW, D);
    k_gatew<<<8 * 2 * 128 * 128 / 256, 256, 0, stream>>>(gate_a_w, gate_x_w, WG);
    k_biastab<<<16 * 128 / 256, 256, 0, stream>>>(rel_bias, btab);
    k_rms_h0<<<M / 4, 256, 0, stream>>>(x, norm_a, h0);
    { GemmArgs g{}; g.A = h0; g.lda = D; g.Bt = WaT; g.N = NA; g.K = D; g.C0 = z0; g.ldc = NA; k_gemm<0><<<dim3(NA / 64, M / 64), 256, 0, stream>>>(g); }
    k_lru<<<NB * 8, 128, 0, stream>>>(z0, conv_w, conv_b, WG, gate_a_b, gate_x_b, lru_lambda, y0);
    k_attn<<<M * 16 / 64, 64, 0, stream>>>(z0, q_norm_g, k_norm_g, sinks, btab, y0);
    { GemmArgs g{}; g.A = y0; g.lda = GW; g.Bt = WoaT; g.N = D; g.K = GW; g.resid = x; g.out = out; g.x1b = x1b; k_gemm<1><<<dim3(D / 64, M / 64), 256, 0, stream>>>(g); }
    k_ssq<<<M / 4, 256, 0, stream>>>(out, ssq);
    { GemmArgs g{}; g.A = x1b; g.lda = D; g.Bt = WcT; g.N = NC; g.K = D; g.ssq = ssq; g.U = U; g.V = V; g.G = G; k_gemm<2><<<dim3(NC / 64, M / 64), 256, 0, stream>>>(g); }
    k_vstats<<<M / 4, 256, 0, stream>>>(V, vst);
    k_gate<<<dim3(GW / 256, M), 256, 0, stream>>>(U, V, G, vst, ln_v_g, ln_v_b, spatial_w, spatial_b);
    { GemmArgs g{}; g.A = U; g.lda = GW; g.Bt = WocT; g.N = D; g.K = GW; g.out = out; k_gemm<3><<<dim3(D / 64, M / 64), 256, 0, stream>>>(g); }
}
```

```cpp
#include <hip/hip_runtime.h>
#include <cstdint>
#include <cstdio>

typedef unsigned short bf16;
constexpr int D = 1024, NB = 16, S = 2048, M = NB * S;
constexpr int NA = 4352, NC = 6144, GW = 2048;
constexpr float EPS = 1e-6f;
constexpr size_t MiB = 1u << 20;
constexpr size_t WS_CTL = 0, CTL_ZERO_BYTES = 1 * MiB;
constexpr size_t WS_BIAS = 1 * MiB;
constexpr size_t WS_WAT = 2 * MiB;
constexpr size_t WS_WOAT = 11 * MiB;
constexpr size_t WS_WCT = 15 * MiB;
constexpr size_t WS_WOCT = 27 * MiB;
constexpr size_t WS_WG = 31 * MiB;
constexpr size_t WS_SSQ = 32 * MiB;
constexpr size_t WS_VST = 34 * MiB;
constexpr size_t WS_VFIN = 42 * MiB;
constexpr size_t WS_Z0 = 48 * MiB;
constexpr size_t WS_Y0 = 320 * MiB;
constexpr size_t WS_X1B = 448 * MiB;
constexpr size_t WS_U = 48 * MiB, WS_V = 176 * MiB, WS_G = 304 * MiB;
constexpr size_t WS_END = 512 * MiB;

__device__ __forceinline__ unsigned f2bf(float f) { unsigned u = __builtin_bit_cast(unsigned, f); return (u + 0x7fffu + ((u >> 16) & 1u)) >> 16; }
__device__ __forceinline__ float bf2f(unsigned h) { return __builtin_bit_cast(float, h << 16); }
__device__ __forceinline__ float bfr(float f) { return bf2f(f2bf(f)); }
__device__ __forceinline__ float sigmoidf_(float x) { return 1.f / (1.f + __expf(-x)); }
__device__ __forceinline__ float siluf_(float x) { return x / (1.f + __expf(-x)); }

namespace pg8 {
#define PG8_LAS __attribute__((address_space(3)))
typedef unsigned short bf16_t;
typedef short bf16x8 __attribute__((ext_vector_type(8)));
typedef float f32x4 __attribute__((ext_vector_type(4)));
typedef unsigned u32x4 __attribute__((ext_vector_type(4)));
constexpr int BM = 256, BK = 64, HALF = 128, HTB = HALF * BK * 2  , STAGE_BYTES = 8 * HTB, NXCD = 8, WGM = 8;

__host__ __device__ __forceinline__ int lds_byte(int r, int c) { const int st = (r >> 4) * 2 + (c >> 5), rr = r & 15, cc = c & 31, ob = rr * 64 + cc * 2; return st * 1024 + (ob ^ (((ob >> 9) & 1) << 5)); }
__host__ __device__ __forceinline__ void stage_rc(int b, int& R, int& C) { const int st = b / 1024, sb = b % 1024, swz = sb ^ (((sb >> 9) & 1) << 5); R = (st >> 1) * 16 + swz / 64; C = (st & 1) * 32 + (swz % 64) / 2; }
__host__ __device__ __forceinline__ int perm32(int rho) { const int n = rho >> 4, i = rho & 15; return 8 * (i >> 2) + 4 * n + (i & 3); }

struct Unit { int pm, pn; };
struct Gemm { const bf16_t* A; const bf16_t* Bt; int M, N, K; };

struct StaticOrder {
    int nM, nN, nwg, G, c;
    __host__ __device__ void init(int M, int N, int G_, int c_) { nM = M / BM; nN = N / BM; nwg = nM * nN; G = G_; c = c_; }
    __host__ __device__ bool next(int i, Unit& u) const {
        const long L = (long)i * G + c; if (L >= nwg) return false;
        int wgid = (int)L; { const int q = nwg / NXCD, r = nwg % NXCD, xcd = wgid % NXCD, off = wgid / NXCD; wgid = (xcd < r ? xcd * (q + 1) : r * (q + 1) + (xcd - r) * q) + off; }
        const int nig = WGM * nN, gid = wgid / nig, fm = gid * WGM, gsz = (nM - fm) < WGM ? (nM - fm) : WGM;
        u.pm = fm + ((wgid % nig) % gsz); u.pn = (wgid % nig) / gsz; return true;
    }
    __device__ __forceinline__ void a_ready(const Unit&) const {}
    __device__ __forceinline__ void done(const Unit&) const {}
};
__device__ __forceinline__ unsigned cvt_pk_bf16(float lo, float hi) { unsigned r; asm volatile("v_cvt_pk_bf16_f32 %0, %1, %2" : "=v"(r) : "v"(lo), "v"(hi)); return r; }
typedef float f32x2 __attribute__((ext_vector_type(2)));
typedef unsigned u32x2 __attribute__((ext_vector_type(2)));
struct EpiZ0 {
    static constexpr bool PERM = true, AFTER_DRAIN = false;
    bf16_t* O; int ldc;
    __device__ __forceinline__ void operator()(const f32x4 (&acc)[2][2][4][2], const Unit& u, int wr, int wc, int fr, int fq) const {
        const int row0 = u.pm * BM + wr * 64 + fr, col0 = u.pn * BM + wc * 32 + 8 * fq;
#pragma unroll
        for (int ai = 0; ai < 2; ++ai)
#pragma unroll
            for (int m = 0; m < 4; ++m) { bf16_t* rowp = O + (size_t)(row0 + ai * HALF + m * 16) * ldc + col0;
#pragma unroll
                for (int bj = 0; bj < 2; ++bj) { const f32x4 v0 = acc[ai][bj][m][0], v1 = acc[ai][bj][m][1];
                    u32x4 w; w.x = cvt_pk_bf16(v0[0], v0[1]); w.y = cvt_pk_bf16(v0[2], v0[3]); w.z = cvt_pk_bf16(v1[0], v1[1]); w.w = cvt_pk_bf16(v1[2], v1[3]);
                    *(u32x4*)(rowp + bj * HALF) = w; } }
    }
};
struct EpiRes1 {
    static constexpr bool PERM = true, AFTER_DRAIN = false;
    const float* resid; float* out; bf16_t* x1b; float* ssq;
    __device__ __forceinline__ void operator()(const f32x4 (&acc)[2][2][4][2], const Unit& u, int wr, int wc, int fr, int fq) const {
        const int row0 = u.pm * BM + wr * 64 + fr, col0 = u.pn * BM + wc * 32 + 8 * fq;
#pragma unroll
        for (int ai = 0; ai < 2; ++ai)
#pragma unroll
            for (int m = 0; m < 4; ++m) { const int row = row0 + ai * HALF + m * 16; const size_t off = (size_t)row * 1024 + col0; float s = 0.f;
#pragma unroll
                for (int bj = 0; bj < 2; ++bj) {
                    const f32x4 r0 = *(const f32x4*)(resid + off + bj * HALF), r1 = *(const f32x4*)(resid + off + bj * HALF + 4);
                    const f32x4 v0 = acc[ai][bj][m][0] + r0, v1 = acc[ai][bj][m][1] + r1;
                    *(f32x4*)(out + off + bj * HALF) = v0; *(f32x4*)(out + off + bj * HALF + 4) = v1;
                    u32x4 w; w.x = cvt_pk_bf16(v0[0], v0[1]); w.y = cvt_pk_bf16(v0[2], v0[3]); w.z = cvt_pk_bf16(v1[0], v1[1]); w.w = cvt_pk_bf16(v1[2], v1[3]);
                    *(u32x4*)(x1b + off + bj * HALF) = w;
                    s += (v0[0] * v0[0] + v0[1] * v0[1]) + (v0[2] * v0[2] + v0[3] * v0[3]) + (v1[0] * v1[0] + v1[1] * v1[1]) + (v1[2] * v1[2] + v1[3] * v1[3]); }
                s += __shfl_xor(s, 16); s += __shfl_xor(s, 32);
                if (fq == 0) ssq[(size_t)row * 16 + u.pn * 4 + wc] = s; }
    }
};
struct EpiZ1 {
    static constexpr bool PERM = true, AFTER_DRAIN = false;
    bf16_t* O; size_t split_stride; const float* ssq; float* vst;
    __device__ __forceinline__ void operator()(const f32x4 (&acc)[2][2][4][2], const Unit& u, int wr, int wc, int fr, int fq) const {
        const int row0 = u.pm * BM + wr * 64 + fr; const int t = u.pn >> 3, colt = (u.pn & 7) * BM;
        bf16_t* base = O + (size_t)t * split_stride; const int col0 = colt + wc * 32 + 8 * fq;
#pragma unroll
        for (int ai = 0; ai < 2; ++ai)
#pragma unroll
            for (int m = 0; m < 4; ++m) { const int row = row0 + ai * HALF + m * 16;
                const f32x4* sp = (const f32x4*)(ssq + (size_t)row * 16); const f32x4 a = sp[0], b = sp[1], c = sp[2], d = sp[3];
                const float tot = ((a[0] + a[1]) + (a[2] + a[3])) + ((b[0] + b[1]) + (b[2] + b[3])) + ((c[0] + c[1]) + (c[2] + c[3])) + ((d[0] + d[1]) + (d[2] + d[3]));
                const float rstd = rsqrtf(tot * (1.f / 1024.f) + 1e-6f);
                bf16_t* rowp = base + (size_t)row * 2048 + col0; float s1 = 0.f, s2 = 0.f;
#pragma unroll
                for (int bj = 0; bj < 2; ++bj) { const f32x4 v0 = acc[ai][bj][m][0] * rstd, v1 = acc[ai][bj][m][1] * rstd;
                    u32x4 w; w.x = cvt_pk_bf16(v0[0], v0[1]); w.y = cvt_pk_bf16(v0[2], v0[3]); w.z = cvt_pk_bf16(v1[0], v1[1]); w.w = cvt_pk_bf16(v1[2], v1[3]);
                    *(u32x4*)(rowp + bj * HALF) = w;
                    s1 += ((v0[0] + v0[1]) + (v0[2] + v0[3])) + ((v1[0] + v1[1]) + (v1[2] + v1[3]));
                    s2 += (v0[0] * v0[0] + v0[1] * v0[1]) + (v0[2] * v0[2] + v0[3] * v0[3]) + (v1[0] * v1[0] + v1[1] * v1[1]) + (v1[2] * v1[2] + v1[3] * v1[3]); }
                if (t == 1) { s1 += __shfl_xor(s1, 16); s1 += __shfl_xor(s1, 32); s2 += __shfl_xor(s2, 16); s2 += __shfl_xor(s2, 32);
                    if (fq == 0) { f32x2 o; o.x = s1; o.y = s2; *(f32x2*)(vst + ((size_t)row * 32 + (u.pn & 7) * 4 + wc) * 2) = o; } } }
    }
};
struct EpiRes3 {
    static constexpr bool PERM = true, AFTER_DRAIN = false;
    float* out;
    __device__ __forceinline__ void operator()(const f32x4 (&acc)[2][2][4][2], const Unit& u, int wr, int wc, int fr, int fq) const {
        const int row0 = u.pm * BM + wr * 64 + fr, col0 = u.pn * BM + wc * 32 + 8 * fq;
#pragma unroll
        for (int ai = 0; ai < 2; ++ai)
#pragma unroll
            for (int m = 0; m < 4; ++m) { const size_t off = (size_t)(row0 + ai * HALF + m * 16) * 1024 + col0;
#pragma unroll
                for (int bj = 0; bj < 2; ++bj) {
                    const f32x4 r0 = *(const f32x4*)(out + off + bj * HALF), r1 = *(const f32x4*)(out + off + bj * HALF + 4);
                    *(f32x4*)(out + off + bj * HALF) = acc[ai][bj][m][0] + r0; *(f32x4*)(out + off + bj * HALF + 4) = acc[ai][bj][m][1] + r1; } }
    }
};
template <class Epi, class Sched, bool ALIGN_EPI = false, bool SP2 = false>
__device__ __forceinline__ void gemm_phase(PG8_LAS unsigned char* lds, const Gemm g, const Sched& S, const Epi& E) {
    const int tid = threadIdx.x, wid = __builtin_amdgcn_readfirstlane(tid >> 6), lane = tid & 63, wr = wid >> 2, wc = wid & 3, fr = lane & 15, fq = lane >> 4;
    const int K = g.K, nt = K / BK;
    unsigned voffA[2], voffB[2];
#pragma unroll
    for (int i = 0; i < 2; ++i) { int R, C; stage_rc(tid * 16 + i * 8192, R, C); const int Rb = Epi::PERM ? ((R & ~31) + perm32(R & 31)) : R;
        voffA[i] = (unsigned)(R * K + C) * 2u; voffB[i] = (unsigned)(Rb * K + C) * 2u; }
    const size_t kstep = (size_t)(BK * 2);
    const size_t hstep = (size_t)HALF * K * 2;
    const size_t tstep = 2 * hstep;
    const unsigned ldsw = (unsigned)wid * 1024u;
    const int aoff = lds_byte(wr * 64 + fr, fq * 8), boff = lds_byte(wc * 32 + fr, fq * 8);
#define PG8_SA(b, h) (((b) * 2 + (h)) * HTB)
#define PG8_SB(b, h) ((4 + (b) * 2 + (h)) * HTB)
#define PG8_STAGE(bufoff, gbase, voff) do { _Pragma("unroll") for (int _i = 0; _i < 2; ++_i) \
        __builtin_amdgcn_global_load_lds((const unsigned*)((const char*)(gbase) + (voff)[_i]), (PG8_LAS unsigned*)(lds + (bufoff) + ldsw + _i * 8192), 16, 0, 0); } while (0)
#define PG8_LDA(dst, b, h) do { _Pragma("unroll") for (int m = 0; m < 4; ++m) _Pragma("unroll") for (int k = 0; k < 2; ++k) dst[m][k] = *(const PG8_LAS bf16x8*)(lds + PG8_SA(b, h) + aoff + m * 2048 + k * 1024); } while (0)
#define PG8_LDB(dst, b, h) do { _Pragma("unroll") for (int n = 0; n < 2; ++n) _Pragma("unroll") for (int k = 0; k < 2; ++k) dst[n][k] = *(const PG8_LAS bf16x8*)(lds + PG8_SB(b, h) + boff + n * 2048 + k * 1024); } while (0)
#define PG8_MMA(ai, bj, At, Bt) do { __builtin_amdgcn_s_setprio(1); _Pragma("unroll") for (int m = 0; m < 4; ++m) _Pragma("unroll") for (int n = 0; n < 2; ++n) _Pragma("unroll") for (int k = 0; k < 2; ++k) \
        acc[ai][bj][m][n] = __builtin_amdgcn_mfma_f32_16x16x32_bf16(Bt[n][k], At[m][k], acc[ai][bj][m][n], 0, 0, 0); __builtin_amdgcn_s_setprio(0); } while (0)
#define PG8_WAIT_V(n) asm volatile("s_waitcnt vmcnt(" #n ")" ::: "memory")
#define PG8_WAIT_L(n) asm volatile("s_waitcnt lgkmcnt(" #n ")" ::: "memory")
#define PG8_BAR __builtin_amdgcn_s_barrier()
#define PG8_SCHED __builtin_amdgcn_sched_barrier(0)
    Unit cur, nxt; int ui = 0;
    if (!S.next(0, cur)) return;
    f32x4 acc[2][2][4][2];
#pragma unroll
    for (int a = 0; a < 2; ++a)
#pragma unroll
        for (int b = 0; b < 2; ++b)
#pragma unroll
            for (int m = 0; m < 4; ++m)
#pragma unroll
                for (int n = 0; n < 2; ++n) acc[a][b][m][n] = (f32x4){0.f, 0.f, 0.f, 0.f};
    bf16x8 At[4][2], B0[2][2], B1[2][2];
    const char* cA = (const char*)g.A + (size_t)cur.pm * tstep; const char* cB = (const char*)g.Bt + (size_t)cur.pn * tstep;
    S.a_ready(cur);
    if constexpr (SP2) {
        PG8_STAGE(PG8_SB(0, 0), cB, voffB); PG8_STAGE(PG8_SB(0, 1), cB + hstep, voffB); PG8_STAGE(PG8_SA(0, 0), cA, voffA); PG8_STAGE(PG8_SA(0, 1), cA + hstep, voffA);
        if (wr == 1) PG8_BAR;
        PG8_WAIT_V(2); PG8_BAR;
        PG8_STAGE(PG8_SB(1, 0), cB + kstep, voffB); PG8_STAGE(PG8_SA(1, 0), cA + kstep, voffA); PG8_STAGE(PG8_SB(1, 1), cB + hstep + kstep, voffB);
        PG8_WAIT_V(6); PG8_BAR;
    } else {
        PG8_STAGE(PG8_SB(0, 0), cB, voffB); PG8_STAGE(PG8_SA(0, 0), cA, voffA); PG8_STAGE(PG8_SB(0, 1), cB + hstep, voffB); PG8_STAGE(PG8_SA(0, 1), cA + hstep, voffA);
        if (wr == 1) PG8_BAR;
        PG8_WAIT_V(4); PG8_BAR;
        PG8_STAGE(PG8_SB(1, 0), cB + kstep, voffB); PG8_STAGE(PG8_SA(1, 0), cA + kstep, voffA); PG8_STAGE(PG8_SB(1, 1), cB + hstep + kstep, voffB);
        PG8_WAIT_V(6); PG8_BAR;
    }
    for (;;) {
        const bool has_next = S.next(ui + 1, nxt);
        const char* nA = has_next ? (const char*)g.A + (size_t)nxt.pm * tstep : cA; const char* nB = has_next ? (const char*)g.Bt + (size_t)nxt.pn * tstep : cB;
        for (int t = 0; t < nt; t += 2) {
            const bool last = (t == nt - 2);
            const char* a1 = cA + (size_t)(t + 1) * kstep;
            const char* a2 = last ? nA : cA + (size_t)(t + 2) * kstep; const char* b2 = last ? nB : cB + (size_t)(t + 2) * kstep;
            const char* a3 = a2 + kstep; const char* b3 = b2 + kstep;
            if (last && has_next) S.a_ready(nxt);
            if constexpr (SP2) {
            PG8_LDB(B0, 0, 0); PG8_LDB(B1, 0, 1); PG8_SCHED; PG8_LDA(At, 0, 0); PG8_STAGE(PG8_SA(1, 1), a1 + hstep, voffA);
            PG8_WAIT_V(8); PG8_WAIT_L(0); PG8_BAR; PG8_MMA(0, 0, At, B0); PG8_MMA(0, 1, At, B1); PG8_BAR; PG8_SCHED;
            PG8_LDA(At, 0, 1); PG8_STAGE(PG8_SB(0, 0), b2, voffB); PG8_STAGE(PG8_SB(0, 1), b2 + hstep, voffB); PG8_STAGE(PG8_SA(0, 0), a2, voffA);
            PG8_WAIT_V(8); PG8_WAIT_L(0); PG8_BAR; PG8_MMA(1, 0, At, B0); PG8_MMA(1, 1, At, B1); PG8_BAR; PG8_SCHED;
            PG8_LDB(B0, 1, 0); PG8_LDB(B1, 1, 1); PG8_SCHED; PG8_LDA(At, 1, 0); PG8_STAGE(PG8_SA(0, 1), a2 + hstep, voffA);
            PG8_WAIT_V(8); PG8_WAIT_L(0); PG8_BAR; PG8_MMA(0, 0, At, B0); PG8_MMA(0, 1, At, B1); PG8_BAR; PG8_SCHED;
            PG8_LDA(At, 1, 1); PG8_STAGE(PG8_SB(1, 0), b3, voffB); PG8_STAGE(PG8_SB(1, 1), b3 + hstep, voffB); PG8_STAGE(PG8_SA(1, 0), a3, voffA);
            PG8_WAIT_V(8); PG8_WAIT_L(0); PG8_BAR; PG8_MMA(1, 0, At, B0); PG8_MMA(1, 1, At, B1); PG8_BAR; PG8_SCHED;
            } else {
            PG8_LDB(B0, 0, 0); PG8_SCHED; PG8_LDA(At, 0, 0); PG8_STAGE(PG8_SA(1, 1), a1 + hstep, voffA);
            PG8_WAIT_L(8); PG8_BAR; PG8_WAIT_L(0); PG8_MMA(0, 0, At, B0); PG8_BAR; PG8_SCHED;
            PG8_LDB(B1, 0, 1); PG8_STAGE(PG8_SB(0, 0), b2, voffB);
            PG8_BAR; PG8_WAIT_L(0); PG8_MMA(0, 1, At, B1); PG8_BAR;
            PG8_LDA(At, 0, 1); PG8_STAGE(PG8_SA(0, 0), a2, voffA);
            PG8_BAR; PG8_WAIT_L(0); PG8_MMA(1, 0, At, B0); PG8_BAR; PG8_SCHED;
            PG8_STAGE(PG8_SB(0, 1), b2 + hstep, voffB);
            PG8_WAIT_V(6); PG8_BAR; PG8_MMA(1, 1, At, B1); PG8_BAR;
            PG8_LDB(B0, 1, 0); PG8_SCHED; PG8_LDA(At, 1, 0); PG8_STAGE(PG8_SA(0, 1), a2 + hstep, voffA);
            PG8_WAIT_L(8); PG8_BAR; PG8_WAIT_L(0); PG8_MMA(0, 0, At, B0); PG8_BAR; PG8_SCHED;
            PG8_LDB(B1, 1, 1); PG8_STAGE(PG8_SB(1, 0), b3, voffB);
            PG8_BAR; PG8_WAIT_L(0); PG8_MMA(0, 1, At, B1); PG8_BAR;
            PG8_LDA(At, 1, 1); PG8_STAGE(PG8_SA(1, 0), a3, voffA);
            PG8_BAR; PG8_WAIT_L(0); PG8_MMA(1, 0, At, B0); PG8_BAR; PG8_SCHED;
            PG8_STAGE(PG8_SB(1, 1), b3 + hstep, voffB);
            PG8_WAIT_V(6); PG8_BAR; PG8_MMA(1, 1, At, B1); PG8_BAR;
            }
        }
        if constexpr (ALIGN_EPI) { if (wr == 0) PG8_BAR; }
        if constexpr (!Epi::AFTER_DRAIN) { E(acc, cur, wr, wc, fr, fq); S.done(cur); }
        if (!has_next) break;
#pragma unroll
        for (int a = 0; a < 2; ++a)
#pragma unroll
            for (int b = 0; b < 2; ++b)
#pragma unroll
                for (int m = 0; m < 4; ++m)
#pragma unroll
                    for (int n = 0; n < 2; ++n) acc[a][b][m][n] = (f32x4){0.f, 0.f, 0.f, 0.f};
        cur = nxt; cA = nA; cB = nB; ++ui;
        if constexpr (ALIGN_EPI) { if (wr == 1) PG8_BAR; }
    }
    PG8_WAIT_V(0);
    if constexpr (!ALIGN_EPI) { if (wr == 0) PG8_BAR; }
    PG8_BAR;
    if constexpr (Epi::AFTER_DRAIN) { E.fused(acc, cur, wr, wc, fr, fq, lds, wid, lane); S.done(cur); }
#undef PG8_SA
#undef PG8_SB
#undef PG8_STAGE
#undef PG8_LDA
#undef PG8_LDB
#undef PG8_MMA
#undef PG8_WAIT_V
#undef PG8_WAIT_L
#undef PG8_BAR
#undef PG8_SCHED
}
}

constexpr int NWAVES = 8;
constexpr int RING_OFF = 0, RING_BYTES = 131072;
constexpr int LDSCTL_OFF = RING_BYTES, MISC_OFF = LDSCTL_OFF + 320;
constexpr int LDS_BYTES = 147456;
#define GAS __attribute__((address_space(1)))
#define LAS __attribute__((address_space(3)))
typedef unsigned v4u __attribute__((ext_vector_type(4)));
typedef float f32x4 __attribute__((ext_vector_type(4)));
typedef short bf16x8 __attribute__((ext_vector_type(8)));
typedef GAS unsigned gu32;
#define RLX_AGENT __ATOMIC_RELAXED, __HIP_MEMORY_SCOPE_AGENT
constexpr int CW_TMO = 0, CW_CODE = 1, CW_BAR = 4096;

#define XB_TMO      128
#define XB_XCNT(j)  (256  + 64 * (j))
#define XB_XSUB(j)  (1280 + 64 * (j))
#define XB_XGEN(j)  (2304 + 64 * (j))
#define XB_TOP      3328
#define XB_TOPGEN   3392
#define XCD_BAR_WORDS 3456
#define XB_SPIN_CAP (1u << 18)

__device__ __forceinline__ unsigned xb_ld(unsigned* p)              { return __hip_atomic_load(p, __ATOMIC_RELAXED, __HIP_MEMORY_SCOPE_AGENT); }
__device__ __forceinline__ unsigned xb_add(unsigned* p, unsigned v) { return __hip_atomic_fetch_add(p, v, __ATOMIC_RELAXED, __HIP_MEMORY_SCOPE_AGENT); }
__device__ __forceinline__ unsigned xb_xcc_id() { return (unsigned)__builtin_amdgcn_s_getreg((3 << 11) | 20) & 0xFu; }
#define XB_SPIN(cond, bar) do { unsigned _sp = 0; while (cond) { __builtin_amdgcn_s_sleep(1); \
    if ((++_sp & 255u) == 0u) { if (xb_ld(&(bar)[XB_TMO])) break; if (_sp > XB_SPIN_CAP) { atomicAdd(&(bar)[XB_TMO], 1u); break; } } } } while (0)

struct XcdBarrier {
    unsigned* bar; unsigned x;
    volatile LAS unsigned* st;
};

__device__ __forceinline__ XcdBarrier xcd_barrier_post(unsigned* bar, volatile LAS unsigned* st) {
    XcdBarrier b; b.bar = bar; b.x = xb_xcc_id(); b.st = st;
    if (threadIdx.x == 0) (void)xb_add(&bar[XB_XCNT(b.x)], 1u);
    return b;
}
__device__ __forceinline__ void xcd_barrier_complete(unsigned* bar, unsigned x, unsigned& nloc, unsigned& nx) {
    const unsigned G = gridDim.x * gridDim.y * gridDim.z;
    unsigned sum, cnt, mine, sp = 0u;
    for (;;) {
        sum = 0u; cnt = 0u; mine = 0u;
#pragma unroll
        for (unsigned j = 0; j < 16; ++j) { const unsigned c = xb_ld(&bar[XB_XCNT(j)]); sum += c; cnt += (c > 0u) ? 1u : 0u; mine = (j == x) ? c : mine; }
        if (sum == G) break;
        __builtin_amdgcn_s_sleep(1);
        if ((++sp & 255u) == 0u) { if (xb_ld(&bar[XB_TMO])) break; if (sp > XB_SPIN_CAP) { atomicAdd(&bar[XB_TMO], 1u); break; } }
    }
    nloc = mine > 0u ? mine : 1u; nx = cnt > 0u ? cnt : 1u;
}

__device__ __forceinline__ void xcd_barrier(const XcdBarrier& b) {
    asm volatile("s_waitcnt vmcnt(0)" ::: "memory");
    __syncthreads();
    if (threadIdx.x == 0) {
        unsigned* bar = b.bar;
        __builtin_amdgcn_s_waitcnt(0);
        unsigned nloc = b.st[0], nx = b.st[1];
        if (nloc == 0u) { xcd_barrier_complete(bar, b.x, nloc, nx); b.st[0] = nloc; b.st[1] = nx; }
        const unsigned old = xb_add(&bar[XB_XSUB(b.x)], 1u);
        const unsigned gen = old / nloc;
        if (old + 1u == (gen + 1u) * nloc) {
            __builtin_amdgcn_fence(__ATOMIC_RELEASE, "agent");
            asm volatile("s_waitcnt vmcnt(0)" ::: "memory");
            const unsigned og = xb_add(&bar[XB_TOP], 1u);
            const unsigned tg = og / nx;
            if (og + 1u == (tg + 1u) * nx) xb_add(&bar[XB_TOPGEN], 1u);
            else XB_SPIN(xb_ld(&bar[XB_TOPGEN]) == tg, bar);
            __builtin_amdgcn_fence(__ATOMIC_ACQUIRE, "agent");
            xb_add(&bar[XB_XGEN(b.x)], 1u);
            asm volatile("s_waitcnt vmcnt(0)" ::: "memory");
        } else {
            XB_SPIN(xb_ld(&bar[XB_XGEN(b.x)]) == gen, bar);
            __builtin_amdgcn_fence(__ATOMIC_ACQUIRE, "agent");
            asm volatile("s_waitcnt vmcnt(0)" ::: "memory");
        }
    }
    __syncthreads();
}

struct Args { const float* in[22]; float* out; unsigned char* ws; int ph_lo, ph_hi; };
struct Frame {
    LAS unsigned char* lds; volatile LAS unsigned* MISC; gu32* ctl;
    int tid, lane, wave, vcu, G;
};
__global__ void __launch_bounds__(NWAVES * 64, 2) mega(Args args) {
    extern __shared__ __attribute__((aligned(16))) unsigned char lds[];
    Frame F;
    F.lds = (LAS unsigned char*)lds;
    F.MISC = (volatile LAS unsigned*)(F.lds + MISC_OFF);
    F.tid = threadIdx.x; F.lane = F.tid & 63; F.wave = __builtin_amdgcn_readfirstlane(F.tid >> 6);
    F.G = gridDim.x; { const int bx = blockIdx.x; F.vcu = (F.G % 8 == 0) ? (bx % 8) * (F.G / 8) + bx / 8 : bx; }
    unsigned char* ws = args.ws;
    F.ctl = (gu32*)(ws + WS_CTL);
    for (int u = F.tid; u < (LDS_BYTES - LDSCTL_OFF) / 4; u += NWAVES * 64) ((LAS unsigned*)(F.lds + LDSCTL_OFF))[u] = 0u;
    __syncthreads();
    const int lo = args.ph_lo, hi = args.ph_hi;
    const bool multi = (hi - lo) > 1;
    XcdBarrier bar; bar.bar = (unsigned*)(F.ctl + CW_BAR); bar.x = 0; bar.st = nullptr;
    if (multi) bar = xcd_barrier_post((unsigned*)(F.ctl + CW_BAR), F.MISC + 8);
#define IN(k) (lo <= (k) && (k) < hi)
#define BOTH(k) (IN(k) && IN((k) + 1))
#define GRID_BAR() xcd_barrier(bar)
    bf16* WaT = (bf16*)(ws + WS_WAT); bf16* WoaT = (bf16*)(ws + WS_WOAT); bf16* WcT = (bf16*)(ws + WS_WCT); bf16* WocT = (bf16*)(ws + WS_WOCT);
    float* ssq = (float*)(ws + WS_SSQ); float* vst = (float*)(ws + WS_VST);
    bf16* z0 = (bf16*)(ws + WS_Z0); bf16* y0 = (bf16*)(ws + WS_Y0); bf16* x1b = (bf16*)(ws + WS_X1B); bf16* U = (bf16*)(ws + WS_U);
    bf16* h0 = (bf16*)args.out;

    if (IN(1)) {
        pg8::Gemm g{h0, WaT, M, NA, D}; pg8::StaticOrder So; So.init(M, NA, F.G, (int)blockIdx.x);
        pg8::EpiZ0 E{z0, NA};
        pg8::gemm_phase<pg8::EpiZ0, pg8::StaticOrder, true, true>(F.lds + RING_OFF, g, So, E);
        if (BOTH(1)) GRID_BAR();
    }
    if (IN(3)) {
        pg8::Gemm g{y0, WoaT, M, D, GW}; pg8::StaticOrder So; So.init(M, D, F.G, (int)blockIdx.x);
        pg8::EpiRes1 E{args.in[0], args.out, x1b, ssq};
        pg8::gemm_phase<pg8::EpiRes1, pg8::StaticOrder, true, true>(F.lds + RING_OFF, g, So, E);
        if (BOTH(3)) GRID_BAR();
    }
    if (IN(4)) {
        pg8::Gemm g{x1b, WcT, M, NC, D}; pg8::StaticOrder So; So.init(M, NC, F.G, (int)blockIdx.x);
        pg8::EpiZ1 E{U, (size_t)(WS_V - WS_U) / 2, ssq, vst};
        pg8::gemm_phase<pg8::EpiZ1, pg8::StaticOrder, true, true>(F.lds + RING_OFF, g, So, E);
        if (BOTH(4)) GRID_BAR();
    }
    if (IN(6)) {
        pg8::Gemm g{U, WocT, M, D, GW}; pg8::StaticOrder So; So.init(M, D, F.G, (int)blockIdx.x);
        pg8::EpiRes3 E{args.out};
        pg8::gemm_phase<pg8::EpiRes3, pg8::StaticOrder, true, true>(F.lds + RING_OFF, g, So, E);
    }
#undef IN
#undef BOTH
}

__global__ void k_transpose(const float* __restrict__ W, const float* __restrict__ scale, bf16* __restrict__ Wt, int K, int N) {
    __shared__ float t[32][33];
    const int k0 = blockIdx.y * 32, n0 = blockIdx.x * 32, tx = threadIdx.x & 31, ty = threadIdx.x >> 5;
    for (int i = ty; i < 32; i += 8) t[i][tx] = W[(size_t)(k0 + i) * N + n0 + tx] * (scale ? scale[k0 + i] : 1.f);
    __syncthreads();
    for (int i = ty; i < 32; i += 8) Wt[(size_t)(n0 + i) * K + k0 + tx] = (bf16)f2bf(t[tx][i]);
}
__global__ void k_gatew(const float* __restrict__ wa, const float* __restrict__ wx, bf16* __restrict__ WG) {
    const int idx = blockIdx.x * 256 + threadIdx.x;
    const int k = idx & 127, c = (idx >> 7) & 127, g = (idx >> 14) & 1, n = idx >> 15;
    const float* w = g ? wx : wa;
    WG[idx] = (bf16)f2bf(w[(size_t)n * 16384 + k * 128 + c]);
}
__global__ void k_biastab(const float* __restrict__ rel_bias, float* __restrict__ tab) {
    const int idx = blockIdx.x * 256 + threadIdx.x;
    const int d = idx & 127, h = idx >> 7;
    int bk;
    if (d < 16) bk = d; else { bk = 16 + (int)(logf((float)d / 16.f) / logf(8.f) * 16.f); if (bk > 31) bk = 31; }
    tab[idx] = rel_bias[bk * 16 + h];
}
__global__ void k_rms_h0(const float* __restrict__ x, const float* __restrict__ g, bf16* __restrict__ h0) {
    const int row = blockIdx.x * 4 + (threadIdx.x >> 6), lane = threadIdx.x & 63;
    const float* xr = x + (size_t)row * D;
    float v[16], s = 0.f;
#pragma unroll
    for (int j = 0; j < 16; ++j) { v[j] = xr[lane + 64 * j]; s += v[j] * v[j]; }
#pragma unroll
    for (int o = 1; o < 64; o <<= 1) s += __shfl_xor(s, o);
    const float rstd = rsqrtf(s / D + EPS);
#pragma unroll
    for (int j = 0; j < 16; ++j) h0[(size_t)row * D + lane + 64 * j] = (bf16)f2bf(v[j] * rstd * g[lane + 64 * j]);
}
__global__ void k_ssq(const float* __restrict__ x1, float* __restrict__ ssq) {
    const int row = blockIdx.x * 4 + (threadIdx.x >> 6), lane = threadIdx.x & 63;
    const float* xr = x1 + (size_t)row * D;
    float s = 0.f;
#pragma unroll
    for (int j = 0; j < 16; ++j) { const float v = xr[lane + 64 * j]; s += v * v; }
#pragma unroll
    for (int o = 1; o < 64; o <<= 1) s += __shfl_xor(s, o);
    if (lane < 16) ssq[(size_t)row * 16 + lane] = lane == 0 ? s : 0.f;
}
__global__ void k_vfin(const float* __restrict__ vpart, float* __restrict__ vst) {
    const int row = blockIdx.x * 4 + (threadIdx.x >> 6), lane = threadIdx.x & 63;
    float s = lane < 32 ? vpart[((size_t)row * 32 + lane) * 2] : 0.f, q = lane < 32 ? vpart[((size_t)row * 32 + lane) * 2 + 1] : 0.f;
#pragma unroll
    for (int o = 1; o < 64; o <<= 1) { s += __shfl_xor(s, o); q += __shfl_xor(q, o); }
    const float mean = s / GW, var = q / GW - mean * mean;
    if (lane == 0) { vst[row * 2] = mean; vst[row * 2 + 1] = rsqrtf(var + EPS); }
}

__global__ void __launch_bounds__(128) k_lru(const bf16* __restrict__ z0, const float* __restrict__ conv_w, const float* __restrict__ conv_b, const bf16* __restrict__ WG,
                                             const float* __restrict__ ba, const float* __restrict__ bx, const float* __restrict__ lam, bf16* __restrict__ y0) {
    __shared__ float xs[128];
    const int b = blockIdx.x >> 3, n = blockIdx.x & 7, c = threadIdx.x, ch = n * 128 + c;
    const float w0 = conv_w[ch], w1 = conv_w[1024 + ch], w2 = conv_w[2048 + ch], w3 = conv_w[3072 + ch], cb = conv_b[ch];
    const float bac = ba[ch], bxc = bx[ch];
    const float sp = log1pf(expf(-lam[ch]));
    const bf16* wa = WG + ((size_t)(n * 2 + 0) * 128 + c) * 128;
    const bf16* wx = WG + ((size_t)(n * 2 + 1) * 128 + c) * 128;
    float z1 = 0.f, z2 = 0.f, z3 = 0.f, h = 0.f;
    for (int t = 0; t < S; ++t) {
        const size_t row = (size_t)b * S + t;
        const float zt = bf2f(z0[row * NA + ch]);
        const float xa = w0 * z3 + w1 * z2 + w2 * z1 + w3 * zt + cb;
        z3 = z2; z2 = z1; z1 = zt;
        __syncthreads();
        xs[c] = bfr(xa);
        __syncthreads();
        float ra = 0.f, rx = 0.f;
        for (int k = 0; k < 128; ++k) { const float xv = xs[k]; ra += xv * bf2f(wa[k]); rx += xv * bf2f(wx[k]); }
        const float r = sigmoidf_(ra + bac), ig = sigmoidf_(rx + bxc);
        const float log_a = -8.f * r * sp;
        const float a = expf(log_a), mult = sqrtf(-expm1f(2.f * log_a));
        h = a * h + mult * ig * xa;
        const float ga = bf2f(z0[row * NA + 1024 + ch]);
        y0[row * GW + ch] = (bf16)f2bf(h * siluf_(ga));
    }
}

__global__ void __launch_bounds__(64) k_attn(const bf16* __restrict__ z0, const float* __restrict__ qg, const float* __restrict__ kg, const float* __restrict__ sinks,
                                             const float* __restrict__ btab, bf16* __restrict__ y0) {
    const int idx = blockIdx.x * 64 + threadIdx.x;
    const int hq = idx & 15, row = idx >> 4, t = row & (S - 1), kh = hq >> 3;
    const bf16* qp = z0 + (size_t)row * NA + 2048 + hq * 64;
    float q[64], ss = 0.f;
#pragma unroll
    for (int d = 0; d < 64; ++d) { q[d] = bf2f(qp[d]); ss += q[d] * q[d]; }
    const float rq = rsqrtf(ss / 64.f + EPS);
#pragma unroll
    for (int d = 0; d < 64; ++d) q[d] = bfr(q[d] * rq * qg[d]);
    float acc[64];
#pragma unroll
    for (int d = 0; d < 64; ++d) acc[d] = 0.f;
    float m = sinks[hq], l = 1.f;
    const int j0 = t - 127 < 0 ? 0 : t - 127;
    for (int j = j0; j <= t; ++j) {
        const size_t krow = (size_t)(row - t + j);
        const bf16* kp = z0 + krow * NA + 3072 + kh * 64;
        const bf16* vp = z0 + krow * NA + 3200 + kh * 64;
        float ks = 0.f;
#pragma unroll
        for (int d = 0; d < 64; ++d) { const float kv = bf2f(kp[d]); ks += kv * kv; }
        const float rk = rsqrtf(ks / 64.f + EPS);
        float dp = 0.f;
#pragma unroll
        for (int d = 0; d < 64; ++d) dp += q[d] * bfr(bf2f(kp[d]) * rk * kg[d]);
        const float sc = dp * 0.125f + btab[hq * 128 + (t - j)];
        const float mn = fmaxf(m, sc), f = __expf(m - mn), p = __expf(sc - mn);
        l = l * f + p; m = mn;
#pragma unroll
        for (int d = 0; d < 64; ++d) acc[d] = acc[d] * f + p * bf2f(vp[d]);
    }
    const float il = 1.f / l;
    const bf16* gp = z0 + (size_t)row * NA + 3328 + hq * 64;
    bf16* op = y0 + (size_t)row * GW + 1024 + hq * 64;
#pragma unroll
    for (int d = 0; d < 64; ++d) op[d] = (bf16)f2bf(acc[d] * il * siluf_(bf2f(gp[d])));
}

__global__ void __launch_bounds__(256) k_gate(bf16* __restrict__ U, const bf16* __restrict__ V, const bf16* __restrict__ G, const float* __restrict__ vst,
                                              const float* __restrict__ lg, const float* __restrict__ lb, const float* __restrict__ sw, const float* __restrict__ sb) {
    const int row = blockIdx.y, c = blockIdx.x * 256 + threadIdx.x, grp = c >> 8, tt = row & 127, r0 = row - tt;
    const float gam = lg[c], bet = lb[c];
    const float* w = sw + ((size_t)grp * 128 + tt) * 128;
    float acc = 0.f;
    for (int s = 0; s <= tt; ++s) {
        const float v = bf2f(V[(size_t)(r0 + s) * GW + c]);
        const float ln = (v - vst[(r0 + s) * 2]) * vst[(r0 + s) * 2 + 1] * gam + bet;
        acc += w[s] * ln;
    }
    const float sg = acc + sb[grp * 128 + tt];
    const size_t o = (size_t)row * GW + c;
    U[o] = (bf16)f2bf(bf2f(U[o]) * sg * siluf_(bf2f(G[o])));
}


static void launch_mega(const Args& a0, int lo, int hi, int grid, hipStream_t stream) {
    Args a = a0; a.ph_lo = lo; a.ph_hi = hi;
    hipLaunchKernelGGL(mega, dim3(grid), dim3(NWAVES * 64), LDS_BYTES, stream, a);
    const hipError_t le = hipPeekAtLastError();
    if (le != hipSuccess) fprintf(stderr, "kernel_launch: mega launch [%d,%d) failed: %s\n", lo, hi, hipGetErrorName(le));
}

extern "C" void kernel_launch(void* const* d_in, const int* in_sizes, int n_in, void* d_out, int out_size, void* d_ws, size_t ws_size, hipStream_t stream) {
    static int grid = 0;
    if (grid == 0) {
        if (n_in != 22 || in_sizes[0] != M * D || out_size != M * D || ws_size < WS_END) {
            fprintf(stderr, "kernel_launch: unexpected shapes: n_in %d in0 %d out %d ws %zu\n", n_in, n_in > 0 ? in_sizes[0] : -1, out_size, ws_size); grid = -1; return; }
        int dev = 0, cus = 0, per_cu = 0;
        if (hipGetDevice(&dev) != hipSuccess || hipDeviceGetAttribute(&cus, hipDeviceAttributeMultiprocessorCount, dev) != hipSuccess) { fprintf(stderr, "kernel_launch: device query failed\n"); grid = -1; return; }
        if (hipFuncSetAttribute((const void*)mega, hipFuncAttributeMaxDynamicSharedMemorySize, LDS_BYTES) != hipSuccess) { fprintf(stderr, "kernel_launch: hipFuncSetAttribute failed\n"); grid = -1; return; }
        if (hipOccupancyMaxActiveBlocksPerMultiprocessor(&per_cu, (const void*)mega, NWAVES * 64, LDS_BYTES) != hipSuccess || per_cu < 1)
            fprintf(stderr, "kernel_launch: note: occupancy query reports %d workgroups per CU\n", per_cu);
        (void)hipGetLastError();
        grid = cus;
    }
    if (grid < 0) return;
    const float* x = (const float*)d_in[0]; const float* norm_a = (const float*)d_in[1]; const float* w_in_a = (const float*)d_in[2];
    const float* conv_w = (const float*)d_in[3]; const float* conv_b = (const float*)d_in[4]; const float* gate_a_w = (const float*)d_in[5];
    const float* gate_a_b = (const float*)d_in[6]; const float* gate_x_w = (const float*)d_in[7]; const float* gate_x_b = (const float*)d_in[8];
    const float* lru_lambda = (const float*)d_in[9]; const float* q_norm_g = (const float*)d_in[10]; const float* k_norm_g = (const float*)d_in[11];
    const float* sinks = (const float*)d_in[12]; const float* w_out_a = (const float*)d_in[13]; const float* rel_bias = (const float*)d_in[14];
    const float* norm_c = (const float*)d_in[15]; const float* w_in_c = (const float*)d_in[16]; const float* ln_v_g = (const float*)d_in[17];
    const float* ln_v_b = (const float*)d_in[18]; const float* spatial_w = (const float*)d_in[19]; const float* spatial_b = (const float*)d_in[20];
    const float* w_out_c = (const float*)d_in[21];
    unsigned char* ws = (unsigned char*)d_ws; float* out = (float*)d_out;
    float* btab = (float*)(ws + WS_BIAS); bf16* WaT = (bf16*)(ws + WS_WAT); bf16* WoaT = (bf16*)(ws + WS_WOAT); bf16* WcT = (bf16*)(ws + WS_WCT); bf16* WocT = (bf16*)(ws + WS_WOCT);
    bf16* WG = (bf16*)(ws + WS_WG); float* vst = (float*)(ws + WS_VST); float* vfin = (float*)(ws + WS_VFIN);
    bf16* z0 = (bf16*)(ws + WS_Z0); bf16* y0 = (bf16*)(ws + WS_Y0);
    bf16* U = (bf16*)(ws + WS_U); bf16* V = (bf16*)(ws + WS_V); bf16* G = (bf16*)(ws + WS_G);
    bf16* h0 = (bf16*)d_out;
    if (hipMemsetAsync(ws + WS_CTL, 0, CTL_ZERO_BYTES, stream) != hipSuccess) { fprintf(stderr, "kernel_launch: memset failed\n"); return; }
    Args a{};
    for (int i = 0; i < 22; ++i) a.in[i] = (const float*)d_in[i];
    a.out = out; a.ws = ws;

    k_transpose<<<dim3(NA / 32, D / 32), 256, 0, stream>>>(w_in_a, nullptr, WaT, D, NA);
    k_transpose<<<dim3(D / 32, GW / 32), 256, 0, stream>>>(w_out_a, nullptr, WoaT, GW, D);
    k_transpose<<<dim3(NC / 32, D / 32), 256, 0, stream>>>(w_in_c, norm_c, WcT, D, NC);
    k_transpose<<<dim3(D / 32, GW / 32), 256, 0, stream>>>(w_out_c, nullptr, WocT, GW, D);
    k_gatew<<<8 * 2 * 128 * 128 / 256, 256, 0, stream>>>(gate_a_w, gate_x_w, WG);
    k_biastab<<<16 * 128 / 256, 256, 0, stream>>>(rel_bias, btab);
    k_rms_h0<<<M / 4, 256, 0, stream>>>(x, norm_a, h0);
    launch_mega(a, 1, 2, grid, stream);
    k_lru<<<NB * 8, 128, 0, stream>>>(z0, conv_w, conv_b, WG, gate_a_b, gate_x_b, lru_lambda, y0);
    k_attn<<<M * 16 / 64, 64, 0, stream>>>(z0, q_norm_g, k_norm_g, sinks, btab, y0);
    launch_mega(a, 3, 4, grid, stream);
    launch_mega(a, 4, 5, grid, stream);
    k_vfin<<<M / 4, 256, 0, stream>>>(vst, vfin);
    k_gate<<<dim3(GW / 256, M), 256, 0, stream>>>(U, V, G, vfin, ln_v_g, ln_v_b, spatial_w, spatial_b);
    launch_mega(a, 6, 7, grid, stream);
}
```

```cpp
#include <hip/hip_runtime.h>
#include <cstdint>
#include <cstdio>

typedef unsigned short bf16;
constexpr int D = 1024, NB = 16, S = 2048, M = NB * S;
constexpr int NA = 4352, NC = 6144, GW = 2048;
constexpr float EPS = 1e-6f;
constexpr size_t MiB = 1u << 20;
constexpr size_t WS_CTL = 0, CTL_ZERO_BYTES = 1 * MiB;
constexpr size_t WS_BIAS = 1 * MiB;
constexpr size_t WS_WAT = 2 * MiB;
constexpr size_t WS_WOAT = 11 * MiB;
constexpr size_t WS_WCT = 15 * MiB;
constexpr size_t WS_WOCT = 27 * MiB;
constexpr size_t WS_WG = 31 * MiB;
constexpr size_t WS_SSQ = 32 * MiB;
constexpr size_t WS_VST = 34 * MiB;
constexpr size_t WS_VFIN = 42 * MiB;
constexpr size_t WS_Z0 = 48 * MiB;
constexpr size_t WS_Y0 = 320 * MiB;
constexpr size_t WS_X1B = 448 * MiB;
constexpr size_t WS_U = 48 * MiB, WS_V = 176 * MiB, WS_G = 304 * MiB;
constexpr size_t WS_END = 512 * MiB;

__device__ __forceinline__ unsigned f2bf(float f) { unsigned u = __builtin_bit_cast(unsigned, f); return (u + 0x7fffu + ((u >> 16) & 1u)) >> 16; }
__device__ __forceinline__ float bf2f(unsigned h) { return __builtin_bit_cast(float, h << 16); }
__device__ __forceinline__ float bfr(float f) { return bf2f(f2bf(f)); }
__device__ __forceinline__ float sigmoidf_(float x) { return 1.f / (1.f + __expf(-x)); }
__device__ __forceinline__ float siluf_(float x) { return x / (1.f + __expf(-x)); }

namespace pg8 {
#define PG8_LAS __attribute__((address_space(3)))
typedef unsigned short bf16_t;
typedef short bf16x8 __attribute__((ext_vector_type(8)));
typedef float f32x4 __attribute__((ext_vector_type(4)));
typedef unsigned u32x4 __attribute__((ext_vector_type(4)));
constexpr int BM = 256, BK = 64, HALF = 128, HTB = HALF * BK * 2  , STAGE_BYTES = 8 * HTB, NXCD = 8, WGM = 8;

__host__ __device__ __forceinline__ int lds_byte(int r, int c) { const int st = (r >> 4) * 2 + (c >> 5), rr = r & 15, cc = c & 31, ob = rr * 64 + cc * 2; return st * 1024 + (ob ^ (((ob >> 9) & 1) << 5)); }
__host__ __device__ __forceinline__ void stage_rc(int b, int& R, int& C) { const int st = b / 1024, sb = b % 1024, swz = sb ^ (((sb >> 9) & 1) << 5); R = (st >> 1) * 16 + swz / 64; C = (st & 1) * 32 + (swz % 64) / 2; }
__host__ __device__ __forceinline__ int perm32(int rho) { const int n = rho >> 4, i = rho & 15; return 8 * (i >> 2) + 4 * n + (i & 3); }

struct Unit { int pm, pn; };
struct Gemm { const bf16_t* A; const bf16_t* Bt; int M, N, K; };

struct StaticOrder {
    int nM, nN, nwg, G, c;
    __host__ __device__ void init(int M, int N, int G_, int c_) { nM = M / BM; nN = N / BM; nwg = nM * nN; G = G_; c = c_; }
    __host__ __device__ bool next(int i, Unit& u) const {
        const long L = (long)i * G + c; if (L >= nwg) return false;
        int wgid = (int)L; { const int q = nwg / NXCD, r = nwg % NXCD, xcd = wgid % NXCD, off = wgid / NXCD; wgid = (xcd < r ? xcd * (q + 1) : r * (q + 1) + (xcd - r) * q) + off; }
        const int nig = WGM * nN, gid = wgid / nig, fm = gid * WGM, gsz = (nM - fm) < WGM ? (nM - fm) : WGM;
        u.pm = fm + ((wgid % nig) % gsz); u.pn = (wgid % nig) / gsz; return true;
    }
    __device__ __forceinline__ void a_ready(const Unit&) const {}
    __device__ __forceinline__ void done(const Unit&) const {}
};
__device__ __forceinline__ unsigned cvt_pk_bf16(float lo, float hi) { unsigned r; asm volatile("v_cvt_pk_bf16_f32 %0, %1, %2" : "=v"(r) : "v"(lo), "v"(hi)); return r; }
typedef float f32x2 __attribute__((ext_vector_type(2)));
typedef unsigned u32x2 __attribute__((ext_vector_type(2)));
struct EpiZ0 {
    static constexpr bool PERM = true, AFTER_DRAIN = false;
    bf16_t* O; int ldc;
    __device__ __forceinline__ void operator()(const f32x4 (&acc)[2][2][4][2], const Unit& u, int wr, int wc, int fr, int fq) const {
        const int row0 = u.pm * BM + wr * 64 + fr, col0 = u.pn * BM + wc * 32 + 8 * fq;
#pragma unroll
        for (int ai = 0; ai < 2; ++ai)
#pragma unroll
            for (int m = 0; m < 4; ++m) { bf16_t* rowp = O + (size_t)(row0 + ai * HALF + m * 16) * ldc + col0;
#pragma unroll
                for (int bj = 0; bj < 2; ++bj) { const f32x4 v0 = acc[ai][bj][m][0], v1 = acc[ai][bj][m][1];
                    u32x4 w; w.x = cvt_pk_bf16(v0[0], v0[1]); w.y = cvt_pk_bf16(v0[2], v0[3]); w.z = cvt_pk_bf16(v1[0], v1[1]); w.w = cvt_pk_bf16(v1[2], v1[3]);
                    *(u32x4*)(rowp + bj * HALF) = w; } }
    }
};
struct EpiRes1 {
    static constexpr bool PERM = true, AFTER_DRAIN = false;
    const float* resid; float* out; bf16_t* x1b; float* ssq;
    __device__ __forceinline__ void operator()(const f32x4 (&acc)[2][2][4][2], const Unit& u, int wr, int wc, int fr, int fq) const {
        const int row0 = u.pm * BM + wr * 64 + fr, col0 = u.pn * BM + wc * 32 + 8 * fq;
#pragma unroll
        for (int ai = 0; ai < 2; ++ai)
#pragma unroll
            for (int m = 0; m < 4; ++m) { const int row = row0 + ai * HALF + m * 16; const size_t off = (size_t)row * 1024 + col0; float s = 0.f;
#pragma unroll
                for (int bj = 0; bj < 2; ++bj) {
                    const f32x4 r0 = *(const f32x4*)(resid + off + bj * HALF), r1 = *(const f32x4*)(resid + off + bj * HALF + 4);
                    const f32x4 v0 = acc[ai][bj][m][0] + r0, v1 = acc[ai][bj][m][1] + r1;
                    *(f32x4*)(out + off + bj * HALF) = v0; *(f32x4*)(out + off + bj * HALF + 4) = v1;
                    u32x4 w; w.x = cvt_pk_bf16(v0[0], v0[1]); w.y = cvt_pk_bf16(v0[2], v0[3]); w.z = cvt_pk_bf16(v1[0], v1[1]); w.w = cvt_pk_bf16(v1[2], v1[3]);
                    *(u32x4*)(x1b + off + bj * HALF) = w;
                    s += (v0[0] * v0[0] + v0[1] * v0[1]) + (v0[2] * v0[2] + v0[3] * v0[3]) + (v1[0] * v1[0] + v1[1] * v1[1]) + (v1[2] * v1[2] + v1[3] * v1[3]); }
                s += __shfl_xor(s, 16); s += __shfl_xor(s, 32);
                if (fq == 0) ssq[(size_t)row * 16 + u.pn * 4 + wc] = s; }
    }
};
struct EpiZ1 {
    static constexpr bool PERM = true, AFTER_DRAIN = false;
    bf16_t* O; size_t split_stride; const float* ssq; float* vst;
    __device__ __forceinline__ void operator()(const f32x4 (&acc)[2][2][4][2], const Unit& u, int wr, int wc, int fr, int fq) const {
        const int row0 = u.pm * BM + wr * 64 + fr; const int t = u.pn >> 3, colt = (u.pn & 7) * BM;
        bf16_t* base = O + (size_t)t * split_stride; const int col0 = colt + wc * 32 + 8 * fq;
#pragma unroll
        for (int ai = 0; ai < 2; ++ai)
#pragma unroll
            for (int m = 0; m < 4; ++m) { const int row = row0 + ai * HALF + m * 16;
                const f32x4* sp = (const f32x4*)(ssq + (size_t)row * 16); const f32x4 a = sp[0], b = sp[1], c = sp[2], d = sp[3];
                const float tot = ((a[0] + a[1]) + (a[2] + a[3])) + ((b[0] + b[1]) + (b[2] + b[3])) + ((c[0] + c[1]) + (c[2] + c[3])) + ((d[0] + d[1]) + (d[2] + d[3]));
                const float rstd = rsqrtf(tot * (1.f / 1024.f) + 1e-6f);
                bf16_t* rowp = base + (size_t)row * 2048 + col0; float s1 = 0.f, s2 = 0.f;
#pragma unroll
                for (int bj = 0; bj < 2; ++bj) { const f32x4 v0 = acc[ai][bj][m][0] * rstd, v1 = acc[ai][bj][m][1] * rstd;
                    u32x4 w; w.x = cvt_pk_bf16(v0[0], v0[1]); w.y = cvt_pk_bf16(v0[2], v0[3]); w.z = cvt_pk_bf16(v1[0], v1[1]); w.w = cvt_pk_bf16(v1[2], v1[3]);
                    *(u32x4*)(rowp + bj * HALF) = w;
                    s1 += ((v0[0] + v0[1]) + (v0[2] + v0[3])) + ((v1[0] + v1[1]) + (v1[2] + v1[3]));
                    s2 += (v0[0] * v0[0] + v0[1] * v0[1]) + (v0[2] * v0[2] + v0[3] * v0[3]) + (v1[0] * v1[0] + v1[1] * v1[1]) + (v1[2] * v1[2] + v1[3] * v1[3]); }
                if (t == 1) { s1 += __shfl_xor(s1, 16); s1 += __shfl_xor(s1, 32); s2 += __shfl_xor(s2, 16); s2 += __shfl_xor(s2, 32);
                    if (fq == 0) { f32x2 o; o.x = s1; o.y = s2; *(f32x2*)(vst + ((size_t)row * 32 + (u.pn & 7) * 4 + wc) * 2) = o; } } }
    }
};
struct EpiRes3 {
    static constexpr bool PERM = true, AFTER_DRAIN = false;
    float* out;
    __device__ __forceinline__ void operator()(const f32x4 (&acc)[2][2][4][2], const Unit& u, int wr, int wc, int fr, int fq) const {
        const int row0 = u.pm * BM + wr * 64 + fr, col0 = u.pn * BM + wc * 32 + 8 * fq;
#pragma unroll
        for (int ai = 0; ai < 2; ++ai)
#pragma unroll
            for (int m = 0; m < 4; ++m) { const size_t off = (size_t)(row0 + ai * HALF + m * 16) * 1024 + col0;
#pragma unroll
                for (int bj = 0; bj < 2; ++bj) {
                    const f32x4 r0 = *(const f32x4*)(out + off + bj * HALF), r1 = *(const f32x4*)(out + off + bj * HALF + 4);
                    *(f32x4*)(out + off + bj * HALF) = acc[ai][bj][m][0] + r0; *(f32x4*)(out + off + bj * HALF + 4) = acc[ai][bj][m][1] + r1; } }
    }
};
template <class Epi, class Sched, bool ALIGN_EPI = false, bool SP2 = false>
__device__ __forceinline__ void gemm_phase(PG8_LAS unsigned char* lds, const Gemm g, const Sched& S, const Epi& E) {
    const int tid = threadIdx.x, wid = __builtin_amdgcn_readfirstlane(tid >> 6), lane = tid & 63, wr = wid >> 2, wc = wid & 3, fr = lane & 15, fq = lane >> 4;
    const int K = g.K, nt = K / BK;
    unsigned voffA[2], voffB[2];
#pragma unroll
    for (int i = 0; i < 2; ++i) { int R, C; stage_rc(tid * 16 + i * 8192, R, C); const int Rb = Epi::PERM ? ((R & ~31) + perm32(R & 31)) : R;
        voffA[i] = (unsigned)(R * K + C) * 2u; voffB[i] = (unsigned)(Rb * K + C) * 2u; }
    const size_t kstep = (size_t)(BK * 2);
    const size_t hstep = (size_t)HALF * K * 2;
    const size_t tstep = 2 * hstep;
    const unsigned ldsw = (unsigned)wid * 1024u;
    const int aoff = lds_byte(wr * 64 + fr, fq * 8), boff = lds_byte(wc * 32 + fr, fq * 8);
#define PG8_SA(b, h) (((b) * 2 + (h)) * HTB)
#define PG8_SB(b, h) ((4 + (b) * 2 + (h)) * HTB)
#define PG8_STAGE(bufoff, gbase, voff) do { _Pragma("unroll") for (int _i = 0; _i < 2; ++_i) \
        __builtin_amdgcn_global_load_lds((const unsigned*)((const char*)(gbase) + (voff)[_i]), (PG8_LAS unsigned*)(lds + (bufoff) + ldsw + _i * 8192), 16, 0, 0); } while (0)
#define PG8_LDA(dst, b, h) do { _Pragma("unroll") for (int m = 0; m < 4; ++m) _Pragma("unroll") for (int k = 0; k < 2; ++k) dst[m][k] = *(const PG8_LAS bf16x8*)(lds + PG8_SA(b, h) + aoff + m * 2048 + k * 1024); } while (0)
#define PG8_LDB(dst, b, h) do { _Pragma("unroll") for (int n = 0; n < 2; ++n) _Pragma("unroll") for (int k = 0; k < 2; ++k) dst[n][k] = *(const PG8_LAS bf16x8*)(lds + PG8_SB(b, h) + boff + n * 2048 + k * 1024); } while (0)
#define PG8_MMA(ai, bj, At, Bt) do { __builtin_amdgcn_s_setprio(1); _Pragma("unroll") for (int m = 0; m < 4; ++m) _Pragma("unroll") for (int n = 0; n < 2; ++n) _Pragma("unroll") for (int k = 0; k < 2; ++k) \
        acc[ai][bj][m][n] = __builtin_amdgcn_mfma_f32_16x16x32_bf16(Bt[n][k], At[m][k], acc[ai][bj][m][n], 0, 0, 0); __builtin_amdgcn_s_setprio(0); } while (0)
#define PG8_WAIT_V(n) asm volatile("s_waitcnt vmcnt(" #n ")" ::: "memory")
#define PG8_WAIT_L(n) asm volatile("s_waitcnt lgkmcnt(" #n ")" ::: "memory")
#define PG8_BAR __builtin_amdgcn_s_barrier()
#define PG8_SCHED __builtin_amdgcn_sched_barrier(0)
    Unit cur, nxt; int ui = 0;
    if (!S.next(0, cur)) return;
    f32x4 acc[2][2][4][2];
#pragma unroll
    for (int a = 0; a < 2; ++a)
#pragma unroll
        for (int b = 0; b < 2; ++b)
#pragma unroll
            for (int m = 0; m < 4; ++m)
#pragma unroll
                for (int n = 0; n < 2; ++n) acc[a][b][m][n] = (f32x4){0.f, 0.f, 0.f, 0.f};
    bf16x8 At[4][2], B0[2][2], B1[2][2];
    const char* cA = (const char*)g.A + (size_t)cur.pm * tstep; const char* cB = (const char*)g.Bt + (size_t)cur.pn * tstep;
    S.a_ready(cur);
    if constexpr (SP2) {
        PG8_STAGE(PG8_SB(0, 0), cB, voffB); PG8_STAGE(PG8_SB(0, 1), cB + hstep, voffB); PG8_STAGE(PG8_SA(0, 0), cA, voffA); PG8_STAGE(PG8_SA(0, 1), cA + hstep, voffA);
        if (wr == 1) PG8_BAR;
        PG8_WAIT_V(2); PG8_BAR;
        PG8_STAGE(PG8_SB(1, 0), cB + kstep, voffB); PG8_STAGE(PG8_SA(1, 0), cA + kstep, voffA); PG8_STAGE(PG8_SB(1, 1), cB + hstep + kstep, voffB);
        PG8_WAIT_V(6); PG8_BAR;
    } else {
        PG8_STAGE(PG8_SB(0, 0), cB, voffB); PG8_STAGE(PG8_SA(0, 0), cA, voffA); PG8_STAGE(PG8_SB(0, 1), cB + hstep, voffB); PG8_STAGE(PG8_SA(0, 1), cA + hstep, voffA);
        if (wr == 1) PG8_BAR;
        PG8_WAIT_V(4); PG8_BAR;
        PG8_STAGE(PG8_SB(1, 0), cB + kstep, voffB); PG8_STAGE(PG8_SA(1, 0), cA + kstep, voffA); PG8_STAGE(PG8_SB(1, 1), cB + hstep + kstep, voffB);
        PG8_WAIT_V(6); PG8_BAR;
    }
    for (;;) {
        const bool has_next = S.next(ui + 1, nxt);
        const char* nA = has_next ? (const char*)g.A + (size_t)nxt.pm * tstep : cA; const char* nB = has_next ? (const char*)g.Bt + (size_t)nxt.pn * tstep : cB;
        for (int t = 0; t < nt; t += 2) {
            const bool last = (t == nt - 2);
            const char* a1 = cA + (size_t)(t + 1) * kstep;
            const char* a2 = last ? nA : cA + (size_t)(t + 2) * kstep; const char* b2 = last ? nB : cB + (size_t)(t + 2) * kstep;
            const char* a3 = a2 + kstep; const char* b3 = b2 + kstep;
            if (last && has_next) S.a_ready(nxt);
            if constexpr (SP2) {
            PG8_LDB(B0, 0, 0); PG8_LDB(B1, 0, 1); PG8_SCHED; PG8_LDA(At, 0, 0); PG8_STAGE(PG8_SA(1, 1), a1 + hstep, voffA);
            PG8_WAIT_V(8); PG8_WAIT_L(0); PG8_BAR; PG8_MMA(0, 0, At, B0); PG8_MMA(0, 1, At, B1); PG8_BAR; PG8_SCHED;
            PG8_LDA(At, 0, 1); PG8_STAGE(PG8_SB(0, 0), b2, voffB); PG8_STAGE(PG8_SB(0, 1), b2 + hstep, voffB); PG8_STAGE(PG8_SA(0, 0), a2, voffA);
            PG8_WAIT_V(8); PG8_WAIT_L(0); PG8_BAR; PG8_MMA(1, 0, At, B0); PG8_MMA(1, 1, At, B1); PG8_BAR; PG8_SCHED;
            PG8_LDB(B0, 1, 0); PG8_LDB(B1, 1, 1); PG8_SCHED; PG8_LDA(At, 1, 0); PG8_STAGE(PG8_SA(0, 1), a2 + hstep, voffA);
            PG8_WAIT_V(8); PG8_WAIT_L(0); PG8_BAR; PG8_MMA(0, 0, At, B0); PG8_MMA(0, 1, At, B1); PG8_BAR; PG8_SCHED;
            PG8_LDA(At, 1, 1); PG8_STAGE(PG8_SB(1, 0), b3, voffB); PG8_STAGE(PG8_SB(1, 1), b3 + hstep, voffB); PG8_STAGE(PG8_SA(1, 0), a3, voffA);
            PG8_WAIT_V(8); PG8_WAIT_L(0); PG8_BAR; PG8_MMA(1, 0, At, B0); PG8_MMA(1, 1, At, B1); PG8_BAR; PG8_SCHED;
            } else {
            PG8_LDB(B0, 0, 0); PG8_SCHED; PG8_LDA(At, 0, 0); PG8_STAGE(PG8_SA(1, 1), a1 + hstep, voffA);
            PG8_WAIT_L(8); PG8_BAR; PG8_WAIT_L(0); PG8_MMA(0, 0, At, B0); PG8_BAR; PG8_SCHED;
            PG8_LDB(B1, 0, 1); PG8_STAGE(PG8_SB(0, 0), b2, voffB);
            PG8_BAR; PG8_WAIT_L(0); PG8_MMA(0, 1, At, B1); PG8_BAR;
            PG8_LDA(At, 0, 1); PG8_STAGE(PG8_SA(0, 0), a2, voffA);
            PG8_BAR; PG8_WAIT_L(0); PG8_MMA(1, 0, At, B0); PG8_BAR; PG8_SCHED;
            PG8_STAGE(PG8_SB(0, 1), b2 + hstep, voffB);
            PG8_WAIT_V(6); PG8_BAR; PG8_MMA(1, 1, At, B1); PG8_BAR;
            PG8_LDB(B0, 1, 0); PG8_SCHED; PG8_LDA(At, 1, 0); PG8_STAGE(PG8_SA(0, 1), a2 + hstep, voffA);
            PG8_WAIT_L(8); PG8_BAR; PG8_WAIT_L(0); PG8_MMA(0, 0, At, B0); PG8_BAR; PG8_SCHED;
            PG8_LDB(B1, 1, 1); PG8_STAGE(PG8_SB(1, 0), b3, voffB);
            PG8_BAR; PG8_WAIT_L(0); PG8_MMA(0, 1, At, B1); PG8_BAR;
            PG8_LDA(At, 1, 1); PG8_STAGE(PG8_SA(1, 0), a3, voffA);
            PG8_BAR; PG8_WAIT_L(0); PG8_MMA(1, 0, At, B0); PG8_BAR; PG8_SCHED;
            PG8_STAGE(PG8_SB(1, 1), b3 + hstep, voffB);
            PG8_WAIT_V(6); PG8_BAR; PG8_MMA(1, 1, At, B1); PG8_BAR;
            }
        }
        if constexpr (ALIGN_EPI) { if (wr == 0) PG8_BAR; }
        if constexpr (!Epi::AFTER_DRAIN) { E(acc, cur, wr, wc, fr, fq); S.done(cur); }
        if (!has_next) break;
#pragma unroll
        for (int a = 0; a < 2; ++a)
#pragma unroll
            for (int b = 0; b < 2; ++b)
#pragma unroll
                for (int m = 0; m < 4; ++m)
#pragma unroll
                    for (int n = 0; n < 2; ++n) acc[a][b][m][n] = (f32x4){0.f, 0.f, 0.f, 0.f};
        cur = nxt; cA = nA; cB = nB; ++ui;
        if constexpr (ALIGN_EPI) { if (wr == 1) PG8_BAR; }
    }
    PG8_WAIT_V(0);
    if constexpr (!ALIGN_EPI) { if (wr == 0) PG8_BAR; }
    PG8_BAR;
    if constexpr (Epi::AFTER_DRAIN) { E.fused(acc, cur, wr, wc, fr, fq, lds, wid, lane); S.done(cur); }
#undef PG8_SA
#undef PG8_SB
#undef PG8_STAGE
#undef PG8_LDA
#undef PG8_LDB
#undef PG8_MMA
#undef PG8_WAIT_V
#undef PG8_WAIT_L
#undef PG8_BAR
#undef PG8_SCHED
}
}

constexpr int NWAVES = 8;
constexpr int RING_OFF = 0, RING_BYTES = 131072;
constexpr int LDSCTL_OFF = RING_BYTES, MISC_OFF = LDSCTL_OFF + 320;
constexpr int LDS_BYTES = 147456;
#define GAS __attribute__((address_space(1)))
#define LAS __attribute__((address_space(3)))
typedef unsigned v4u __attribute__((ext_vector_type(4)));
typedef float f32x4 __attribute__((ext_vector_type(4)));
typedef short bf16x8 __attribute__((ext_vector_type(8)));
typedef GAS unsigned gu32;
#define RLX_AGENT __ATOMIC_RELAXED, __HIP_MEMORY_SCOPE_AGENT
constexpr int CW_TMO = 0, CW_CODE = 1, CW_BAR = 4096;

struct Args { const float* in[22]; float* out; unsigned char* ws; int ph_lo, ph_hi; };
struct Frame {
    LAS unsigned char* lds; volatile LAS unsigned* MISC; gu32* ctl;
    int tid, lane, wave, vcu, G;
};
#define XB_TMO      128
#define XB_XCNT(j)  (256  + 64 * (j))
#define XB_XSUB(j)  (1280 + 64 * (j))
#define XB_XGEN(j)  (2304 + 64 * (j))
#define XB_TOP      3328
#define XB_TOPGEN   3392
#define XCD_BAR_WORDS 3456
#define XB_SPIN_CAP (1u << 18)

__device__ __forceinline__ unsigned xb_ld(unsigned* p)              { return __hip_atomic_load(p, __ATOMIC_RELAXED, __HIP_MEMORY_SCOPE_AGENT); }
__device__ __forceinline__ unsigned xb_add(unsigned* p, unsigned v) { return __hip_atomic_fetch_add(p, v, __ATOMIC_RELAXED, __HIP_MEMORY_SCOPE_AGENT); }
__device__ __forceinline__ unsigned xb_xcc_id() { return (unsigned)__builtin_amdgcn_s_getreg((3 << 11) | 20) & 0xFu; }
#define XB_SPIN(cond, bar) do { unsigned _sp = 0; while (cond) { __builtin_amdgcn_s_sleep(1); \
    if ((++_sp & 255u) == 0u) { if (xb_ld(&(bar)[XB_TMO])) break; if (_sp > XB_SPIN_CAP) { atomicAdd(&(bar)[XB_TMO], 1u); break; } } } } while (0)

struct XcdBarrier {
    unsigned* bar; unsigned x;
    volatile LAS unsigned* st;
};

__device__ __forceinline__ XcdBarrier xcd_barrier_post(unsigned* bar, volatile LAS unsigned* st) {
    XcdBarrier b; b.bar = bar; b.x = xb_xcc_id(); b.st = st;
    if (threadIdx.x == 0) (void)xb_add(&bar[XB_XCNT(b.x)], 1u);
    return b;
}
__device__ __forceinline__ void xcd_barrier_complete(unsigned* bar, unsigned x, unsigned& nloc, unsigned& nx) {
    const unsigned G = gridDim.x * gridDim.y * gridDim.z;
    unsigned sum, cnt, mine, sp = 0u;
    for (;;) {
        sum = 0u; cnt = 0u; mine = 0u;
#pragma unroll
        for (unsigned j = 0; j < 16; ++j) { const unsigned c = xb_ld(&bar[XB_XCNT(j)]); sum += c; cnt += (c > 0u) ? 1u : 0u; mine = (j == x) ? c : mine; }
        if (sum == G) break;
        __builtin_amdgcn_s_sleep(1);
        if ((++sp & 255u) == 0u) { if (xb_ld(&bar[XB_TMO])) break; if (sp > XB_SPIN_CAP) { atomicAdd(&bar[XB_TMO], 1u); break; } }
    }
    nloc = mine > 0u ? mine : 1u; nx = cnt > 0u ? cnt : 1u;
}

__device__ __forceinline__ void xcd_barrier(const XcdBarrier& b) {
    asm volatile("s_waitcnt vmcnt(0)" ::: "memory");
    __syncthreads();
    if (threadIdx.x == 0) {
        unsigned* bar = b.bar;
        __builtin_amdgcn_s_waitcnt(0);
        unsigned nloc = b.st[0], nx = b.st[1];
        if (nloc == 0u) { xcd_barrier_complete(bar, b.x, nloc, nx); b.st[0] = nloc; b.st[1] = nx; }
        const unsigned old = xb_add(&bar[XB_XSUB(b.x)], 1u);
        const unsigned gen = old / nloc;
        if (old + 1u == (gen + 1u) * nloc) {
            __builtin_amdgcn_fence(__ATOMIC_RELEASE, "agent");
            asm volatile("s_waitcnt vmcnt(0)" ::: "memory");
            const unsigned og = xb_add(&bar[XB_TOP], 1u);
            const unsigned tg = og / nx;
            if (og + 1u == (tg + 1u) * nx) xb_add(&bar[XB_TOPGEN], 1u);
            else XB_SPIN(xb_ld(&bar[XB_TOPGEN]) == tg, bar);
            __builtin_amdgcn_fence(__ATOMIC_ACQUIRE, "agent");
            xb_add(&bar[XB_XGEN(b.x)], 1u);
            asm volatile("s_waitcnt vmcnt(0)" ::: "memory");
        } else {
            XB_SPIN(xb_ld(&bar[XB_XGEN(b.x)]) == gen, bar);
            __builtin_amdgcn_fence(__ATOMIC_ACQUIRE, "agent");
            asm volatile("s_waitcnt vmcnt(0)" ::: "memory");
        }
    }
    __syncthreads();
}

#define LDS_WAIT() asm volatile("s_waitcnt lgkmcnt(0)" ::: "memory")
__device__ __forceinline__ unsigned pk2(float lo, float hi) { return f2bf(lo) | (f2bf(hi) << 16); }
__device__ __forceinline__ float wave_sum(float v) {
#pragma unroll
    for (int o = 1; o < 64; o <<= 1) v += __shfl_xor(v, o);
    return v;
}
__device__ __forceinline__ void p0_transpose_item(const float* W, int K, int N, bf16* WT, const float* scale, LAS float* scr, int item, int lane) {
    const int nblk = N / 32, kb = item / nblk, nb = item % nblk, k0 = 64 * kb, n0 = 32 * nb;
#pragma unroll 8
    for (int i = 0; i < 32; ++i) { const int kk = 2 * i + (lane >> 5); float w = W[(size_t)(k0 + kk) * N + n0 + (lane & 31)]; if (scale) w *= scale[k0 + kk]; scr[kk * 33 + (lane & 31)] = w; }
    LDS_WAIT(); asm volatile("" ::: "memory");
    const int c = lane & 7;
#pragma unroll
    for (int j = 0; j < 4; ++j) { const int n = (lane >> 3) + 8 * j; const LAS float* s = scr + (8 * c) * 33 + n;
        v4u o; o.x = pk2(s[0 * 33], s[1 * 33]); o.y = pk2(s[2 * 33], s[3 * 33]); o.z = pk2(s[4 * 33], s[5 * 33]); o.w = pk2(s[6 * 33], s[7 * 33]);
        *(GAS v4u*)(WT + (size_t)(n0 + n) * K + k0 + 8 * c) = o; }
    LDS_WAIT(); asm volatile("" ::: "memory");
}
__device__ __forceinline__ void rms_row_to_bf16(const float* xrow, const float* gain, bf16* orow, int lane) {
    const GAS f32x4* xr = (const GAS f32x4*)xrow + lane; const GAS f32x4* gr = (const GAS f32x4*)gain + lane;
    f32x4 v[4]; float s = 0.f;
#pragma unroll
    for (int j = 0; j < 4; ++j) { v[j] = xr[64 * j]; s += (v[j].x * v[j].x + v[j].y * v[j].y) + (v[j].z * v[j].z + v[j].w * v[j].w); }
    const float rstd = rsqrtf(wave_sum(s) * (1.f / D) + EPS);
    GAS unsigned long long* o8 = (GAS unsigned long long*)orow + lane;
#pragma unroll
    for (int j = 0; j < 4; ++j) { const f32x4 g = gr[64 * j]; o8[64 * j] = (unsigned long long)pk2(v[j].x * rstd * g.x, v[j].y * rstd * g.y) | ((unsigned long long)pk2(v[j].z * rstd * g.z, v[j].w * rstd * g.w) << 32); }
}
__device__ __forceinline__ void p0_prologue(const Frame& F, const Args& args, unsigned char* ws) {
    LAS float* scr = (LAS float*)(F.lds + RING_OFF + F.wave * 16384);
    const int gw = F.vcu * NWAVES + F.wave, NGW = F.G * NWAVES;
    constexpr int I_A = (D / 64) * (NA / 32), I_OA = (GW / 64) * (D / 32), I_C = (D / 64) * (NC / 32), I_OC = I_OA, I_G = 16 * 8;
    constexpr int NITEMS = I_A + I_OA + I_C + I_OC + I_G;
    bf16* WaT = (bf16*)(ws + WS_WAT); bf16* WoaT = (bf16*)(ws + WS_WOAT); bf16* WcT = (bf16*)(ws + WS_WCT); bf16* WocT = (bf16*)(ws + WS_WOCT); bf16* WG = (bf16*)(ws + WS_WG);
    for (int it = gw; it < NITEMS; it += NGW) {
        int r = it;
        if (r < I_A) { p0_transpose_item(args.in[2], D, NA, WaT, nullptr, scr, r, F.lane); continue; } r -= I_A;
        if (r < I_OA) { p0_transpose_item(args.in[13], GW, D, WoaT, nullptr, scr, r, F.lane); continue; } r -= I_OA;
        if (r < I_C) { p0_transpose_item(args.in[16], D, NC, WcT, args.in[15], scr, r, F.lane); continue; } r -= I_C;
        if (r < I_OC) { p0_transpose_item(args.in[21], GW, D, WocT, nullptr, scr, r, F.lane); continue; } r -= I_OC;
        { const int mat = r >> 3, sub = r & 7, n = mat >> 1, gate = mat & 1;
          p0_transpose_item((gate ? args.in[7] : args.in[5]) + (size_t)n * 16384, 128, 128, WG + (size_t)mat * 16384, nullptr, scr, sub, F.lane); }
    }
    { float* btab = (float*)(ws + WS_BIAS); const int gt = F.vcu * (NWAVES * 64) + F.tid;
      if (gt < 16 * 128) { const int d = gt & 127, h = gt >> 7; int bk;
          if (d < 16) bk = d; else { bk = 16 + (int)(logf((float)d / 16.f) / logf(8.f) * 16.f); if (bk > 31) bk = 31; }
          btab[gt] = args.in[14][bk * 16 + h]; } }
    bf16* h0 = (bf16*)args.out;
    for (int m = gw; m < M; m += NGW) rms_row_to_bf16(args.in[0] + (size_t)m * D, args.in[1], h0 + (size_t)m * D, F.lane);
}

typedef float f32x16 __attribute__((ext_vector_type(16)));
constexpr int P5_VSTRIDE = 272;
constexpr int P5_VT = 0, P5_W = 256 * P5_VSTRIDE, P5_ST = P5_W + 128 * P5_VSTRIDE;
static_assert(P5_ST + 5 * 128 * 4 <= RING_BYTES, "P5 LDS map");
__device__ __forceinline__ void p5_gate(const Frame& F, const Args& args, unsigned char* ws) {
    LAS unsigned char* L = F.lds + RING_OFF;
    LAS float* mu = (LAS float*)(L + P5_ST); LAS float* rs = mu + 128; LAS float* A1 = mu + 256; LAS float* A2 = mu + 384; LAS float* bb = mu + 512;
    bf16* U = (bf16*)(ws + WS_U); const bf16* V = (const bf16*)(ws + WS_V); const bf16* G = (const bf16*)(ws + WS_G); const float* vst = (const float*)(ws + WS_VST);
    const float* lg = args.in[17]; const float* lb = args.in[18]; const float* sw = args.in[19]; const float* sb = args.in[20];
    const int tid = F.tid, lane = F.lane, w = F.wave, l31 = lane & 31, hi = lane >> 5;
    for (int ch = F.vcu; ch < M / 128; ch += F.G) {
        const int r0 = ch * 128;
        __syncthreads();
        { const int row = tid >> 2, part = tid & 3;
          const f32x4* p = (const f32x4*)(vst + ((size_t)(r0 + row) * 32 + part * 8) * 2);
          const f32x4 a = p[0], b = p[1], c = p[2], d = p[3];
          float s1 = ((a.x + a.z) + (b.x + b.z)) + ((c.x + c.z) + (d.x + d.z));
          float s2 = ((a.y + a.w) + (b.y + b.w)) + ((c.y + c.w) + (d.y + d.w));
          s1 += __shfl_xor(s1, 1); s1 += __shfl_xor(s1, 2); s2 += __shfl_xor(s2, 1); s2 += __shfl_xor(s2, 2);
          const float mean = s1 * (1.f / GW), var = s2 * (1.f / GW) - mean * mean;
          if (part == 0) { mu[row] = mean; rs[row] = rsqrtf(var + EPS); } }
        __syncthreads();
        for (int g = 0; g < 8; ++g) {
            { const int t = tid >> 2, seg = tid & 3; const float* wrow = sw + ((size_t)g * 128 + t) * 128 + 32 * seg; float a1 = 0.f, a2 = 0.f;
#pragma unroll
              for (int q = 0; q < 4; ++q) { const f32x4 w0 = *(const f32x4*)(wrow + 8 * q), w1 = *(const f32x4*)(wrow + 8 * q + 4);
                  const float wv[8] = {w0.x, w0.y, w0.z, w0.w, w1.x, w1.y, w1.z, w1.w}; float o[8];
#pragma unroll
                  for (int e = 0; e < 8; ++e) { const int s = 32 * seg + 8 * q + e; const float wm = (s <= t) ? wv[e] : 0.f; a2 += wm; const float wp = bfr(wm * rs[s]); a1 += wp * mu[s]; o[e] = wp; }
                  v4u pk; pk.x = pk2(o[0], o[1]); pk.y = pk2(o[2], o[3]); pk.z = pk2(o[4], o[5]); pk.w = pk2(o[6], o[7]);
                  *(LAS v4u*)(L + P5_W + t * P5_VSTRIDE + (32 * seg + 8 * q) * 2) = pk; }
              a1 += __shfl_xor(a1, 1); a1 += __shfl_xor(a1, 2); a2 += __shfl_xor(a2, 1); a2 += __shfl_xor(a2, 2);
              if (seg == 0) { A1[t] = a1; A2[t] = a2; bb[t] = sb[g * 128 + t]; } }
            { const int cgl = lane >> 4, spl = lane & 15;
#pragma unroll
              for (int i = 0; i < 4; ++i) { const int sp = 16 * i + spl;
                  const bf16* vp = V + (size_t)(r0 + 2 * sp) * GW + g * 256 + 32 * w + 8 * cgl;
                  const v4u v0 = *(const v4u*)vp, v1 = *(const v4u*)(vp + GW);
                  const unsigned a0[4] = {v0.x, v0.y, v0.z, v0.w}, a1_[4] = {v1.x, v1.y, v1.z, v1.w};
#pragma unroll
                  for (int e = 0; e < 8; ++e) { const unsigned lo = (e & 1) ? (a0[e >> 1] >> 16) : (a0[e >> 1] & 0xffffu), hi2 = (e & 1) ? (a1_[e >> 1] & 0xffff0000u) : (a1_[e >> 1] << 16);
                      *(LAS unsigned*)(L + P5_VT + (32 * w + 8 * cgl + e) * P5_VSTRIDE + sp * 4) = lo | hi2; } } }
            __syncthreads();
            f32x16 acc[4];
            { const int prow = 16 * ((l31 >> 2) & 1) + 4 * (l31 >> 3) + (l31 & 3);
              const LAS unsigned char* ap = L + P5_VT + (32 * w + prow) * P5_VSTRIDE + hi * 16;
              const LAS unsigned char* bp = L + P5_W + l31 * P5_VSTRIDE + hi * 16;
              bf16x8 af[8];
#pragma unroll
              for (int ks = 0; ks < 8; ++ks) af[ks] = *(const LAS bf16x8*)(ap + ks * 32);
#pragma unroll
              for (int j = 0; j < 4; ++j) { f32x16 a = {0.f, 0.f, 0.f, 0.f, 0.f, 0.f, 0.f, 0.f, 0.f, 0.f, 0.f, 0.f, 0.f, 0.f, 0.f, 0.f};
#pragma unroll
                  for (int ks = 0; ks < 2 * j + 2; ++ks) { const bf16x8 bfr_ = *(const LAS bf16x8*)(bp + j * 32 * P5_VSTRIDE + ks * 32); a = __builtin_amdgcn_mfma_f32_32x32x16_bf16(af[ks], bfr_, a, 0, 0, 0); }
                  acc[j] = a; } }
            __syncthreads();
            { const int c0 = g * 256 + 32 * w + 16 * hi;
              float gam[16], bet[16];
#pragma unroll
              for (int q = 0; q < 4; ++q) { const f32x4 a = *(const f32x4*)(lg + c0 + 4 * q), b = *(const f32x4*)(lb + c0 + 4 * q);
                  gam[4 * q] = a.x; gam[4 * q + 1] = a.y; gam[4 * q + 2] = a.z; gam[4 * q + 3] = a.w; bet[4 * q] = b.x; bet[4 * q + 1] = b.y; bet[4 * q + 2] = b.z; bet[4 * q + 3] = b.w; }
#pragma unroll
              for (int j = 0; j < 4; ++j) { const int t = 32 * j + l31; const float a1 = A1[t], a2 = A2[t], b0 = bb[t];
                  const size_t off = (size_t)(r0 + t) * GW + c0;
                  const v4u u0 = *(const v4u*)(U + off), u1 = *(const v4u*)(U + off + 8), g0 = *(const v4u*)(G + off), g1 = *(const v4u*)(G + off + 8);
                  const unsigned uu[8] = {u0.x, u0.y, u0.z, u0.w, u1.x, u1.y, u1.z, u1.w}, gg[8] = {g0.x, g0.y, g0.z, g0.w, g1.x, g1.y, g1.z, g1.w};
                  unsigned o[8];
#pragma unroll
                  for (int q = 0; q < 8; ++q) { float y[2];
#pragma unroll
                      for (int e = 0; e < 2; ++e) { const int r = 2 * q + e; const float uv = e ? bf2f(uu[q] >> 16) : bf2f(uu[q] & 0xffffu), gv = e ? bf2f(gg[q] >> 16) : bf2f(gg[q] & 0xffffu);
                          const float sg = gam[r] * (acc[j][r] - a1) + bet[r] * a2 + b0; y[e] = uv * sg * siluf_(gv); }
                      o[q] = pk2(y[0], y[1]); }
                  v4u o0, o1; o0.x = o[0]; o0.y = o[1]; o0.z = o[2]; o0.w = o[3]; o1.x = o[4]; o1.y = o[5]; o1.z = o[6]; o1.w = o[7];
                  *(v4u*)(U + off) = o0; *(v4u*)(U + off + 8) = o1; } }
        }
    }
}

typedef float f32x4_t __attribute__((ext_vector_type(4)));
constexpr int LR_XA = 0, LR_WB = 32768, LR_XF = 65536, LR_XFS = 68, LR_TOT = LR_XF + 128 * LR_XFS * 4;
static_assert(LR_TOT + 8 * 64 * 2 * 4 <= RING_BYTES, "LRU LDS map");
__device__ __forceinline__ void p2_lru(const Frame& F, const Args& args, unsigned char* ws) {
    LAS unsigned char* L = F.lds + RING_OFF;
    const bf16* z0 = (const bf16*)(ws + WS_Z0); bf16* y0 = (bf16*)(ws + WS_Y0); const bf16* WG = (const bf16*)(ws + WS_WG);
    const float* conv_w = args.in[3]; const float* conv_b = args.in[4]; const float* gab = args.in[6]; const float* gxb = args.in[8]; const float* lam = args.in[9];
    const int tid = F.tid, lane = F.lane, w = F.wave, q = lane >> 4, cc = lane & 15;
    for (int unit = F.vcu; unit < NB * 16; unit += F.G) {
        const int b = unit >> 4, n = (unit >> 1) & 7, hf = unit & 1;
        __syncthreads();
#pragma unroll
        for (int i = 0; i < 4; ++i) { const int idx = tid + 512 * i, ck = idx & 15, row = idx >> 4, gate = row >> 6, c = row & 63;
            const v4u v = *(const v4u*)(WG + ((size_t)(n * 2 + gate) * 128 + 64 * hf + c) * 128 + 8 * ck);
            *(LAS v4u*)(L + LR_WB + row * 256 + ((ck ^ (row & 15)) << 4)) = v; }
        const int cg = tid & 15, tq = tid >> 4, chc = n * 128 + 8 * cg;
        float cw[4][8], cb[8];
#pragma unroll
        for (int k = 0; k < 4; ++k) { const f32x4 a = *(const f32x4*)(conv_w + k * 1024 + chc), c2 = *(const f32x4*)(conv_w + k * 1024 + chc + 4);
            cw[k][0] = a.x; cw[k][1] = a.y; cw[k][2] = a.z; cw[k][3] = a.w; cw[k][4] = c2.x; cw[k][5] = c2.y; cw[k][6] = c2.z; cw[k][7] = c2.w; }
        { const f32x4 a = *(const f32x4*)(conv_b + chc), c2 = *(const f32x4*)(conv_b + chc + 4); cb[0] = a.x; cb[1] = a.y; cb[2] = a.z; cb[3] = a.w; cb[4] = c2.x; cb[5] = c2.y; cb[6] = c2.z; cb[7] = c2.w; }
        float ba[4], bx[4], sp[4], hprev[4];
#pragma unroll
        for (int ct = 0; ct < 4; ++ct) { const int ch = n * 128 + 64 * hf + 16 * ct + cc; ba[ct] = gab[ch]; bx[ct] = gxb[ch]; sp[ct] = 8.f * log1pf(expf(-lam[ch])); hprev[ct] = 0.f; }
        for (int chunk = 0; chunk < 16; ++chunk) {
            const int t0 = chunk * 128; const size_t rowb = (size_t)b * S + t0;
            { v4u zr[7];
#pragma unroll
              for (int i = 0; i < 7; ++i) { const int t = t0 + 4 * tq - 3 + i;
                  if (t >= 0) zr[i] = *(const v4u*)(z0 + ((size_t)b * S + t) * NA + chc); else zr[i] = (v4u){0u, 0u, 0u, 0u}; }
              float zf[7][8];
#pragma unroll
              for (int i = 0; i < 7; ++i) { const unsigned u4[4] = {zr[i].x, zr[i].y, zr[i].z, zr[i].w};
#pragma unroll
                  for (int e = 0; e < 8; ++e) zf[i][e] = (e & 1) ? bf2f(u4[e >> 1] >> 16) : bf2f(u4[e >> 1] & 0xffffu); }
#pragma unroll
              for (int r = 0; r < 4; ++r) { const int tok = 4 * tq + r; float xa[8];
#pragma unroll
                  for (int e = 0; e < 8; ++e) xa[e] = cb[e] + cw[0][e] * zf[r][e] + cw[1][e] * zf[r + 1][e] + cw[2][e] * zf[r + 2][e] + cw[3][e] * zf[r + 3][e];
                  v4u pk; pk.x = pk2(xa[0], xa[1]); pk.y = pk2(xa[2], xa[3]); pk.z = pk2(xa[4], xa[5]); pk.w = pk2(xa[6], xa[7]);
                  *(LAS v4u*)(L + LR_XA + tok * 256 + ((cg ^ (tok & 15)) << 4)) = pk;
                  if ((cg >> 3) == hf) { LAS float* xf = (LAS float*)(L + LR_XF) + tok * LR_XFS + 8 * (cg & 7);
                      *(LAS f32x4*)xf = (f32x4){xa[0], xa[1], xa[2], xa[3]}; *(LAS f32x4*)(xf + 4) = (f32x4){xa[4], xa[5], xa[6], xa[7]}; } } }
            float gav[4][4];
#pragma unroll
            for (int ct = 0; ct < 4; ++ct)
#pragma unroll
                for (int r = 0; r < 4; ++r) gav[ct][r] = bf2f(z0[(rowb + 16 * w + 4 * q + r) * NA + 1024 + n * 128 + 64 * hf + 16 * ct + cc]);
            __syncthreads();
            f32x4 acc[2][4];
#pragma unroll
            for (int g2 = 0; g2 < 2; ++g2)
#pragma unroll
                for (int ct = 0; ct < 4; ++ct) acc[g2][ct] = (f32x4){0.f, 0.f, 0.f, 0.f};
            { const int tok = 16 * w + cc;
#pragma unroll
              for (int ks = 0; ks < 4; ++ks) { const int ck = 4 * ks + q;
                  const bf16x8 af = *(const LAS bf16x8*)(L + LR_XA + tok * 256 + ((ck ^ (tok & 15)) << 4));
#pragma unroll
                  for (int g2 = 0; g2 < 2; ++g2)
#pragma unroll
                      for (int ct = 0; ct < 4; ++ct) { const int rb = g2 * 64 + 16 * ct + cc;
                          const bf16x8 bf_ = *(const LAS bf16x8*)(L + LR_WB + rb * 256 + ((ck ^ (rb & 15)) << 4));
                          acc[g2][ct] = __builtin_amdgcn_mfma_f32_16x16x32_bf16(af, bf_, acc[g2][ct], 0, 0, 0); } } }
            float Ai[4][4], Hi[4][4];
#pragma unroll
            for (int ct = 0; ct < 4; ++ct) { float ap = 1.f, hp = 0.f;
#pragma unroll
                for (int r = 0; r < 4; ++r) { const float rg = sigmoidf_(acc[0][ct][r] + ba[ct]), ig = sigmoidf_(acc[1][ct][r] + bx[ct]);
                    const float la = -sp[ct] * rg, a = __expf(la), x2 = 2.f * la;
                    const float em = x2 * (1.f + x2 * (0.5f + x2 * (0.16666667f + x2 * (0.041666668f + x2 * (0.0083333338f + x2 * 0.0013888889f)))));
                    const float xav = ((const LAS float*)(L + LR_XF))[(16 * w + 4 * q + r) * LR_XFS + 16 * ct + cc];
                    const float bt = sqrtf(fmaxf(-em, 0.f)) * ig * xav;
                    ap *= a; hp = a * hp + bt; Ai[ct][r] = ap; Hi[ct][r] = hp; } }
            float PA[4], PH[4], WA[4], WH[4];
#pragma unroll
            for (int ct = 0; ct < 4; ++ct) { float pa = 1.f, ph = 0.f, wa = 1.f, wh = 0.f;
#pragma unroll
                for (int qq = 0; qq < 4; ++qq) { const float ta = __shfl(Ai[ct][3], qq * 16 + cc), th = __shfl(Hi[ct][3], qq * 16 + cc);
                    if (qq < q) { ph = ta * ph + th; pa = ta * pa; }
                    wh = ta * wh + th; wa = ta * wa; }
                PA[ct] = pa; PH[ct] = ph; WA[ct] = wa; WH[ct] = wh; }
            if (q == 0) {
#pragma unroll
                for (int ct = 0; ct < 4; ++ct) { LAS float* tp = (LAS float*)(L + LR_TOT) + (w * 64 + 16 * ct + cc) * 2; tp[0] = WA[ct]; tp[1] = WH[ct]; } }
            __syncthreads();
#pragma unroll
            for (int ct = 0; ct < 4; ++ct) { float hin = hprev[ct], hall = hprev[ct];
#pragma unroll
                for (int ww = 0; ww < 8; ++ww) { const LAS float* tp = (const LAS float*)(L + LR_TOT) + (ww * 64 + 16 * ct + cc) * 2; const float ta = tp[0], th = tp[1];
                    if (ww < w) hin = ta * hin + th;
                    hall = ta * hall + th; }
                hprev[ct] = hall;
                const float hl = PA[ct] * hin + PH[ct];
#pragma unroll
                for (int r = 0; r < 4; ++r) { const float h = Ai[ct][r] * hl + Hi[ct][r];
                    y0[(rowb + 16 * w + 4 * q + r) * GW + n * 128 + 64 * hf + 16 * ct + cc] = (bf16)f2bf(h * siluf_(gav[ct][r])); } }
        }
    }
}

constexpr int AT_KS = 0, AT_VT = 32768, AT_VSTRIDE = 528, AT_BL = AT_VT + 64 * AT_VSTRIDE;
static_assert(AT_BL + 8 * 192 * 4 <= RING_BYTES, "attention LDS map");
__device__ __forceinline__ int crow(int r, int hi) { return (r & 3) + 8 * (r >> 2) + 4 * hi; }
__device__ __forceinline__ void p2_attn(const Frame& F, const Args& args, unsigned char* ws) {
    LAS unsigned char* L = F.lds + RING_OFF;
    const bf16* z0 = (const bf16*)(ws + WS_Z0); bf16* y0 = (bf16*)(ws + WS_Y0); const float* btab = (const float*)(ws + WS_BIAS);
    const float* qg = args.in[10]; const float* kg = args.in[11]; const float* sinks = args.in[12];
    const int tid = F.tid, lane = F.lane, w = F.wave, l31 = lane & 31, hi = lane >> 5;
    for (int unit = F.vcu; unit < NB * 16 * 2; unit += F.G) {
        const int kh = unit & 1, qb = (unit >> 1) & 15, b = unit >> 5;
        const long tk0 = (long)qb * 128 - 128;
        __syncthreads();
#pragma unroll
        for (int i = 0; i < 4; ++i) { const int idx = tid + 512 * i, c = idx & 7, j = idx >> 3; const long tk = tk0 + j;
            v4u kv = (v4u){0u, 0u, 0u, 0u};
            if (tk >= 0) kv = *(const v4u*)(z0 + ((size_t)b * S + tk) * NA + 3072 + kh * 64 + 8 * c);
            const unsigned u4[4] = {kv.x, kv.y, kv.z, kv.w}; float kf[8], ss = 0.f;
#pragma unroll
            for (int e = 0; e < 8; ++e) { kf[e] = (e & 1) ? bf2f(u4[e >> 1] >> 16) : bf2f(u4[e >> 1] & 0xffffu); ss += kf[e] * kf[e]; }
            ss += __shfl_xor(ss, 1); ss += __shfl_xor(ss, 2); ss += __shfl_xor(ss, 4);
            const float rk = rsqrtf(ss * (1.f / 64.f) + EPS);
            const f32x4 g0 = *(const f32x4*)(kg + 8 * c), g1 = *(const f32x4*)(kg + 8 * c + 4);
            v4u pk; pk.x = pk2(kf[0] * rk * g0.x, kf[1] * rk * g0.y); pk.y = pk2(kf[2] * rk * g0.z, kf[3] * rk * g0.w); pk.z = pk2(kf[4] * rk * g1.x, kf[5] * rk * g1.y); pk.w = pk2(kf[6] * rk * g1.z, kf[7] * rk * g1.w);
            *(LAS v4u*)(L + AT_KS + c * 4096 + j * 16) = pk; }
        { const int cl = lane >> 4, jl = lane & 15;
#pragma unroll
          for (int i = 0; i < 2; ++i) { const int jp = 16 * w + jl, c = 4 * i + cl; const long tk = tk0 + 2 * jp;
              v4u v0 = (v4u){0u, 0u, 0u, 0u}, v1 = (v4u){0u, 0u, 0u, 0u};
              if (tk >= 0) { const bf16* vp = z0 + ((size_t)b * S + tk) * NA + 3200 + kh * 64 + 8 * c; v0 = *(const v4u*)vp; v1 = *(const v4u*)(vp + NA); }
              const unsigned a0[4] = {v0.x, v0.y, v0.z, v0.w}, a1[4] = {v1.x, v1.y, v1.z, v1.w};
#pragma unroll
              for (int e = 0; e < 8; ++e) { const unsigned lo = (e & 1) ? (a0[e >> 1] >> 16) : (a0[e >> 1] & 0xffffu), hi2 = (e & 1) ? (a1[e >> 1] & 0xffff0000u) : (a1[e >> 1] << 16);
                  *(LAS unsigned*)(L + AT_VT + (8 * c + e) * AT_VSTRIDE + jp * 4) = lo | hi2; } } }
#pragma unroll
        for (int i = 0; i < 3; ++i) { const int idx = tid + 512 * i, hh = idx / 192, e = idx - hh * 192, dist = e - 32;
            ((LAS float*)(L + AT_BL))[idx] = (dist >= 0 && dist < 128) ? btab[(kh * 8 + hh) * 128 + dist] : -INFINITY; }
        __syncthreads();
        const int qt = w & 3;
        for (int ti = 0; ti < 4; ++ti) {
            const int g = (w >> 2) + 2 * ti, hq = kh * 8 + g;
            const size_t R = (size_t)b * S + qb * 128 + 32 * qt + l31;
            bf16x8 qf[4];
            { v4u qr[4]; float ss = 0.f; float qv[4][8];
#pragma unroll
              for (int ds = 0; ds < 4; ++ds) qr[ds] = *(const v4u*)(z0 + R * NA + 2048 + hq * 64 + 16 * ds + 8 * hi);
#pragma unroll
              for (int ds = 0; ds < 4; ++ds) { const unsigned u4[4] = {qr[ds].x, qr[ds].y, qr[ds].z, qr[ds].w};
#pragma unroll
                  for (int e = 0; e < 8; ++e) { qv[ds][e] = (e & 1) ? bf2f(u4[e >> 1] >> 16) : bf2f(u4[e >> 1] & 0xffffu); ss += qv[ds][e] * qv[ds][e]; } }
              ss += __shfl_xor(ss, 32);
              const float rq = rsqrtf(ss * (1.f / 64.f) + EPS) * 0.125f;
#pragma unroll
              for (int ds = 0; ds < 4; ++ds) { const f32x4 g0 = *(const f32x4*)(qg + 16 * ds + 8 * hi), g1 = *(const f32x4*)(qg + 16 * ds + 8 * hi + 4);
                  v4u pk; pk.x = pk2(qv[ds][0] * rq * g0.x, qv[ds][1] * rq * g0.y); pk.y = pk2(qv[ds][2] * rq * g0.z, qv[ds][3] * rq * g0.w);
                  pk.z = pk2(qv[ds][4] * rq * g1.x, qv[ds][5] * rq * g1.y); pk.w = pk2(qv[ds][6] * rq * g1.z, qv[ds][7] * rq * g1.w);
                  qf[ds] = __builtin_bit_cast(bf16x8, pk); } }
            f32x16 sc[5];
            const float sink = sinks[hq]; float m = sink;
            const LAS float* bl = (const LAS float*)(L + AT_BL) + g * 192 + (l31 - 4 * hi);
#pragma unroll
            for (int kk = 0; kk < 5; ++kk) { f32x16 a;
                if (qb == 0 && qt + kk < 4) {
#pragma unroll
                    for (int r = 0; r < 16; ++r) a[r] = -INFINITY;
                } else {
#pragma unroll
                    for (int r = 0; r < 16; ++r) a[r] = 0.f;
#pragma unroll
                    for (int ds = 0; ds < 4; ++ds) { const bf16x8 kf = *(const LAS bf16x8*)(L + AT_KS + (2 * ds + hi) * 4096 + (32 * (qt + kk) + l31) * 16);
                        a = __builtin_amdgcn_mfma_f32_32x32x16_bf16(kf, qf[ds], a, 0, 0, 0); }
#pragma unroll
                    for (int r = 0; r < 16; ++r) { const float v = a[r] + bl[160 - 32 * kk - (r & 3) - 8 * (r >> 2)]; a[r] = v; m = fmaxf(m, v); }
                }
                sc[kk] = a;
                __builtin_amdgcn_sched_barrier(0); }
            m = fmaxf(m, __shfl_xor(m, 32));
            float sum = 0.f;
#pragma unroll
            for (int kk = 0; kk < 5; ++kk)
#pragma unroll
                for (int r = 0; r < 16; ++r) { const float p = __expf(sc[kk][r] - m); sc[kk][r] = p; sum += p; }
            sum += __shfl_xor(sum, 32);
            const float inv = 1.f / (sum + __expf(sink - m));
            f32x16 o[2];
            o[0] = (f32x16){0.f, 0.f, 0.f, 0.f, 0.f, 0.f, 0.f, 0.f, 0.f, 0.f, 0.f, 0.f, 0.f, 0.f, 0.f, 0.f}; o[1] = o[0];
#pragma unroll
            for (int kk = 0; kk < 5; ++kk)
#pragma unroll
                for (int s = 0; s < 2; ++s) { v4u pk; pk.x = pk2(sc[kk][8 * s], sc[kk][8 * s + 1]); pk.y = pk2(sc[kk][8 * s + 2], sc[kk][8 * s + 3]); pk.z = pk2(sc[kk][8 * s + 4], sc[kk][8 * s + 5]); pk.w = pk2(sc[kk][8 * s + 6], sc[kk][8 * s + 7]);
                    const bf16x8 pf = __builtin_bit_cast(bf16x8, pk);
#pragma unroll
                    for (int dt = 0; dt < 2; ++dt) { const LAS unsigned char* vp = L + AT_VT + (32 * dt + l31) * AT_VSTRIDE + (32 * (qt + kk) + 16 * s + 4 * hi) * 2;
                        const unsigned long long lo = *(const LAS unsigned long long*)vp, hi8 = *(const LAS unsigned long long*)(vp + 16);
                        v4u vv; vv.x = (unsigned)lo; vv.y = (unsigned)(lo >> 32); vv.z = (unsigned)hi8; vv.w = (unsigned)(hi8 >> 32);
                        o[dt] = __builtin_amdgcn_mfma_f32_32x32x16_bf16(__builtin_bit_cast(bf16x8, vv), pf, o[dt], 0, 0, 0); } }
            __builtin_amdgcn_sched_barrier(0);
#pragma unroll
            for (int dt = 0; dt < 2; ++dt)
#pragma unroll
                for (int k = 0; k < 4; ++k) { const unsigned long long gv = *(const unsigned long long*)(z0 + R * NA + 3328 + hq * 64 + 32 * dt + 8 * k + 4 * hi); float y[4];
#pragma unroll
                    for (int e = 0; e < 4; ++e) { const float gf = bf2f((unsigned)(gv >> (16 * e)) & 0xffffu); y[e] = o[dt][4 * k + e] * inv * siluf_(gf); }
                    const unsigned long long ov = (unsigned long long)pk2(y[0], y[1]) | ((unsigned long long)pk2(y[2], y[3]) << 32);
                    *(unsigned long long*)(y0 + R * GW + 1024 + hq * 64 + 32 * dt + 8 * k + 4 * hi) = ov; }
        }
    }
}

__global__ void __launch_bounds__(NWAVES * 64, 2) mega(Args args) {
    extern __shared__ __attribute__((aligned(16))) unsigned char lds[];
    Frame F;
    F.lds = (LAS unsigned char*)lds;
    F.MISC = (volatile LAS unsigned*)(F.lds + MISC_OFF);
    F.tid = threadIdx.x; F.lane = F.tid & 63; F.wave = __builtin_amdgcn_readfirstlane(F.tid >> 6);
    F.G = gridDim.x; { const int bx = blockIdx.x; F.vcu = (F.G % 8 == 0) ? (bx % 8) * (F.G / 8) + bx / 8 : bx; }
    unsigned char* ws = args.ws;
    F.ctl = (gu32*)(ws + WS_CTL);
    for (int u = F.tid; u < (LDS_BYTES - LDSCTL_OFF) / 4; u += NWAVES * 64) ((LAS unsigned*)(F.lds + LDSCTL_OFF))[u] = 0u;
    __syncthreads();
    const int lo = args.ph_lo, hi = args.ph_hi;
    const bool multi = (hi - lo) > 1;
    XcdBarrier bar; bar.bar = (unsigned*)(F.ctl + CW_BAR); bar.x = 0; bar.st = nullptr;
    if (multi) bar = xcd_barrier_post((unsigned*)(F.ctl + CW_BAR), F.MISC + 8);
#define IN(k) (lo <= (k) && (k) < hi)
#define BOTH(k) (IN(k) && IN((k) + 1))
#define GRID_BAR() xcd_barrier(bar)
    bf16* WaT = (bf16*)(ws + WS_WAT); bf16* WoaT = (bf16*)(ws + WS_WOAT); bf16* WcT = (bf16*)(ws + WS_WCT); bf16* WocT = (bf16*)(ws + WS_WOCT);
    float* ssq = (float*)(ws + WS_SSQ); float* vst = (float*)(ws + WS_VST);
    bf16* z0 = (bf16*)(ws + WS_Z0); bf16* y0 = (bf16*)(ws + WS_Y0); bf16* x1b = (bf16*)(ws + WS_X1B); bf16* U = (bf16*)(ws + WS_U);
    bf16* h0 = (bf16*)args.out;

    if (IN(0)) { p0_prologue(F, args, ws); if (BOTH(0)) GRID_BAR(); }
    if (IN(1)) {
        pg8::Gemm g{h0, WaT, M, NA, D}; pg8::StaticOrder So; So.init(M, NA, F.G, (int)blockIdx.x);
        pg8::EpiZ0 E{z0, NA};
        pg8::gemm_phase<pg8::EpiZ0, pg8::StaticOrder, true, true>(F.lds + RING_OFF, g, So, E);
        if (BOTH(1)) GRID_BAR();
    }
    if (IN(2)) { p2_lru(F, args, ws); p2_attn(F, args, ws); if (BOTH(2)) GRID_BAR(); }
    if (IN(3)) {
        pg8::Gemm g{y0, WoaT, M, D, GW}; pg8::StaticOrder So; So.init(M, D, F.G, (int)blockIdx.x);
        pg8::EpiRes1 E{args.in[0], args.out, x1b, ssq};
        pg8::gemm_phase<pg8::EpiRes1, pg8::StaticOrder, true, true>(F.lds + RING_OFF, g, So, E);
        if (BOTH(3)) GRID_BAR();
    }
    if (IN(4)) {
        pg8::Gemm g{x1b, WcT, M, NC, D}; pg8::StaticOrder So; So.init(M, NC, F.G, (int)blockIdx.x);
        pg8::EpiZ1 E{U, (size_t)(WS_V - WS_U) / 2, ssq, vst};
        pg8::gemm_phase<pg8::EpiZ1, pg8::StaticOrder, true, true>(F.lds + RING_OFF, g, So, E);
        if (BOTH(4)) GRID_BAR();
    }
    if (IN(5)) { p5_gate(F, args, ws); if (BOTH(5)) GRID_BAR(); }
    if (IN(6)) {
        pg8::Gemm g{U, WocT, M, D, GW}; pg8::StaticOrder So; So.init(M, D, F.G, (int)blockIdx.x);
        pg8::EpiRes3 E{args.out};
        pg8::gemm_phase<pg8::EpiRes3, pg8::StaticOrder, true, true>(F.lds + RING_OFF, g, So, E);
    }
#undef IN
#undef BOTH
}

__global__ void k_transpose(const float* __restrict__ W, const float* __restrict__ scale, bf16* __restrict__ Wt, int K, int N) {
    __shared__ float t[32][33];
    const int k0 = blockIdx.y * 32, n0 = blockIdx.x * 32, tx = threadIdx.x & 31, ty = threadIdx.x >> 5;
    for (int i = ty; i < 32; i += 8) t[i][tx] = W[(size_t)(k0 + i) * N + n0 + tx] * (scale ? scale[k0 + i] : 1.f);
    __syncthreads();
    for (int i = ty; i < 32; i += 8) Wt[(size_t)(n0 + i) * K + k0 + tx] = (bf16)f2bf(t[tx][i]);
}
__global__ void k_gatew(const float* __restrict__ wa, const float* __restrict__ wx, bf16* __restrict__ WG) {
    const int idx = blockIdx.x * 256 + threadIdx.x;
    const int k = idx & 127, c = (idx >> 7) & 127, g = (idx >> 14) & 1, n = idx >> 15;
    const float* w = g ? wx : wa;
    WG[idx] = (bf16)f2bf(w[(size_t)n * 16384 + k * 128 + c]);
}
__global__ void k_biastab(const float* __restrict__ rel_bias, float* __restrict__ tab) {
    const int idx = blockIdx.x * 256 + threadIdx.x;
    const int d = idx & 127, h = idx >> 7;
    int bk;
    if (d < 16) bk = d; else { bk = 16 + (int)(logf((float)d / 16.f) / logf(8.f) * 16.f); if (bk > 31) bk = 31; }
    tab[idx] = rel_bias[bk * 16 + h];
}
__global__ void k_rms_h0(const float* __restrict__ x, const float* __restrict__ g, bf16* __restrict__ h0) {
    const int row = blockIdx.x * 4 + (threadIdx.x >> 6), lane = threadIdx.x & 63;
    const float* xr = x + (size_t)row * D;
    float v[16], s = 0.f;
#pragma unroll
    for (int j = 0; j < 16; ++j) { v[j] = xr[lane + 64 * j]; s += v[j] * v[j]; }
#pragma unroll
    for (int o = 1; o < 64; o <<= 1) s += __shfl_xor(s, o);
    const float rstd = rsqrtf(s / D + EPS);
#pragma unroll
    for (int j = 0; j < 16; ++j) h0[(size_t)row * D + lane + 64 * j] = (bf16)f2bf(v[j] * rstd * g[lane + 64 * j]);
}
__global__ void k_ssq(const float* __restrict__ x1, float* __restrict__ ssq) {
    const int row = blockIdx.x * 4 + (threadIdx.x >> 6), lane = threadIdx.x & 63;
    const float* xr = x1 + (size_t)row * D;
    float s = 0.f;
#pragma unroll
    for (int j = 0; j < 16; ++j) { const float v = xr[lane + 64 * j]; s += v * v; }
#pragma unroll
    for (int o = 1; o < 64; o <<= 1) s += __shfl_xor(s, o);
    if (lane < 16) ssq[(size_t)row * 16 + lane] = lane == 0 ? s : 0.f;
}
__global__ void k_vfin(const float* __restrict__ vpart, float* __restrict__ vst) {
    const int row = blockIdx.x * 4 + (threadIdx.x >> 6), lane = threadIdx.x & 63;
    float s = lane < 32 ? vpart[((size_t)row * 32 + lane) * 2] : 0.f, q = lane < 32 ? vpart[((size_t)row * 32 + lane) * 2 + 1] : 0.f;
#pragma unroll
    for (int o = 1; o < 64; o <<= 1) { s += __shfl_xor(s, o); q += __shfl_xor(q, o); }
    const float mean = s / GW, var = q / GW - mean * mean;
    if (lane == 0) { vst[row * 2] = mean; vst[row * 2 + 1] = rsqrtf(var + EPS); }
}

__global__ void __launch_bounds__(128) k_lru(const bf16* __restrict__ z0, const float* __restrict__ conv_w, const float* __restrict__ conv_b, const bf16* __restrict__ WG,
                                             const float* __restrict__ ba, const float* __restrict__ bx, const float* __restrict__ lam, bf16* __restrict__ y0) {
    __shared__ float xs[128];
    const int b = blockIdx.x >> 3, n = blockIdx.x & 7, c = threadIdx.x, ch = n * 128 + c;
    const float w0 = conv_w[ch], w1 = conv_w[1024 + ch], w2 = conv_w[2048 + ch], w3 = conv_w[3072 + ch], cb = conv_b[ch];
    const float bac = ba[ch], bxc = bx[ch];
    const float sp = log1pf(expf(-lam[ch]));
    const bf16* wa = WG + ((size_t)(n * 2 + 0) * 128 + c) * 128;
    const bf16* wx = WG + ((size_t)(n * 2 + 1) * 128 + c) * 128;
    float z1 = 0.f, z2 = 0.f, z3 = 0.f, h = 0.f;
    for (int t = 0; t < S; ++t) {
        const size_t row = (size_t)b * S + t;
        const float zt = bf2f(z0[row * NA + ch]);
        const float xa = w0 * z3 + w1 * z2 + w2 * z1 + w3 * zt + cb;
        z3 = z2; z2 = z1; z1 = zt;
        __syncthreads();
        xs[c] = bfr(xa);
        __syncthreads();
        float ra = 0.f, rx = 0.f;
        for (int k = 0; k < 128; ++k) { const float xv = xs[k]; ra += xv * bf2f(wa[k]); rx += xv * bf2f(wx[k]); }
        const float r = sigmoidf_(ra + bac), ig = sigmoidf_(rx + bxc);
        const float log_a = -8.f * r * sp;
        const float a = expf(log_a), mult = sqrtf(-expm1f(2.f * log_a));
        h = a * h + mult * ig * xa;
        const float ga = bf2f(z0[row * NA + 1024 + ch]);
        y0[row * GW + ch] = (bf16)f2bf(h * siluf_(ga));
    }
}

__global__ void __launch_bounds__(64) k_attn(const bf16* __restrict__ z0, const float* __restrict__ qg, const float* __restrict__ kg, const float* __restrict__ sinks,
                                             const float* __restrict__ btab, bf16* __restrict__ y0) {
    const int idx = blockIdx.x * 64 + threadIdx.x;
    const int hq = idx & 15, row = idx >> 4, t = row & (S - 1), kh = hq >> 3;
    const bf16* qp = z0 + (size_t)row * NA + 2048 + hq * 64;
    float q[64], ss = 0.f;
#pragma unroll
    for (int d = 0; d < 64; ++d) { q[d] = bf2f(qp[d]); ss += q[d] * q[d]; }
    const float rq = rsqrtf(ss / 64.f + EPS);
#pragma unroll
    for (int d = 0; d < 64; ++d) q[d] = bfr(q[d] * rq * qg[d]);
    float acc[64];
#pragma unroll
    for (int d = 0; d < 64; ++d) acc[d] = 0.f;
    float m = sinks[hq], l = 1.f;
    const int j0 = t - 127 < 0 ? 0 : t - 127;
    for (int j = j0; j <= t; ++j) {
        const size_t krow = (size_t)(row - t + j);
        const bf16* kp = z0 + krow * NA + 3072 + kh * 64;
        const bf16* vp = z0 + krow * NA + 3200 + kh * 64;
        float ks = 0.f;
#pragma unroll
        for (int d = 0; d < 64; ++d) { const float kv = bf2f(kp[d]); ks += kv * kv; }
        const float rk = rsqrtf(ks / 64.f + EPS);
        float dp = 0.f;
#pragma unroll
        for (int d = 0; d < 64; ++d) dp += q[d] * bfr(bf2f(kp[d]) * rk * kg[d]);
        const float sc = dp * 0.125f + btab[hq * 128 + (t - j)];
        const float mn = fmaxf(m, sc), f = __expf(m - mn), p = __expf(sc - mn);
        l = l * f + p; m = mn;
#pragma unroll
        for (int d = 0; d < 64; ++d) acc[d] = acc[d] * f + p * bf2f(vp[d]);
    }
    const float il = 1.f / l;
    const bf16* gp = z0 + (size_t)row * NA + 3328 + hq * 64;
    bf16* op = y0 + (size_t)row * GW + 1024 + hq * 64;
#pragma unroll
    for (int d = 0; d < 64; ++d) op[d] = (bf16)f2bf(acc[d] * il * siluf_(bf2f(gp[d])));
}

__global__ void __launch_bounds__(256) k_gate(bf16* __restrict__ U, const bf16* __restrict__ V, const bf16* __restrict__ G, const float* __restrict__ vst,
                                              const float* __restrict__ lg, const float* __restrict__ lb, const float* __restrict__ sw, const float* __restrict__ sb) {
    const int row = blockIdx.y, c = blockIdx.x * 256 + threadIdx.x, grp = c >> 8, tt = row & 127, r0 = row - tt;
    const float gam = lg[c], bet = lb[c];
    const float* w = sw + ((size_t)grp * 128 + tt) * 128;
    float acc = 0.f;
    for (int s = 0; s <= tt; ++s) {
        const float v = bf2f(V[(size_t)(r0 + s) * GW + c]);
        const float ln = (v - vst[(r0 + s) * 2]) * vst[(r0 + s) * 2 + 1] * gam + bet;
        acc += w[s] * ln;
    }
    const float sg = acc + sb[grp * 128 + tt];
    const size_t o = (size_t)row * GW + c;
    U[o] = (bf16)f2bf(bf2f(U[o]) * sg * siluf_(bf2f(G[o])));
}


static void launch_mega(const Args& a0, int lo, int hi, int grid, hipStream_t stream) {
    Args a = a0; a.ph_lo = lo; a.ph_hi = hi;
    hipLaunchKernelGGL(mega, dim3(grid), dim3(NWAVES * 64), LDS_BYTES, stream, a);
    const hipError_t le = hipPeekAtLastError();
    if (le != hipSuccess) fprintf(stderr, "kernel_launch: mega launch [%d,%d) failed: %s\n", lo, hi, hipGetErrorName(le));
}

extern "C" void kernel_launch(void* const* d_in, const int* in_sizes, int n_in, void* d_out, int out_size, void* d_ws, size_t ws_size, hipStream_t stream) {
    static int grid = 0;
    if (grid == 0) {
        if (n_in != 22 || in_sizes[0] != M * D || out_size != M * D || ws_size < WS_END) {
            fprintf(stderr, "kernel_launch: unexpected shapes: n_in %d in0 %d out %d ws %zu\n", n_in, n_in > 0 ? in_sizes[0] : -1, out_size, ws_size); grid = -1; return; }
        int dev = 0, cus = 0, per_cu = 0;
        if (hipGetDevice(&dev) != hipSuccess || hipDeviceGetAttribute(&cus, hipDeviceAttributeMultiprocessorCount, dev) != hipSuccess) { fprintf(stderr, "kernel_launch: device query failed\n"); grid = -1; return; }
        if (hipFuncSetAttribute((const void*)mega, hipFuncAttributeMaxDynamicSharedMemorySize, LDS_BYTES) != hipSuccess) { fprintf(stderr, "kernel_launch: hipFuncSetAttribute failed\n"); grid = -1; return; }
        if (hipOccupancyMaxActiveBlocksPerMultiprocessor(&per_cu, (const void*)mega, NWAVES * 64, LDS_BYTES) != hipSuccess || per_cu < 1)
            fprintf(stderr, "kernel_launch: note: occupancy query reports %d workgroups per CU\n", per_cu);
        (void)hipGetLastError();
        grid = cus;
    }
    if (grid < 0) return;
    const float* x = (const float*)d_in[0]; const float* norm_a = (const float*)d_in[1]; const float* w_in_a = (const float*)d_in[2];
    const float* conv_w = (const float*)d_in[3]; const float* conv_b = (const float*)d_in[4]; const float* gate_a_w = (const float*)d_in[5];
    const float* gate_a_b = (const float*)d_in[6]; const float* gate_x_w = (const float*)d_in[7]; const float* gate_x_b = (const float*)d_in[8];
    const float* lru_lambda = (const float*)d_in[9]; const float* q_norm_g = (const float*)d_in[10]; const float* k_norm_g = (const float*)d_in[11];
    const float* sinks = (const float*)d_in[12]; const float* w_out_a = (const float*)d_in[13]; const float* rel_bias = (const float*)d_in[14];
    const float* norm_c = (const float*)d_in[15]; const float* w_in_c = (const float*)d_in[16]; const float* ln_v_g = (const float*)d_in[17];
    const float* ln_v_b = (const float*)d_in[18]; const float* spatial_w = (const float*)d_in[19]; const float* spatial_b = (const float*)d_in[20];
    const float* w_out_c = (const float*)d_in[21];
    unsigned char* ws = (unsigned char*)d_ws; float* out = (float*)d_out;
    float* btab = (float*)(ws + WS_BIAS); bf16* WaT = (bf16*)(ws + WS_WAT); bf16* WoaT = (bf16*)(ws + WS_WOAT); bf16* WcT = (bf16*)(ws + WS_WCT); bf16* WocT = (bf16*)(ws + WS_WOCT);
    bf16* WG = (bf16*)(ws + WS_WG); float* vst = (float*)(ws + WS_VST); float* vfin = (float*)(ws + WS_VFIN);
    bf16* z0 = (bf16*)(ws + WS_Z0); bf16* y0 = (bf16*)(ws + WS_Y0);
    bf16* U = (bf16*)(ws + WS_U); bf16* V = (bf16*)(ws + WS_V); bf16* G = (bf16*)(ws + WS_G);
    bf16* h0 = (bf16*)d_out;
    if (hipMemsetAsync(ws + WS_CTL, 0, CTL_ZERO_BYTES, stream) != hipSuccess) { fprintf(stderr, "kernel_launch: memset failed\n"); return; }
    Args a{};
    for (int i = 0; i < 22; ++i) a.in[i] = (const float*)d_in[i];
    a.out = out; a.ws = ws;

#ifndef USE_P0
#define USE_P0 1
#endif
#ifndef USE_P2
#define USE_P2 1
#endif
#ifndef USE_P5
#define USE_P5 1
#endif
#if USE_P0
    launch_mega(a, 0, 1, grid, stream);
#else
    k_transpose<<<dim3(NA / 32, D / 32), 256, 0, stream>>>(w_in_a, nullptr, WaT, D, NA);
    k_transpose<<<dim3(D / 32, GW / 32), 256, 0, stream>>>(w_out_a, nullptr, WoaT, GW, D);
    k_transpose<<<dim3(NC / 32, D / 32), 256, 0, stream>>>(w_in_c, norm_c, WcT, D, NC);
    k_transpose<<<dim3(D / 32, GW / 32), 256, 0, stream>>>(w_out_c, nullptr, WocT, GW, D);
    k_gatew<<<8 * 2 * 128 * 128 / 256, 256, 0, stream>>>(gate_a_w, gate_x_w, WG);
    k_biastab<<<16 * 128 / 256, 256, 0, stream>>>(rel_bias, btab);
    k_rms_h0<<<M / 4, 256, 0, stream>>>(x, norm_a, h0);
#endif
    launch_mega(a, 1, 2, grid, stream);
#if USE_P2
    launch_mega(a, 2, 3, grid, stream);
#else
    k_lru<<<NB * 8, 128, 0, stream>>>(z0, conv_w, conv_b, WG, gate_a_b, gate_x_b, lru_lambda, y0);
    k_attn<<<M * 16 / 64, 64, 0, stream>>>(z0, q_norm_g, k_norm_g, sinks, btab, y0);
#endif
    launch_mega(a, 3, 4, grid, stream);
    launch_mega(a, 4, 5, grid, stream);
#if USE_P5
    launch_mega(a, 5, 6, grid, stream);
#else
    k_vfin<<<M / 4, 256, 0, stream>>>(vst, vfin);
    k_gate<<<dim3(GW / 256, M), 256, 0, stream>>>(U, V, G, vfin, ln_v_g, ln_v_b, spatial_w, spatial_b);
#endif
    launch_mega(a, 6, 7, grid, stream);
}
```

```cpp
#include <hip/hip_runtime.h>
#include <cstdint>
#include <cstdio>

typedef unsigned short bf16;
constexpr int D = 1024, NB = 16, S = 2048, M = NB * S;
constexpr int NA = 4352, NC = 6144, GW = 2048;
constexpr float EPS = 1e-6f;
constexpr size_t MiB = 1u << 20;
constexpr size_t WS_CTL = 0, CTL_ZERO_BYTES = 1 * MiB;
constexpr size_t WS_BIAS = 1 * MiB;
constexpr size_t WS_WAT = 2 * MiB;
constexpr size_t WS_WOAT = 11 * MiB;
constexpr size_t WS_WCT = 15 * MiB;
constexpr size_t WS_WOCT = 27 * MiB;
constexpr size_t WS_WG = 31 * MiB;
constexpr size_t WS_WS = 31 * MiB + 512 * 1024;
constexpr size_t WS_SSQ = 32 * MiB;
constexpr size_t WS_VST = 34 * MiB;
constexpr size_t WS_Z0 = 48 * MiB;
constexpr size_t WS_Y0 = 320 * MiB;
constexpr size_t WS_X1B = 448 * MiB;
constexpr size_t WS_U = 48 * MiB, WS_V = 176 * MiB, WS_G = 304 * MiB;
constexpr size_t WS_END = 512 * MiB;

__device__ __forceinline__ unsigned f2bf(float f) { unsigned u = __builtin_bit_cast(unsigned, f); return (u + 0x7fffu + ((u >> 16) & 1u)) >> 16; }
__device__ __forceinline__ float bf2f(unsigned h) { return __builtin_bit_cast(float, h << 16); }

namespace pg8 {
#define PG8_LAS __attribute__((address_space(3)))
typedef unsigned short bf16_t;
typedef short bf16x8 __attribute__((ext_vector_type(8)));
typedef float f32x4 __attribute__((ext_vector_type(4)));
typedef unsigned u32x4 __attribute__((ext_vector_type(4)));
constexpr int BM = 256, BK = 64, HALF = 128, HTB = HALF * BK * 2  , STAGE_BYTES = 8 * HTB, NXCD = 8, WGM = 4;

__host__ __device__ __forceinline__ int lds_byte(int r, int c) { const int st = (r >> 4) * 2 + (c >> 5), rr = r & 15, cc = c & 31, ob = rr * 64 + cc * 2; return st * 1024 + (ob ^ (((ob >> 9) & 1) << 5)); }
__host__ __device__ __forceinline__ void stage_rc(int b, int& R, int& C) { const int st = b / 1024, sb = b % 1024, swz = sb ^ (((sb >> 9) & 1) << 5); R = (st >> 1) * 16 + swz / 64; C = (st & 1) * 32 + (swz % 64) / 2; }
__host__ __device__ __forceinline__ int perm32(int rho) { const int n = rho >> 4, i = rho & 15; return 8 * (i >> 2) + 4 * n + (i & 3); }

struct Unit { int pm, pn; };
struct Gemm { const bf16_t* A; const bf16_t* Bt; int M, N, K; unsigned* dummy; };

struct StaticOrder {
    int nM, nN, nwg, G, c, wgm;
    __host__ __device__ void init(int M, int N, int G_, int c_, int wgm_ = WGM) { nM = M / BM; nN = N / BM; nwg = nM * nN; G = G_; c = c_; wgm = wgm_; }
    __host__ __device__ bool next(int i, Unit& u) const {
        const long L = (long)i * G + c; if (L >= nwg) return false;
        int wgid = (int)L; { const int q = nwg / NXCD, r = nwg % NXCD, xcd = wgid % NXCD, off = wgid / NXCD; wgid = (xcd < r ? xcd * (q + 1) : r * (q + 1) + (xcd - r) * q) + off; }
        const int nig = wgm * nN, gid = wgid / nig, fm = gid * wgm, gsz = (nM - fm) < wgm ? (nM - fm) : wgm;
        u.pm = fm + ((wgid % nig) % gsz); u.pn = (wgid % nig) / gsz; return true;
    }
    __device__ __forceinline__ void a_ready(const Unit&) const {}
    __device__ __forceinline__ void done(const Unit&) const {}
};
__device__ __forceinline__ unsigned cvt_pk_bf16(float lo, float hi) { unsigned r; asm volatile("v_cvt_pk_bf16_f32 %0, %1, %2" : "=v"(r) : "v"(lo), "v"(hi)); return r; }
typedef float f32x2 __attribute__((ext_vector_type(2)));
typedef unsigned u32x2 __attribute__((ext_vector_type(2)));
#ifndef REPS_Z0
#define REPS_Z0 1
#endif
#ifndef REPS_R1
#define REPS_R1 1
#endif
#ifndef REPS_Z1
#define REPS_Z1 1
#endif
struct EpiZ0 {
    static constexpr bool PERM = true, AFTER_DRAIN = false; static constexpr int REPS = REPS_Z0, NST = 16;
    bf16_t* O; int ldc;
    __device__ __forceinline__ void operator()(const f32x4 (&acc)[2][2][4][2], const Unit& u, int wr, int wc, int fr, int fq) const {
        const int row0 = u.pm * BM + wr * 64 + fr, col0 = u.pn * BM + wc * 32 + 8 * fq;
#pragma unroll
        for (int ai = 0; ai < 2; ++ai)
#pragma unroll
            for (int m = 0; m < 4; ++m) { bf16_t* rowp = O + (size_t)(row0 + ai * HALF + m * 16) * ldc + col0;
#pragma unroll
                for (int bj = 0; bj < 2; ++bj) { const f32x4 v0 = acc[ai][bj][m][0], v1 = acc[ai][bj][m][1];
                    u32x4 w; w.x = cvt_pk_bf16(v0[0], v0[1]); w.y = cvt_pk_bf16(v0[2], v0[3]); w.z = cvt_pk_bf16(v1[0], v1[1]); w.w = cvt_pk_bf16(v1[2], v1[3]);
                    *(u32x4*)(rowp + bj * HALF) = w; } }
    }
};
struct EpiRes1 {
    static constexpr bool PERM = true, AFTER_DRAIN = false; static constexpr int REPS = REPS_R1, NST = 16;
    const float* resid; bf16_t* x1b; float* ssq;
    __device__ __forceinline__ void operator()(const f32x4 (&acc)[2][2][4][2], const Unit& u, int wr, int wc, int fr, int fq) const {
        const int row0 = u.pm * BM + wr * 64 + fr, col0 = u.pn * BM + wc * 32 + 8 * fq;
#pragma unroll
        for (int ai = 0; ai < 2; ++ai)
#pragma unroll
            for (int m = 0; m < 4; ++m) { const int row = row0 + ai * HALF + m * 16; const size_t off = (size_t)row * 1024 + col0; float s = 0.f;
#pragma unroll
                for (int bj = 0; bj < 2; ++bj) {
                    const f32x4 r0 = __builtin_nontemporal_load((const f32x4*)(resid + off + bj * HALF)), r1 = __builtin_nontemporal_load((const f32x4*)(resid + off + bj * HALF + 4));
                    const f32x4 v0 = acc[ai][bj][m][0] + r0, v1 = acc[ai][bj][m][1] + r1;
                    u32x4 w; w.x = cvt_pk_bf16(v0[0], v0[1]); w.y = cvt_pk_bf16(v0[2], v0[3]); w.z = cvt_pk_bf16(v1[0], v1[1]); w.w = cvt_pk_bf16(v1[2], v1[3]);
                    *(u32x4*)(x1b + off + bj * HALF) = w;
                    s += (v0[0] * v0[0] + v0[1] * v0[1]) + (v0[2] * v0[2] + v0[3] * v0[3]) + (v1[0] * v1[0] + v1[1] * v1[1]) + (v1[2] * v1[2] + v1[3] * v1[3]); }
                s += __shfl_xor(s, 16); s += __shfl_xor(s, 32);
                if (fq == 0) ssq[(size_t)row * 16 + u.pn * 4 + wc] = s; }
    }
};
struct EpiZ1 {
    static constexpr bool PERM = true, AFTER_DRAIN = false; static constexpr int REPS = REPS_Z1, NST = 16;
    bf16_t* O; size_t split_stride; float* vst;
    __device__ __forceinline__ void operator()(const f32x4 (&acc)[2][2][4][2], const Unit& u, int wr, int wc, int fr, int fq) const {
        const int row0 = u.pm * BM + wr * 64 + fr; const int t = u.pn >> 3, colt = (u.pn & 7) * BM;
        bf16_t* base = O + (size_t)t * split_stride; const int col0 = colt + wc * 32 + 8 * fq;
#pragma unroll
        for (int ai = 0; ai < 2; ++ai)
#pragma unroll
            for (int m = 0; m < 4; ++m) { const int row = row0 + ai * HALF + m * 16;
                bf16_t* rowp = base + (size_t)row * 2048 + col0; float s1 = 0.f, s2 = 0.f;
#pragma unroll
                for (int bj = 0; bj < 2; ++bj) { const f32x4 v0 = acc[ai][bj][m][0], v1 = acc[ai][bj][m][1];
                    u32x4 w; w.x = cvt_pk_bf16(v0[0], v0[1]); w.y = cvt_pk_bf16(v0[2], v0[3]); w.z = cvt_pk_bf16(v1[0], v1[1]); w.w = cvt_pk_bf16(v1[2], v1[3]);
                    *(u32x4*)(rowp + bj * HALF) = w;
                    if (t == 1) { s1 += ((v0[0] + v0[1]) + (v0[2] + v0[3])) + ((v1[0] + v1[1]) + (v1[2] + v1[3]));
                        s2 += (v0[0] * v0[0] + v0[1] * v0[1]) + (v0[2] * v0[2] + v0[3] * v0[3]) + (v1[0] * v1[0] + v1[1] * v1[1]) + (v1[2] * v1[2] + v1[3] * v1[3]); } }
                if (t == 1) { s1 += __shfl_xor(s1, 16); s1 += __shfl_xor(s1, 32); s2 += __shfl_xor(s2, 16); s2 += __shfl_xor(s2, 32);
                    if (fq == 0) { f32x2 o; o.x = s1; o.y = s2; *(f32x2*)(vst + ((size_t)row * 32 + (u.pn & 7) * 4 + wc) * 2) = o; } } }
    }
};
struct EpiRes3 {
    static constexpr bool PERM = true, AFTER_DRAIN = false; static constexpr int REPS = 1, NST = 32;
    const bf16_t* x1b; float* out;
    __device__ __forceinline__ void operator()(const f32x4 (&acc)[2][2][4][2], const Unit& u, int wr, int wc, int fr, int fq) const {
        const int row0 = u.pm * BM + wr * 64 + fr, col0 = u.pn * BM + wc * 32 + 8 * fq;
#pragma unroll
        for (int ai = 0; ai < 2; ++ai)
#pragma unroll
            for (int m = 0; m < 4; ++m) { const size_t off = (size_t)(row0 + ai * HALF + m * 16) * 1024 + col0;
#pragma unroll
                for (int bj = 0; bj < 2; ++bj) { const u32x4 xb = *(const u32x4*)(x1b + off + bj * HALF);
                    f32x4 r0, r1; r0[0] = __builtin_bit_cast(float, xb.x << 16); r0[1] = __builtin_bit_cast(float, xb.x & 0xffff0000u); r0[2] = __builtin_bit_cast(float, xb.y << 16); r0[3] = __builtin_bit_cast(float, xb.y & 0xffff0000u);
                    r1[0] = __builtin_bit_cast(float, xb.z << 16); r1[1] = __builtin_bit_cast(float, xb.z & 0xffff0000u); r1[2] = __builtin_bit_cast(float, xb.w << 16); r1[3] = __builtin_bit_cast(float, xb.w & 0xffff0000u);
                    __builtin_nontemporal_store(acc[ai][bj][m][0] + r0, (f32x4*)(out + off + bj * HALF)); __builtin_nontemporal_store(acc[ai][bj][m][1] + r1, (f32x4*)(out + off + bj * HALF + 4)); } }
    }
};
template <class Epi, class Sched, bool ALIGN_EPI = false, bool SP2 = false>
__device__ __forceinline__ void gemm_phase(PG8_LAS unsigned char* lds, const Gemm g, const Sched& S, const Epi& E, const int wave_in) {
    const int wid = wave_in; int lane = (int)__builtin_amdgcn_mbcnt_hi(~0u, __builtin_amdgcn_mbcnt_lo(~0u, 0u)); asm volatile("" : "+v"(lane));
    const int tid = wid * 64 + lane, wr = wid >> 2, wc = wid & 3, fr = lane & 15, fq = lane >> 4;
    const int K = g.K, nt = K / BK;
    unsigned voffA[2], voffB[2];
#pragma unroll
    for (int i = 0; i < 2; ++i) { int R, C; stage_rc(tid * 16 + i * 8192, R, C); const int Rb = Epi::PERM ? ((R & ~31) + perm32(R & 31)) : R;
        voffA[i] = (unsigned)(R * K + C) * 2u; voffB[i] = (unsigned)(Rb * K + C) * 2u; }
    const size_t kstep = (size_t)(BK * 2);
    const size_t hstep = (size_t)HALF * K * 2;
    const size_t tstep = 2 * hstep;
    const unsigned ldsw = (unsigned)wid * 1024u;
    const int aoff = lds_byte(wr * 64 + fr, fq * 8); int boff = lds_byte(wc * 32 + fr, fq * 8) + 4 * HTB; asm volatile("" : "+v"(boff));
#define PG8_SA(b, h) (((b) * 2 + (h)) * HTB)
#define PG8_SB(b, h) ((4 + (b) * 2 + (h)) * HTB)
#define PG8_SBR(b, h) (((b) * 2 + (h)) * HTB)
#define PG8_STAGE(bufoff, gbase, voff) do { _Pragma("unroll") for (int _i = 0; _i < 2; ++_i) \
        __builtin_amdgcn_global_load_lds((const unsigned*)((const char*)(gbase) + (voff)[_i]), (PG8_LAS unsigned*)(lds + (bufoff) + ldsw + _i * 8192), 16, 0, 0); } while (0)
#define PG8_LDA(dst, b, h) do { _Pragma("unroll") for (int m = 0; m < 4; ++m) _Pragma("unroll") for (int k = 0; k < 2; ++k) dst[m][k] = *(const PG8_LAS bf16x8*)(lds + PG8_SA(b, h) + aoff + m * 2048 + k * 1024); } while (0)
#define PG8_LDB(dst, b, h) do { _Pragma("unroll") for (int n = 0; n < 2; ++n) _Pragma("unroll") for (int k = 0; k < 2; ++k) dst[n][k] = *(const PG8_LAS bf16x8*)(lds + boff + (PG8_SBR(b, h) + n * 2048 + k * 1024)); } while (0)
#define PG8_MMA(ai, bj, At, Bt) do { __builtin_amdgcn_s_setprio(1); _Pragma("unroll") for (int m = 0; m < 4; ++m) _Pragma("unroll") for (int n = 0; n < 2; ++n) _Pragma("unroll") for (int k = 0; k < 2; ++k) \
        acc[ai][bj][m][n] = __builtin_amdgcn_mfma_f32_16x16x32_bf16(Bt[n][k], At[m][k], acc[ai][bj][m][n], 0, 0, 0); __builtin_amdgcn_s_setprio(0); } while (0)
#define PG8_MMA0(ai, bj, At, Bt) do { __builtin_amdgcn_s_setprio(1); _Pragma("unroll") for (int m = 0; m < 4; ++m) _Pragma("unroll") for (int n = 0; n < 2; ++n) { \
        acc[ai][bj][m][n] = __builtin_amdgcn_mfma_f32_16x16x32_bf16(Bt[n][0], At[m][0], (f32x4){0.f, 0.f, 0.f, 0.f}, 0, 0, 0);     \
        acc[ai][bj][m][n] = __builtin_amdgcn_mfma_f32_16x16x32_bf16(Bt[n][1], At[m][1], acc[ai][bj][m][n], 0, 0, 0); } __builtin_amdgcn_s_setprio(0); } while (0)
#define PG8_WAIT_V(n) asm volatile("s_waitcnt vmcnt(" #n ")" ::: "memory")
#define PG8_WAIT_VX(n) asm volatile("s_waitcnt vmcnt(%0)" :: "i"(n) : "memory")
#define PG8_WAIT_L(n) asm volatile("s_waitcnt lgkmcnt(" #n ")" ::: "memory")
#define PG8_BAR __builtin_amdgcn_s_barrier()
#define PG8_SCHED __builtin_amdgcn_sched_barrier(0)
#define PG8_SP2_BODY(W01, MMAF) do { \
            PG8_LDB(B0, 0, 0); PG8_LDB(B1, 0, 1); PG8_SCHED; PG8_LDA(At, 0, 0); PG8_STAGE(PG8_SA(1, 1), a1 + hstep, voffA); \
            W01; PG8_WAIT_L(0); PG8_BAR; MMAF(0, 0, At, B0); MMAF(0, 1, At, B1); PG8_BAR; PG8_SCHED; \
            PG8_LDA(At, 0, 1); PG8_STAGE(PG8_SB(0, 0), b2, voffB); PG8_STAGE(PG8_SB(0, 1), b2 + hstep, voffB); PG8_STAGE(PG8_SA(0, 0), a2, voffA); \
            W01; PG8_WAIT_L(0); PG8_BAR; MMAF(1, 0, At, B0); MMAF(1, 1, At, B1); PG8_BAR; PG8_SCHED; \
            PG8_LDB(B0, 1, 0); PG8_LDB(B1, 1, 1); PG8_SCHED; PG8_LDA(At, 1, 0); PG8_STAGE(PG8_SA(0, 1), a2 + hstep, voffA); \
            PG8_WAIT_V(8); PG8_WAIT_L(0); PG8_BAR; PG8_MMA(0, 0, At, B0); PG8_MMA(0, 1, At, B1); PG8_BAR; PG8_SCHED; \
            PG8_LDA(At, 1, 1); PG8_STAGE(PG8_SB(1, 0), b3, voffB); PG8_STAGE(PG8_SB(1, 1), b3 + hstep, voffB); PG8_STAGE(PG8_SA(1, 0), a3, voffA); \
            PG8_WAIT_V(8); PG8_WAIT_L(0); PG8_BAR; PG8_MMA(1, 0, At, B0); PG8_MMA(1, 1, At, B1); PG8_BAR; PG8_SCHED; \
            } while (0)
    Unit cur, nxt; int ui = 0;
    if (!S.next(0, cur)) return;
    f32x4 acc[2][2][4][2];
    if constexpr (!SP2) {
#pragma unroll
    for (int a = 0; a < 2; ++a)
#pragma unroll
        for (int b = 0; b < 2; ++b)
#pragma unroll
            for (int m = 0; m < 4; ++m)
#pragma unroll
                for (int n = 0; n < 2; ++n) acc[a][b][m][n] = (f32x4){0.f, 0.f, 0.f, 0.f};
    }
    bf16x8 At[4][2], B0[2][2], B1[2][2];
    const char* cA = (const char*)g.A + (size_t)cur.pm * tstep; const char* cB = (const char*)g.Bt + (size_t)cur.pn * tstep;
    S.a_ready(cur);
    if constexpr (SP2) {
        PG8_STAGE(PG8_SB(0, 0), cB, voffB); PG8_STAGE(PG8_SB(0, 1), cB + hstep, voffB); PG8_STAGE(PG8_SA(0, 0), cA, voffA); PG8_STAGE(PG8_SA(0, 1), cA + hstep, voffA);
        if (wr == 1) PG8_BAR;
        PG8_WAIT_V(2); PG8_BAR;
        PG8_STAGE(PG8_SB(1, 0), cB + kstep, voffB); PG8_STAGE(PG8_SA(1, 0), cA + kstep, voffA); PG8_STAGE(PG8_SB(1, 1), cB + hstep + kstep, voffB);
        PG8_WAIT_V(6); PG8_BAR;
    } else {
        PG8_STAGE(PG8_SB(0, 0), cB, voffB); PG8_STAGE(PG8_SA(0, 0), cA, voffA); PG8_STAGE(PG8_SB(0, 1), cB + hstep, voffB); PG8_STAGE(PG8_SA(0, 1), cA + hstep, voffA);
        if (wr == 1) PG8_BAR;
        PG8_WAIT_V(4); PG8_BAR;
        PG8_STAGE(PG8_SB(1, 0), cB + kstep, voffB); PG8_STAGE(PG8_SA(1, 0), cA + kstep, voffA); PG8_STAGE(PG8_SB(1, 1), cB + hstep + kstep, voffB);
        PG8_WAIT_V(6); PG8_BAR;
    }
    if constexpr (SP2) {
        const unsigned* dmb = g.dummy + ((size_t)blockIdx.x * 8 + wid) * 64;
        const unsigned dmo = (unsigned)lane * 4u;
#pragma unroll
        for (int i = 0; i < Epi::NST; ++i) asm volatile("global_store_dword %0, %0, %1\n\ts_nop 0" :: "v"(dmo), "s"(dmb) : "memory");
    }
    for (;;) {
        const bool has_next = S.next(ui + 1, nxt);
        const char* nA = has_next ? (const char*)g.A + (size_t)nxt.pm * tstep : cA; const char* nB = has_next ? (const char*)g.Bt + (size_t)nxt.pn * tstep : cB;
        if constexpr (SP2) {
            { const char* a1 = cA + kstep; const char* a2 = cA + 2 * kstep; const char* b2 = cB + 2 * kstep; const char* a3 = a2 + kstep; const char* b3 = b2 + kstep;
              PG8_SP2_BODY(PG8_WAIT_VX(8 + Epi::NST), PG8_MMA0); }
            for (int t = 2; t < nt; t += 2) {
                const bool last = (t == nt - 2);
                const char* a1 = cA + (size_t)(t + 1) * kstep;
                const char* a2 = last ? nA : cA + (size_t)(t + 2) * kstep; const char* b2 = last ? nB : cB + (size_t)(t + 2) * kstep;
                const char* a3 = a2 + kstep; const char* b3 = b2 + kstep;
                if (last && has_next) S.a_ready(nxt);
                PG8_SP2_BODY(PG8_WAIT_V(8), PG8_MMA);
            }
        } else {
        for (int t = 0; t < nt; t += 2) {
            const bool last = (t == nt - 2);
            const char* a1 = cA + (size_t)(t + 1) * kstep;
            const char* a2 = last ? nA : cA + (size_t)(t + 2) * kstep; const char* b2 = last ? nB : cB + (size_t)(t + 2) * kstep;
            const char* a3 = a2 + kstep; const char* b3 = b2 + kstep;
            if (last && has_next) S.a_ready(nxt);
            PG8_LDB(B0, 0, 0); PG8_SCHED; PG8_LDA(At, 0, 0); PG8_STAGE(PG8_SA(1, 1), a1 + hstep, voffA);
            PG8_WAIT_L(8); PG8_BAR; PG8_WAIT_L(0); PG8_MMA(0, 0, At, B0); PG8_BAR; PG8_SCHED;
            PG8_LDB(B1, 0, 1); PG8_STAGE(PG8_SB(0, 0), b2, voffB);
            PG8_BAR; PG8_WAIT_L(0); PG8_MMA(0, 1, At, B1); PG8_BAR;
            PG8_LDA(At, 0, 1); PG8_STAGE(PG8_SA(0, 0), a2, voffA);
            PG8_BAR; PG8_WAIT_L(0); PG8_MMA(1, 0, At, B0); PG8_BAR; PG8_SCHED;
            PG8_STAGE(PG8_SB(0, 1), b2 + hstep, voffB);
            PG8_WAIT_V(6); PG8_BAR; PG8_MMA(1, 1, At, B1); PG8_BAR;
            PG8_LDB(B0, 1, 0); PG8_SCHED; PG8_LDA(At, 1, 0); PG8_STAGE(PG8_SA(0, 1), a2 + hstep, voffA);
            PG8_WAIT_L(8); PG8_BAR; PG8_WAIT_L(0); PG8_MMA(0, 0, At, B0); PG8_BAR; PG8_SCHED;
            PG8_LDB(B1, 1, 1); PG8_STAGE(PG8_SB(1, 0), b3, voffB);
            PG8_BAR; PG8_WAIT_L(0); PG8_MMA(0, 1, At, B1); PG8_BAR;
            PG8_LDA(At, 1, 1); PG8_STAGE(PG8_SA(1, 0), a3, voffA);
            PG8_BAR; PG8_WAIT_L(0); PG8_MMA(1, 0, At, B0); PG8_BAR; PG8_SCHED;
            PG8_STAGE(PG8_SB(1, 1), b3 + hstep, voffB);
            PG8_WAIT_V(6); PG8_BAR; PG8_MMA(1, 1, At, B1); PG8_BAR;
        }
        }
        if constexpr (ALIGN_EPI) { if (wr == 0) PG8_BAR; }
        if constexpr (!Epi::AFTER_DRAIN) { int le = (int)__builtin_amdgcn_mbcnt_hi(~0u, __builtin_amdgcn_mbcnt_lo(~0u, 0u)); asm volatile("" : "+v"(le));
            E(acc, cur, wr, wc, le & 15, le >> 4); if constexpr (Epi::REPS > 1) { asm volatile("" ::: "memory"); E(acc, cur, wr, wc, le & 15, le >> 4); } S.done(cur); }
        if (!has_next) break;
        if constexpr (!SP2) {
#pragma unroll
        for (int a = 0; a < 2; ++a)
#pragma unroll
            for (int b = 0; b < 2; ++b)
#pragma unroll
                for (int m = 0; m < 4; ++m)
#pragma unroll
                    for (int n = 0; n < 2; ++n) acc[a][b][m][n] = (f32x4){0.f, 0.f, 0.f, 0.f};
        }
        cur = nxt; cA = nA; cB = nB; ++ui;
        if constexpr (ALIGN_EPI) { if (wr == 1) PG8_BAR; }
    }
    PG8_WAIT_V(0);
    if constexpr (!ALIGN_EPI) { if (wr == 0) PG8_BAR; }
    PG8_BAR;
    if constexpr (Epi::AFTER_DRAIN) { E.fused(acc, cur, wr, wc, fr, fq, lds, wid, lane); S.done(cur); }
#undef PG8_SA
#undef PG8_SB
#undef PG8_SBR
#undef PG8_STAGE
#undef PG8_LDA
#undef PG8_LDB
#undef PG8_MMA
#undef PG8_MMA0
#undef PG8_WAIT_V
#undef PG8_WAIT_VX
#undef PG8_SP2_BODY
#undef PG8_WAIT_L
#undef PG8_BAR
#undef PG8_SCHED
}
}

constexpr int NWAVES = 8;
constexpr int RING_OFF = 0, RING_BYTES = 155648;
constexpr int LDSCTL_OFF = RING_BYTES, MISC_OFF = LDSCTL_OFF + 320;
constexpr int LDS_BYTES = 163840;
#define GAS __attribute__((address_space(1)))
#define LAS __attribute__((address_space(3)))
typedef unsigned v4u __attribute__((ext_vector_type(4)));
typedef float f32x4 __attribute__((ext_vector_type(4)));
typedef short bf16x8 __attribute__((ext_vector_type(8)));
typedef GAS unsigned gu32;
#define RLX_AGENT __ATOMIC_RELAXED, __HIP_MEMORY_SCOPE_AGENT
constexpr int CW_TMO = 0, CW_CODE = 1, CW_BAR = 4096;

__device__ __forceinline__ int lane_id() { return (int)__builtin_amdgcn_mbcnt_hi(~0u, __builtin_amdgcn_mbcnt_lo(~0u, 0u)); }
struct Args { const float* in[22]; float* out; unsigned char* ws; int ph_lo, ph_hi; };
struct Frame {
    LAS unsigned char* lds; volatile LAS unsigned* MISC; gu32* ctl;
    int wave, vcu, G;
};
#define XB_TMO      128
#define XB_XCNT(j)  (256  + 64 * (j))
#define XB_XSUB(j)  (1280 + 64 * (j))
#define XB_XGEN(j)  (2304 + 64 * (j))
#define XB_TOP      3328
#define XB_TOPGEN   3392
#define XCD_BAR_WORDS 3456
#define XB_SPIN_CAP (1u << 18)

__device__ __forceinline__ unsigned xb_ld(unsigned* p)              { return __hip_atomic_load(p, __ATOMIC_RELAXED, __HIP_MEMORY_SCOPE_AGENT); }
__device__ __forceinline__ unsigned xb_add(unsigned* p, unsigned v) { return __hip_atomic_fetch_add(p, v, __ATOMIC_RELAXED, __HIP_MEMORY_SCOPE_AGENT); }
__device__ __forceinline__ unsigned xb_xcc_id() { return (unsigned)__builtin_amdgcn_s_getreg((3 << 11) | 20) & 0xFu; }
#define XB_SPIN(cond, bar) do { unsigned _sp = 0; while (cond) { __builtin_amdgcn_s_sleep(1); \
    if ((++_sp & 255u) == 0u) { if (xb_ld(&(bar)[XB_TMO])) break; if (_sp > XB_SPIN_CAP) { atomicAdd(&(bar)[XB_TMO], 1u); break; } } } } while (0)

struct XcdBarrier {
    unsigned* bar; unsigned x; int wave;
    volatile LAS unsigned* st;
};

__device__ __forceinline__ XcdBarrier xcd_barrier_post(unsigned* bar, volatile LAS unsigned* st) {
    XcdBarrier b; b.bar = bar; b.x = xb_xcc_id(); b.st = st;
    if (threadIdx.x == 0) (void)xb_add(&bar[XB_XCNT(b.x)], 1u);
    return b;
}
__device__ __forceinline__ void xcd_barrier_complete(unsigned* bar, unsigned x, unsigned& nloc, unsigned& nx) {
    const unsigned G = gridDim.x * gridDim.y * gridDim.z;
    unsigned sum, cnt, mine, sp = 0u;
    for (;;) {
        sum = 0u; cnt = 0u; mine = 0u;
#pragma unroll
        for (unsigned j = 0; j < 16; ++j) { const unsigned c = xb_ld(&bar[XB_XCNT(j)]); sum += c; cnt += (c > 0u) ? 1u : 0u; mine = (j == x) ? c : mine; }
        if (sum == G) break;
        __builtin_amdgcn_s_sleep(1);
        if ((++sp & 255u) == 0u) { if (xb_ld(&bar[XB_TMO])) break; if (sp > XB_SPIN_CAP) { atomicAdd(&bar[XB_TMO], 1u); break; } }
    }
    nloc = mine > 0u ? mine : 1u; nx = cnt > 0u ? cnt : 1u;
}

__device__ __forceinline__ void xcd_barrier(const XcdBarrier& b) {
    asm volatile("s_waitcnt vmcnt(0)" ::: "memory");
    __syncthreads();
    if (b.wave == 0 && lane_id() == 0) {
        unsigned* bar = b.bar;
        __builtin_amdgcn_s_waitcnt(0);
        __builtin_amdgcn_fence(__ATOMIC_ACQUIRE, "agent");
        unsigned nloc = b.st[0], nx = b.st[1];
        if (nloc == 0u) { xcd_barrier_complete(bar, b.x, nloc, nx); b.st[0] = nloc; b.st[1] = nx; }
        const unsigned old = xb_add(&bar[XB_XSUB(b.x)], 1u);
        const unsigned gen = old / nloc;
        if (old + 1u == (gen + 1u) * nloc) {
            __builtin_amdgcn_fence(__ATOMIC_RELEASE, "agent");
            asm volatile("s_waitcnt vmcnt(0)" ::: "memory");
            const unsigned og = xb_add(&bar[XB_TOP], 1u);
            const unsigned tg = og / nx;
            if (og + 1u == (tg + 1u) * nx) xb_add(&bar[XB_TOPGEN], 1u);
            else XB_SPIN(xb_ld(&bar[XB_TOPGEN]) == tg, bar);
            xb_add(&bar[XB_XGEN(b.x)], 1u);
            asm volatile("s_waitcnt vmcnt(0)" ::: "memory");
        } else {
            XB_SPIN(xb_ld(&bar[XB_XGEN(b.x)]) == gen, bar);
            asm volatile("s_waitcnt vmcnt(0)" ::: "memory");
        }
    }
    __syncthreads();
}

__device__ __forceinline__ float fsigmoid(float x) { return __builtin_amdgcn_rcpf(1.f + __builtin_amdgcn_exp2f(-1.4426950408889634f * x)); }
__device__ __forceinline__ float fsilu(float x) { return x * fsigmoid(x); }
typedef float cvt_f32x2 __attribute__((ext_vector_type(2))); typedef __bf16 cvt_bf16x2 __attribute__((ext_vector_type(2)));
__device__ __forceinline__ unsigned cvtpk(float lo, float hi) { const cvt_f32x2 v = {lo, hi}; const cvt_bf16x2 b = __builtin_convertvector(v, cvt_bf16x2); return __builtin_bit_cast(unsigned, b); }
__device__ __forceinline__ float bflo(unsigned u) { return __builtin_bit_cast(float, u << 16); }
__device__ __forceinline__ float bfhi(unsigned u) { return __builtin_bit_cast(float, u & 0xffff0000u); }


#define LDS_WAIT() asm volatile("s_waitcnt lgkmcnt(0)" ::: "memory")
__device__ __forceinline__ unsigned pk2(float lo, float hi) { return f2bf(lo) | (f2bf(hi) << 16); }
__device__ __forceinline__ void p0_transpose_item(const float* W, int K, int N, bf16* WT, const float* scale, LAS float* scr, int item, int lane, float cs = 1.f) {
    const int nblk = N / 32, kb = item / nblk, nb = item % nblk, k0 = 64 * kb, n0 = 32 * nb;
    const int lr = lane >> 3, lc = 4 * (lane & 7);
    f32x4 v[8];
#pragma unroll
    for (int i = 0; i < 8; ++i) v[i] = *(const GAS f32x4*)(W + (size_t)(k0 + lr + 8 * i) * N + n0 + lc);
#pragma unroll
    for (int i = 0; i < 8; ++i) { const int kk = lr + 8 * i; const float sc = scale ? scale[k0 + kk] : cs; LAS float* d = scr + kk * 33 + lc;
        d[0] = v[i].x * sc; d[1] = v[i].y * sc; d[2] = v[i].z * sc; d[3] = v[i].w * sc; }
    LDS_WAIT(); asm volatile("" ::: "memory");
    const int c = lane & 7;
#pragma unroll
    for (int j = 0; j < 4; ++j) { const int n = (lane >> 3) + 8 * j; const LAS float* s = scr + (8 * c) * 33 + n;
        v4u o; o.x = pk2(s[0 * 33], s[1 * 33]); o.y = pk2(s[2 * 33], s[3 * 33]); o.z = pk2(s[4 * 33], s[5 * 33]); o.w = pk2(s[6 * 33], s[7 * 33]);
        *(GAS v4u*)(WT + (size_t)(n0 + n) * K + k0 + 8 * c) = o; }
    LDS_WAIT(); asm volatile("" ::: "memory");
}
template <int NR> __device__ __forceinline__ void rms_rows_to_bf16(const float* xrow, const float* gain, bf16* orow, int lane) {
    const GAS f32x4* gr = (const GAS f32x4*)gain + lane;
    f32x4 v[NR][4]; float s[NR];
#pragma unroll
    for (int r = 0; r < NR; ++r) { const GAS f32x4* xr = (const GAS f32x4*)(xrow + (size_t)r * D) + lane;
#pragma unroll
        for (int j = 0; j < 4; ++j) v[r][j] = __builtin_nontemporal_load(xr + 64 * j); }
#pragma unroll
    for (int r = 0; r < NR; ++r) { s[r] = 0.f;
#pragma unroll
        for (int j = 0; j < 4; ++j) s[r] += (v[r][j].x * v[r][j].x + v[r][j].y * v[r][j].y) + (v[r][j].z * v[r][j].z + v[r][j].w * v[r][j].w); }
#pragma unroll
    for (int o = 1; o < 64; o <<= 1) {
#pragma unroll
        for (int r = 0; r < NR; ++r) s[r] += __shfl_xor(s[r], o); }
#pragma unroll
    for (int r = 0; r < NR; ++r) { const float rstd = rsqrtf(s[r] * (1.f / D) + EPS);
        GAS unsigned long long* o8 = (GAS unsigned long long*)(orow + (size_t)r * D) + lane;
#pragma unroll
        for (int j = 0; j < 4; ++j) { const f32x4 g = gr[64 * j]; o8[64 * j] = (unsigned long long)pk2(v[r][j].x * rstd * g.x, v[r][j].y * rstd * g.y) | ((unsigned long long)pk2(v[r][j].z * rstd * g.z, v[r][j].w * rstd * g.w) << 32); } }
}
constexpr int I_A = (D / 64) * (NA / 32), I_OA = (GW / 64) * (D / 32), I_C = (D / 64) * (NC / 32), I_OC = I_OA, I_G = 16 * 8;
__device__ __forceinline__ void p0_prologue(const Frame& F, const Args& args, unsigned char* ws) {
    int tid_ = F.wave * 64 + lane_id(); asm volatile("" : "+v"(tid_)); const int lane_ = tid_ & 63;
    LAS float* scr = (LAS float*)(F.lds + RING_OFF + F.wave * 16384);
    const int gw = F.vcu * NWAVES + F.wave, NGW = F.G * NWAVES;
    bf16* WaT = (bf16*)(ws + WS_WAT);
    for (int it = gw; it < I_A; it += NGW) p0_transpose_item(args.in[2], D, NA, WaT, nullptr, scr, it, lane_);
    bf16* h0 = (bf16*)args.out;
    for (int m = gw * 4; m < M; m += NGW * 4) rms_rows_to_bf16<4>(args.in[0] + (size_t)m * D, args.in[1], h0 + (size_t)m * D, lane_);
}
__device__ __forceinline__ void p0_layer1_weights(const Frame& F, const Args& args, unsigned char* ws, int icu, int ncu) {
    int tid_ = F.wave * 64 + lane_id(); asm volatile("" : "+v"(tid_)); const int lane_ = tid_ & 63;
    LAS float* scr = (LAS float*)(F.lds + RING_OFF + F.wave * 16384);
    const int gw = icu * NWAVES + F.wave, NGW = ncu * NWAVES;
    bf16* WoaT = (bf16*)(ws + WS_WOAT); bf16* WG = (bf16*)(ws + WS_WG); bf16* WcT = (bf16*)(ws + WS_WCT); bf16* WocT = (bf16*)(ws + WS_WOCT);
    for (int it = gw; it < I_OA + I_G + I_C + I_OC; it += NGW) {
        int r = it;
        if (r < I_OA) { p0_transpose_item(args.in[13], GW, D, WoaT, nullptr, scr, r, lane_); continue; } r -= I_OA;
        if (r < I_G) { const int mat = r >> 3, sub = r & 7, n = mat >> 1, gate = mat & 1;
            p0_transpose_item((gate ? args.in[7] : args.in[5]) + (size_t)n * 16384, 128, 128, WG + (size_t)mat * 16384, nullptr, scr, sub, lane_, -1.4426950408889634f); continue; } r -= I_G;
        if (r < I_C) { p0_transpose_item(args.in[16], D, NC, WcT, args.in[15], scr, r, lane_); continue; } r -= I_C;
        p0_transpose_item(args.in[21], GW, D, WocT, nullptr, scr, r, lane_);
    }
    { float* btab = (float*)(ws + WS_BIAS);
      for (int gt = icu * (NWAVES * 64) + tid_; gt < 16 * 128; gt += ncu * NWAVES * 64) { const int d = gt & 127, h = gt >> 7; int bk;
          if (d < 16) bk = d; else { bk = 16 + (int)(logf((float)d / 16.f) / logf(8.f) * 16.f); if (bk > 31) bk = 31; }
          btab[gt] = args.in[14][bk * 16 + h]; } }
    { bf16* WS = (bf16*)(ws + WS_WS);
      for (int gt = icu * (NWAVES * 64) + tid_; gt < 8 * 128 * 16; gt += ncu * NWAVES * 64) { const int s8 = gt & 15, t = (gt >> 4) & 127; const float* src = args.in[19] + (size_t)gt * 8;
          const f32x4 a = *(const f32x4*)src, b = *(const f32x4*)(src + 4); const float wv[8] = {a.x, a.y, a.z, a.w, b.x, b.y, b.z, b.w}; float o[8];
#pragma unroll
          for (int e = 0; e < 8; ++e) o[e] = (8 * s8 + e <= t) ? wv[e] : 0.f;
          v4u pk; pk.x = pk2(o[0], o[1]); pk.y = pk2(o[2], o[3]); pk.z = pk2(o[4], o[5]); pk.w = pk2(o[6], o[7]);
          *(GAS v4u*)(WS + (size_t)gt * 8) = pk; } }
}

typedef float f32x16 __attribute__((ext_vector_type(16)));
constexpr int P5_VSTRIDE = 272;
constexpr int P5_VT = 0, P5_W0 = 256 * P5_VSTRIDE, P5_ST = P5_W0 + 128 * P5_VSTRIDE, P5_GB = P5_ST + (384 + 1024) * 4;
static_assert(P5_GB + 4096 * 4 <= RING_BYTES, "P5 LDS map");
__device__ __forceinline__ void p5_gate(const Frame& F, const Args& args, unsigned char* ws) {
    LAS unsigned char* L = F.lds + RING_OFF;
    LAS float* mu = (LAS float*)(L + P5_ST); LAS float* rs = mu + 128; LAS float* rx = mu + 256; LAS float* bb = mu + 384;
    bf16* U = (bf16*)(ws + WS_U); const bf16* V = (const bf16*)(ws + WS_V); const bf16* G = (const bf16*)(ws + WS_G); const float* vst = (const float*)(ws + WS_VST);
    const bf16* WS = (const bf16*)(ws + WS_WS);
    const float* lg = args.in[17]; const float* lb = args.in[18]; const float* sb = args.in[20]; const float* ssq = (const float*)(ws + WS_SSQ);
    const int w = F.wave;
    const int NCH = M / 128, nitem = 2 * NCH;
    const int nmine = (nitem - F.vcu + F.G - 1) / F.G;
    for (int idx = 0; idx < nmine; ++idx) {
        const int it = F.vcu + ((2 * F.vcu >= F.G) ? (nmine - 1 - idx) : idx) * F.G;
        const int ch = (it < NCH) ? (NCH - 1 - it) : (it - NCH);
        const int g0 = (it < NCH) ? ((ch >= NCH / 2) ? 0 : 4) : ((ch >= NCH / 2) ? 4 : 0), g1 = g0 + 4;
        const int r0 = ch * 128;
        int tid = F.wave * 64 + lane_id(); asm volatile("" : "+v"(tid));
        const int lane0 = tid & 63, spl0 = lane0 & 15, cgl0 = lane0 >> 4;
        v4u vreg[4][2], wreg[4];
        { const int spl = spl0, cgl = cgl0;
#define P5_LOAD(g_) do { \
        const char* vb_ = (const char*)(V + (size_t)r0 * GW + (g_) * 256); const char* wb_ = (const char*)(WS + (size_t)(g_) * 16384); \
        _Pragma("unroll") for (int i = 0; i < 4; ++i) { const unsigned vo_ = (unsigned)((2 * (16 * i + spl)) * GW + 32 * w + 8 * cgl) * 2u; vreg[i][0] = *(const v4u*)(vb_ + vo_); vreg[i][1] = *(const v4u*)(vb_ + vo_ + GW * 2); } \
        _Pragma("unroll") for (int i = 0; i < 4; ++i) wreg[i] = *(const v4u*)(wb_ + (unsigned)(tid + 512 * i) * 16u); \
        } while (0)
        P5_LOAD(g0); }
        __syncthreads();
        { const int row = tid >> 2, part = tid & 3;
          const f32x4* p = (const f32x4*)(vst + ((size_t)(r0 + row) * 32 + part * 8) * 2);
          const f32x4 a = p[0], b = p[1], c = p[2], d = p[3];
          float s1 = ((a.x + a.z) + (b.x + b.z)) + ((c.x + c.z) + (d.x + d.z));
          float s2 = ((a.y + a.w) + (b.y + b.w)) + ((c.y + c.w) + (d.y + d.w));
          s1 += __shfl_xor(s1, 1); s1 += __shfl_xor(s1, 2); s2 += __shfl_xor(s2, 1); s2 += __shfl_xor(s2, 2);
          const f32x4 sq = *(const f32x4*)(ssq + (size_t)(r0 + row) * 16 + 4 * part); float sx = (sq.x + sq.y) + (sq.z + sq.w); sx += __shfl_xor(sx, 1); sx += __shfl_xor(sx, 2);
          const float rxx = rsqrtf(sx * (1.f / D) + EPS);
          const float mean = s1 * (1.f / GW), var = fmaxf(s2 * (1.f / GW) - mean * mean, 0.f);
          if (part == 0) { mu[row] = mean; rs[row] = rxx * rsqrtf(rxx * rxx * var + EPS); rx[row] = rxx; }
          bb[tid] = sb[tid]; bb[tid + 512] = sb[tid + 512];
          LAS f32x4* gbt = (LAS f32x4*)(L + P5_GB); gbt[tid] = *(const f32x4*)(lg + 4 * tid); gbt[512 + tid] = *(const f32x4*)(lb + 4 * tid); }
        __syncthreads();
        v4u ug[4][4];
        { const int lane = lane0, l31 = lane & 31, hi = lane >> 5; const char* ub0 = (const char*)(U + (size_t)r0 * GW); const char* gb0 = (const char*)(G + (size_t)r0 * GW);
#pragma unroll
          for (int j = 0; j < 4; ++j) { const unsigned off = (unsigned)((32 * j + l31) * GW + g0 * 256 + 32 * w + 16 * hi) * 2u;
              ug[j][0] = *(const v4u*)(ub0 + off); ug[j][1] = *(const v4u*)(ub0 + off + 16); ug[j][2] = *(const v4u*)(gb0 + off); ug[j][3] = *(const v4u*)(gb0 + off + 16); } }
#pragma unroll 1
        for (int g = g0; g < g1; ++g) {
            int tg = tid; asm volatile("" : "+v"(tg));
            const int lane = tg & 63, l31 = lane & 31, hi = lane >> 5, cgl = lane >> 4, spl = lane & 15;
            { const LAS f32x4* gp = (const LAS f32x4*)(L + P5_GB) + (g * 256 + 32 * w + 8 * cgl) / 4; const f32x4 ga0 = gp[0], ga1 = gp[1], be0 = gp[512], be1 = gp[513];
              const float gam[8] = {ga0.x, ga0.y, ga0.z, ga0.w, ga1.x, ga1.y, ga1.z, ga1.w}, bet[8] = {be0.x, be0.y, be0.z, be0.w, be1.x, be1.y, be1.z, be1.w};
#pragma unroll
              for (int i = 0; i < 4; ++i) { const int sp = 16 * i + spl; const float m0 = mu[2 * sp], m1 = mu[2 * sp + 1], q0 = rs[2 * sp], q1 = rs[2 * sp + 1];
                  const unsigned a0[4] = {vreg[i][0].x, vreg[i][0].y, vreg[i][0].z, vreg[i][0].w}, a1[4] = {vreg[i][1].x, vreg[i][1].y, vreg[i][1].z, vreg[i][1].w};
#pragma unroll
                  for (int e = 0; e < 8; ++e) { const float x0 = (e & 1) ? bfhi(a0[e >> 1]) : bflo(a0[e >> 1]), x1 = (e & 1) ? bfhi(a1[e >> 1]) : bflo(a1[e >> 1]);
                      const float n0 = (x0 - m0) * q0 * gam[e] + bet[e], n1 = (x1 - m1) * q1 * gam[e] + bet[e];
                      *(LAS unsigned*)(L + P5_VT + (32 * w + 8 * cgl + e) * P5_VSTRIDE + sp * 4) = cvtpk(n0, n1); } } }
            __syncthreads();
            { LAS unsigned char* wb = L + P5_W0;
#pragma unroll
              for (int i = 0; i < 4; ++i) { const int idx = tid + 512 * i; *(LAS v4u*)(wb + (idx >> 4) * P5_VSTRIDE + (idx & 15) * 16) = wreg[i]; } }
            if (g + 1 < g1) P5_LOAD(g + 1);
            char* ub = (char*)(U + (size_t)r0 * GW + g * 256); const char* gb = (const char*)(G + (size_t)r0 * GW + g * 256);
            __syncthreads();
            const int prow = 16 * ((l31 >> 2) & 1) + 4 * (l31 >> 3) + (l31 & 3);
            const LAS unsigned char* ap = L + P5_VT + (32 * w + prow) * P5_VSTRIDE + hi * 16;
            const LAS unsigned char* bp = L + P5_W0 + l31 * P5_VSTRIDE + hi * 16;
#pragma unroll
            for (int jp = 0; jp < 2; ++jp) {
                f32x16 acc[2];
#pragma unroll
                for (int jj = 0; jj < 2; ++jj) { const int j = 2 * jp + jj; f32x16 a = {0.f, 0.f, 0.f, 0.f, 0.f, 0.f, 0.f, 0.f, 0.f, 0.f, 0.f, 0.f, 0.f, 0.f, 0.f, 0.f};
#pragma unroll
                    for (int ks = 0; ks < 2 * j + 2; ++ks) { const bf16x8 af = *(const LAS bf16x8*)(ap + ks * 32), bfr_ = *(const LAS bf16x8*)(bp + j * 32 * P5_VSTRIDE + ks * 32);
                        a = __builtin_amdgcn_mfma_f32_32x32x16_bf16(af, bfr_, a, 0, 0, 0); }
                    acc[jj] = a; }
#pragma unroll
                for (int jj = 0; jj < 2; ++jj) { const int j = 2 * jp + jj; const int t = 32 * j + l31; const float b0 = bb[g * 128 + t], rxt = rx[t];
                    const unsigned off = (unsigned)(t * GW + 32 * w + 16 * hi) * 2u;
                    const unsigned uu[8] = {ug[j][0].x, ug[j][0].y, ug[j][0].z, ug[j][0].w, ug[j][1].x, ug[j][1].y, ug[j][1].z, ug[j][1].w};
                    const unsigned gg[8] = {ug[j][2].x, ug[j][2].y, ug[j][2].z, ug[j][2].w, ug[j][3].x, ug[j][3].y, ug[j][3].z, ug[j][3].w};
                    unsigned o[8];
#pragma unroll
                    for (int q = 0; q < 8; ++q) { const float y0_ = rxt * bflo(uu[q]) * (acc[jj][2 * q] + b0) * fsilu(rxt * bflo(gg[q])), y1_ = rxt * bfhi(uu[q]) * (acc[jj][2 * q + 1] + b0) * fsilu(rxt * bfhi(gg[q])); o[q] = cvtpk(y0_, y1_); }
                    v4u o0, o1; o0.x = o[0]; o0.y = o[1]; o0.z = o[2]; o0.w = o[3]; o1.x = o[4]; o1.y = o[5]; o1.z = o[6]; o1.w = o[7];
                    *(v4u*)(ub + off) = o0; *(v4u*)(ub + off + 16) = o1;
                    if (g + 1 < g1) { ug[j][0] = *(const v4u*)(ub + 512 + off); ug[j][1] = *(const v4u*)(ub + 512 + off + 16); ug[j][2] = *(const v4u*)(gb + 512 + off); ug[j][3] = *(const v4u*)(gb + 512 + off + 16); } } }
        }
#undef P5_LOAD
    }
}

constexpr int LR_XA = 0;
constexpr int LR_XF = 32768, LR_XFS = 68;
constexpr int LR_GA = LR_XF + 128 * LR_XFS * 4;
constexpr int LR_GAS = 144;
constexpr int LR_Y = LR_GA + 128 * LR_GAS;
constexpr int LR_TOT = LR_Y + 128 * LR_GAS;
static_assert(LR_TOT + 8 * 16 * 2 * 4 <= RING_BYTES, "LRU LDS map");
__device__ __forceinline__ void p2_lru(const Frame& F, const Args& args, unsigned char* ws) {
    LAS unsigned char* L = F.lds + RING_OFF;
    const bf16* z0 = (const bf16*)(ws + WS_Z0); bf16* y0 = (bf16*)(ws + WS_Y0); const bf16* WG = (const bf16*)(ws + WS_WG);
    const float* conv_w = args.in[3]; const float* conv_b = args.in[4]; const float* gab = args.in[6]; const float* gxb = args.in[8]; const float* lam = args.in[9];
    int tid = F.wave * 64 + lane_id(); asm volatile("" : "+v"(tid));
    const int lane = tid & 63, w = F.wave, q = lane >> 4, cc = lane & 15, th = w >> 2, ct = w & 3;
    for (int unit = F.vcu; unit < NB * 16; unit += F.G) {
        const int b = unit >> 4, n = (unit >> 1) & 7, hf = unit & 1;
        const size_t row0 = (size_t)b * S;
        bf16x8 bfrag[2][4];
#pragma unroll
        for (int g2 = 0; g2 < 2; ++g2)
#pragma unroll
            for (int ks = 0; ks < 4; ++ks) bfrag[g2][ks] = *(const bf16x8*)(WG + ((size_t)(n * 2 + g2) * 128 + 64 * hf + 16 * ct + cc) * 128 + 32 * ks + 8 * q);
        const int cg = tid & 15, tq = tid >> 4, chc = n * 128 + 8 * cg;
        float cw[4][8], cb[8];
#pragma unroll
        for (int k = 0; k < 4; ++k) { const f32x4 a = *(const f32x4*)(conv_w + k * 1024 + chc), c2 = *(const f32x4*)(conv_w + k * 1024 + chc + 4);
            cw[k][0] = a.x; cw[k][1] = a.y; cw[k][2] = a.z; cw[k][3] = a.w; cw[k][4] = c2.x; cw[k][5] = c2.y; cw[k][6] = c2.z; cw[k][7] = c2.w; }
        { const f32x4 a = *(const f32x4*)(conv_b + chc), c2 = *(const f32x4*)(conv_b + chc + 4); cb[0] = a.x; cb[1] = a.y; cb[2] = a.z; cb[3] = a.w; cb[4] = c2.x; cb[5] = c2.y; cb[6] = c2.z; cb[7] = c2.w; }
        const int chl = n * 128 + 64 * hf + 16 * ct + cc;
        const float ba = -1.4426950408889634f * gab[chl], bx = -1.4426950408889634f * gxb[chl], sp = 8.f * 1.4426950408889634f * log1pf(expf(-lam[chl]));
        float hprev = 0.f;
        const int mt = tid >> 2, mp = tid & 3;
        v4u zr[7], gr[2];
#pragma unroll
        for (int i = 0; i < 7; ++i) { const int t = 4 * tq - 3 + i; zr[i] = (t >= 0) ? *(const v4u*)(z0 + (row0 + t) * NA + chc) : (v4u){0u, 0u, 0u, 0u}; }
#pragma unroll
        for (int i = 0; i < 2; ++i) gr[i] = *(const v4u*)(z0 + (row0 + mt) * NA + 1024 + n * 128 + 64 * hf + 8 * (mp + 4 * i));
        for (int chunk = 0; chunk < 16; ++chunk) {
            const int t0 = chunk * 128; const size_t rowb = row0 + t0;
            __syncthreads();
            { float zf[7][8];
#pragma unroll
              for (int i = 0; i < 7; ++i) { const unsigned u4[4] = {zr[i].x, zr[i].y, zr[i].z, zr[i].w};
#pragma unroll
                  for (int e = 0; e < 4; ++e) { zf[i][2 * e] = bflo(u4[e]); zf[i][2 * e + 1] = bfhi(u4[e]); } }
#pragma unroll
              for (int r = 0; r < 4; ++r) { const int tok = 4 * tq + r; float xa[8];
#pragma unroll
                  for (int e = 0; e < 8; ++e) xa[e] = cb[e] + cw[0][e] * zf[r][e] + cw[1][e] * zf[r + 1][e] + cw[2][e] * zf[r + 2][e] + cw[3][e] * zf[r + 3][e];
                  v4u pk; pk.x = cvtpk(xa[0], xa[1]); pk.y = cvtpk(xa[2], xa[3]); pk.z = cvtpk(xa[4], xa[5]); pk.w = cvtpk(xa[6], xa[7]);
                  *(LAS v4u*)(L + LR_XA + tok * 256 + ((cg ^ ((tok & 3) | ((tok >> 2) & 12))) << 4)) = pk;
                  if ((cg >> 3) == hf) { LAS float* xf = (LAS float*)(L + LR_XF) + tok * LR_XFS + 8 * (cg & 7);
                      *(LAS f32x4*)xf = (f32x4){xa[0], xa[1], xa[2], xa[3]}; *(LAS f32x4*)(xf + 4) = (f32x4){xa[4], xa[5], xa[6], xa[7]}; } } }
#pragma unroll
            for (int i = 0; i < 2; ++i) *(LAS v4u*)(L + LR_GA + mt * LR_GAS + 16 * (mp + 4 * i)) = gr[i];
            if (chunk < 15) {
#pragma unroll
                for (int i = 0; i < 7; ++i) zr[i] = *(const v4u*)(z0 + (rowb + 128 + 4 * tq - 3 + i) * NA + chc);
#pragma unroll
                for (int i = 0; i < 2; ++i) gr[i] = *(const v4u*)(z0 + (rowb + 128 + mt) * NA + 1024 + n * 128 + 64 * hf + 8 * (mp + 4 * i));
            }
            __syncthreads();
            f32x4 acc[2][4];
#define LR_GATES(tt) do { acc[0][tt] = (f32x4){0.f, 0.f, 0.f, 0.f}; acc[1][tt] = (f32x4){0.f, 0.f, 0.f, 0.f}; \
                const int tokg = 64 * th + 16 * (cc >> 2) + 4 * (tt) + (cc & 3);     \
                _Pragma("unroll") for (int ks = 0; ks < 4; ++ks) { const int ck = 4 * ks + q; \
                    const bf16x8 af = *(const LAS bf16x8*)(L + LR_XA + tokg * 256 + ((ck ^ ((tokg & 3) | ((tokg >> 2) & 12))) << 4)); \
                    acc[0][tt] = __builtin_amdgcn_mfma_f32_16x16x32_bf16(af, bfrag[0][ks], acc[0][tt], 0, 0, 0); \
                    acc[1][tt] = __builtin_amdgcn_mfma_f32_16x16x32_bf16(af, bfrag[1][ks], acc[1][tt], 0, 0, 0); } } while (0)
            float Ai[4][4], Hi[4][4];
            float ap = 1.f, hp = 0.f;
            LR_GATES(0);
#pragma unroll
            for (int tt = 0; tt < 4; ++tt) {
                if (tt == 0) LR_GATES(1); else if (tt == 1) LR_GATES(2); else if (tt == 2) LR_GATES(3);
#pragma unroll
                for (int r = 0; r < 4; ++r) { const int tok = 64 * th + 16 * q + 4 * tt + r;
                    const float rg = __builtin_amdgcn_rcpf(1.f + __builtin_amdgcn_exp2f(acc[0][tt][r] + ba)), ig = __builtin_amdgcn_rcpf(1.f + __builtin_amdgcn_exp2f(acc[1][tt][r] + bx));
                    const float a = __builtin_amdgcn_exp2f(-sp * rg);
                    const float xav = ((const LAS float*)(L + LR_XF))[tok * LR_XFS + 16 * ct + cc];
                    const float bt = __builtin_amdgcn_sqrtf(fmaxf(1.f - a * a, 0.f)) * ig * xav;
                    ap *= a; hp = a * hp + bt; Ai[tt][r] = ap; Hi[tt][r] = hp; }
                __builtin_amdgcn_sched_barrier(0); }
#undef LR_GATES
            float pa = 1.f, ph = 0.f, ra = 1.f, rh = 0.f;
#pragma unroll
            for (int qq = 0; qq < 4; ++qq) { const float ta = __shfl(ap, qq * 16 + cc), tb = __shfl(hp, qq * 16 + cc);
                if (qq < q) { ph = ta * ph + tb; pa = ta * pa; }
                rh = ta * rh + tb; ra = ta * ra; }
            if (q == 0) { LAS float* tp = (LAS float*)(L + LR_TOT) + (w * 16 + cc) * 2; tp[0] = ra; tp[1] = rh; }
            __syncthreads();
            { const LAS float* t0p = (const LAS float*)(L + LR_TOT) + (ct * 16 + cc) * 2; const LAS float* t1p = (const LAS float*)(L + LR_TOT) + ((4 + ct) * 16 + cc) * 2;
              const float a0 = t0p[0], h0_ = t0p[1], a1 = t1p[0], h1 = t1p[1];
              const float hmid = a0 * hprev + h0_;
              const float hin = th ? hmid : hprev;
              hprev = a1 * hmid + h1;
              const float hl = pa * hin + ph;
#pragma unroll
              for (int tt = 0; tt < 4; ++tt)
#pragma unroll
                  for (int r = 0; r < 4; ++r) { const int tok = 64 * th + 16 * q + 4 * tt + r; const float h = Ai[tt][r] * hl + Hi[tt][r];
                      const float gv = bf2f(*(const LAS unsigned short*)(L + LR_GA + tok * LR_GAS + (16 * ct + cc) * 2));
                      *(LAS unsigned short*)(L + LR_Y + tok * LR_GAS + (16 * ct + cc) * 2) = (unsigned short)cvtpk(h * fsilu(gv), 0.f); } }
            __syncthreads();
#pragma unroll
            for (int i = 0; i < 2; ++i) *(v4u*)(y0 + (rowb + mt) * GW + n * 128 + 64 * hf + 8 * (mp + 4 * i)) = *(const LAS v4u*)(L + LR_Y + mt * LR_GAS + 16 * (mp + 4 * i));
        }
    }
}

constexpr int AT_KS = 0, AT_VT = 32768, AT_VSTRIDE = 528, AT_BL = AT_VT + 64 * AT_VSTRIDE, AT_QL = AT_BL + 9 * 192 * 4, AT_RS = 144, AT_WAVE = 2 * 32 * AT_RS;
constexpr int AT_QG = AT_QL + 8 * AT_WAVE, AT_SK = AT_QG + 256;
static_assert(AT_SK + 64 <= RING_BYTES, "attention LDS map");
__device__ __forceinline__ void p2_attn(const Frame& F, const Args& args, unsigned char* ws) {
    LAS unsigned char* L = F.lds + RING_OFF;
    const bf16* z0 = (const bf16*)(ws + WS_Z0); bf16* y0 = (bf16*)(ws + WS_Y0); const float* btab = (const float*)(ws + WS_BIAS);
    const float* qg = args.in[10]; const float* kg = args.in[11]; const float* sinks = args.in[12];
    int tid = F.wave * 64 + lane_id(); asm volatile("" : "+v"(tid));
    const int lane = tid & 63, w = F.wave, l31 = lane & 31, hi = lane >> 5;
    const int qt = w & 3, cl = lane >> 4, jl = lane & 15;
    v4u pr[8];
#define AT_LOAD_KV(unit_) do { const int kh_ = (unit_) & 1, qb_ = ((unit_) >> 1) & 15, b_ = (unit_) >> 5; const long tk0_ = (long)qb_ * 128 - 128; \
        _Pragma("unroll") for (int i = 0; i < 4; ++i) { const int idx = tid + 512 * i, c = idx & 7, j = idx >> 3; const long tk = tk0_ + j; \
            pr[i] = (tk >= 0) ? *(const v4u*)(z0 + ((size_t)b_ * S + tk) * NA + 3072 + kh_ * 64 + 8 * c) : (v4u){0u, 0u, 0u, 0u}; } \
        _Pragma("unroll") for (int i = 0; i < 2; ++i) { const int jp = 16 * w + jl, c = 4 * i + cl; const long tk = tk0_ + 2 * jp; \
            if (tk >= 0) { const bf16* vp = z0 + ((size_t)b_ * S + tk) * NA + 3200 + kh_ * 64 + 8 * c; pr[4 + 2 * i] = *(const v4u*)vp; pr[5 + 2 * i] = *(const v4u*)(vp + NA); } \
            else { pr[4 + 2 * i] = (v4u){0u, 0u, 0u, 0u}; pr[5 + 2 * i] = (v4u){0u, 0u, 0u, 0u}; } } } while (0)
    if (F.vcu < NB * 32) AT_LOAD_KV(F.vcu);
    if (tid < 64) ((LAS float*)(L + AT_QG))[tid] = qg[tid]; else if (tid < 80) ((LAS float*)(L + AT_SK))[tid - 64] = sinks[tid - 64] * 1.4426950408889634f;
    for (int unit = F.vcu; unit < NB * 16 * 2; unit += F.G) {
        const int kh = unit & 1, qb = (unit >> 1) & 15, b = unit >> 5;
        __syncthreads();
        const size_t R0 = (size_t)b * S + qb * 128 + 32 * qt;
        LAS unsigned char* QL = L + AT_QL + w * AT_WAVE; LAS unsigned char* GL = QL + 32 * AT_RS;
        const int mrr = lane >> 3, mch = lane & 7;
        const f32x4 kg0 = *(const f32x4*)(kg + 8 * (tid & 7)), kg1 = *(const f32x4*)(kg + 8 * (tid & 7) + 4);
        v4u t0[8];
        { const bf16* qp = z0 + (R0 + mrr) * NA + 2048 + (kh * 8 + (w >> 2)) * 64 + 8 * mch;
#pragma unroll
          for (int i = 0; i < 4; ++i) { t0[i] = *(const v4u*)(qp + (size_t)(8 * i) * NA); t0[4 + i] = *(const v4u*)(qp + (size_t)(8 * i) * NA + 1280); } }
        __builtin_amdgcn_sched_barrier(0);
#pragma unroll
        for (int i = 0; i < 4; ++i) { const int idx = tid + 512 * i, c = idx & 7, j = idx >> 3;
            const unsigned u4[4] = {pr[i].x, pr[i].y, pr[i].z, pr[i].w}; float kf[8], ss = 0.f;
#pragma unroll
            for (int e = 0; e < 4; ++e) { kf[2 * e] = bflo(u4[e]); kf[2 * e + 1] = bfhi(u4[e]); ss += kf[2 * e] * kf[2 * e] + kf[2 * e + 1] * kf[2 * e + 1]; }
            ss += __shfl_xor(ss, 1); ss += __shfl_xor(ss, 2); ss += __shfl_xor(ss, 4);
            const float rk = rsqrtf(ss * (1.f / 64.f) + EPS);
            v4u pk; pk.x = cvtpk(kf[0] * rk * kg0.x, kf[1] * rk * kg0.y); pk.y = cvtpk(kf[2] * rk * kg0.z, kf[3] * rk * kg0.w); pk.z = cvtpk(kf[4] * rk * kg1.x, kf[5] * rk * kg1.y); pk.w = cvtpk(kf[6] * rk * kg1.z, kf[7] * rk * kg1.w);
            *(LAS v4u*)(L + AT_KS + c * 4096 + j * 16) = pk; }
#pragma unroll
        for (int i = 0; i < 2; ++i) { const int jp = 16 * w + jl, c = 4 * i + cl;
            const unsigned a0[4] = {pr[4 + 2 * i].x, pr[4 + 2 * i].y, pr[4 + 2 * i].z, pr[4 + 2 * i].w}, a1[4] = {pr[5 + 2 * i].x, pr[5 + 2 * i].y, pr[5 + 2 * i].z, pr[5 + 2 * i].w};
#pragma unroll
            for (int e = 0; e < 8; ++e) { const unsigned lo = (e & 1) ? (a0[e >> 1] >> 16) : (a0[e >> 1] & 0xffffu), hi2 = (e & 1) ? (a1[e >> 1] & 0xffff0000u) : (a1[e >> 1] << 16);
                *(LAS unsigned*)(L + AT_VT + (8 * c + e) * AT_VSTRIDE + jp * 4) = lo | hi2; } }
#pragma unroll
        for (int i = 0; i < 3; ++i) { const int idx = tid + 512 * i, hh = idx / 192, e = idx - hh * 192, dist = 159 - e;
            const float bv = btab[(kh * 8 + hh) * 128 + min(max(dist, 0), 127)];
            ((LAS float*)(L + AT_BL))[idx] = (dist >= 0 && dist < 128) ? bv * 1.4426950408889634f : -INFINITY; }
        if (tid < 192) ((LAS float*)(L + AT_BL))[8 * 192 + tid] = -INFINITY;
#pragma unroll
        for (int i = 0; i < 4; ++i) { *(LAS v4u*)(QL + (8 * i + mrr) * AT_RS + 16 * mch) = t0[i]; *(LAS v4u*)(GL + (8 * i + mrr) * AT_RS + 16 * mch) = t0[4 + i]; }
        __syncthreads();
#pragma unroll 1
        for (int ti = 0; ti < 4; ++ti) {
            int lt = lane; asm volatile("" : "+v"(lt));
            const int l31 = lt & 31, hi = lt >> 5;
            const int g = (w >> 2) + 2 * ti, hq = kh * 8 + g;
            if (ti > 0) {
#pragma unroll
                for (int i = 0; i < 4; ++i) { *(LAS v4u*)(QL + (8 * i + mrr) * AT_RS + 16 * mch) = pr[i]; *(LAS v4u*)(GL + (8 * i + mrr) * AT_RS + 16 * mch) = pr[4 + i]; } }
            if (ti < 3) { const bf16* qp = z0 + (R0 + mrr) * NA + 2048 + (hq + 2) * 64 + 8 * mch;
#pragma unroll
                for (int i = 0; i < 4; ++i) { pr[i] = *(const v4u*)(qp + (size_t)(8 * i) * NA); pr[4 + i] = *(const v4u*)(qp + (size_t)(8 * i) * NA + 1280); } }
            else if (unit + F.G < NB * 32) AT_LOAD_KV(unit + F.G);
            asm volatile("s_waitcnt lgkmcnt(0)" ::: "memory");
            bf16x8 qf[4];
            { float ss = 0.f; float qv[4][8];
#pragma unroll
              for (int ds = 0; ds < 4; ++ds) { const v4u qr = *(const LAS v4u*)(QL + l31 * AT_RS + (16 * ds + 8 * hi) * 2); const unsigned u4[4] = {qr.x, qr.y, qr.z, qr.w};
#pragma unroll
                  for (int e = 0; e < 4; ++e) { qv[ds][2 * e] = bflo(u4[e]); qv[ds][2 * e + 1] = bfhi(u4[e]); ss += qv[ds][2 * e] * qv[ds][2 * e] + qv[ds][2 * e + 1] * qv[ds][2 * e + 1]; } }
              ss += __shfl_xor(ss, 32);
              const float rq = rsqrtf(ss * (1.f / 64.f) + EPS) * (0.125f * 1.4426950408889634f);
#pragma unroll
              for (int ds = 0; ds < 4; ++ds) { const f32x4 g0 = *(const LAS f32x4*)(L + AT_QG + (16 * ds + 8 * hi) * 4), g1 = *(const LAS f32x4*)(L + AT_QG + (16 * ds + 8 * hi + 4) * 4);
                  v4u pk; pk.x = cvtpk(qv[ds][0] * rq * g0.x, qv[ds][1] * rq * g0.y); pk.y = cvtpk(qv[ds][2] * rq * g0.z, qv[ds][3] * rq * g0.w);
                  pk.z = cvtpk(qv[ds][4] * rq * g1.x, qv[ds][5] * rq * g1.y); pk.w = cvtpk(qv[ds][6] * rq * g1.z, qv[ds][7] * rq * g1.w);
                  qf[ds] = __builtin_bit_cast(bf16x8, pk); } }
            const float sink = ((const LAS float*)(L + AT_SK))[hq]; float m = sink;
            const LAS float* bl = (const LAS float*)(L + AT_BL) + g * 192 - (l31 - 4 * hi);
            const LAS float* blinf = (const LAS float*)(L + AT_BL) + 8 * 192 - (l31 - 4 * hi);
            f32x16 o[3];
            const f32x16 zero16 = (f32x16){0.f, 0.f, 0.f, 0.f, 0.f, 0.f, 0.f, 0.f, 0.f, 0.f, 0.f, 0.f, 0.f, 0.f, 0.f, 0.f};
            v4u onesv; onesv.x = onesv.y = onesv.z = onesv.w = (l31 == 0) ? 0x3f803f80u : 0u; const bf16x8 onesf = __builtin_bit_cast(bf16x8, onesv);
#pragma unroll
            for (int kk = 0; kk < 5; ++kk) {
                f32x16 a;
#pragma unroll
                for (int r = 0; r < 16; ++r) a[r] = ((qb == 0 && qt + kk < 4) ? blinf : bl)[31 + 32 * kk + (r & 3) + 8 * (r >> 2)];
#pragma unroll
                for (int ds = 0; ds < 4; ++ds) { const bf16x8 kf = *(const LAS bf16x8*)(L + AT_KS + (2 * ds + hi) * 4096 + (32 * (qt + kk) + l31) * 16);
                    a = __builtin_amdgcn_mfma_f32_32x32x16_bf16(kf, qf[ds], a, 0, 0, 0); }
                float tm = fmaxf(fmaxf(a[0], a[1]), a[2]);
#pragma unroll
                for (int r = 3; r < 15; r += 2) tm = fmaxf(fmaxf(tm, a[r]), a[r + 1]);
                tm = fmaxf(tm, a[15]);
                tm = fmaxf(tm, __shfl_xor(tm, 32));
                if (kk == 0) m = fmaxf(m, tm);
                else { const float mn = fmaxf(m, tm), f = __builtin_amdgcn_exp2f(m - mn); m = mn;
#pragma unroll
                    for (int r = 0; r < 16; ++r) { o[0][r] *= f; o[1][r] *= f; }
                    o[2][0] *= f; }
#pragma unroll
                for (int r = 0; r < 16; ++r) a[r] = __builtin_amdgcn_exp2f(a[r] - m);
#pragma unroll
                for (int s = 0; s < 2; ++s) { v4u pk; pk.x = cvtpk(a[8 * s], a[8 * s + 1]); pk.y = cvtpk(a[8 * s + 2], a[8 * s + 3]); pk.z = cvtpk(a[8 * s + 4], a[8 * s + 5]); pk.w = cvtpk(a[8 * s + 6], a[8 * s + 7]);
                    const bf16x8 pf = __builtin_bit_cast(bf16x8, pk);
#pragma unroll
                    for (int dt = 0; dt < 2; ++dt) { const LAS unsigned char* vp = L + AT_VT + (32 * dt + l31) * AT_VSTRIDE + (32 * (qt + kk) + 16 * s + 4 * hi) * 2;
                        const unsigned long long lo = *(const LAS unsigned long long*)vp, hi8 = *(const LAS unsigned long long*)(vp + 16);
                        v4u vv; vv.x = (unsigned)lo; vv.y = (unsigned)(lo >> 32); vv.z = (unsigned)hi8; vv.w = (unsigned)(hi8 >> 32);
                        o[dt] = __builtin_amdgcn_mfma_f32_32x32x16_bf16(__builtin_bit_cast(bf16x8, vv), pf, (kk == 0 && s == 0) ? zero16 : o[dt], 0, 0, 0); }
                    o[2] = __builtin_amdgcn_mfma_f32_32x32x16_bf16(onesf, pf, (kk == 0 && s == 0) ? zero16 : o[2], 0, 0, 0); }
 }
            const float sum = __shfl(o[2][0], l31);
            const float inv = __builtin_amdgcn_rcpf(sum + __builtin_amdgcn_exp2f(sink - m));
#pragma unroll
            for (int dt = 0; dt < 2; ++dt)
#pragma unroll
                for (int k = 0; k < 4; ++k) { LAS unsigned long long* gp = (LAS unsigned long long*)(GL + l31 * AT_RS + (32 * dt + 8 * k + 4 * hi) * 2); const unsigned long long gv = *gp;
                    const unsigned glo = (unsigned)gv, ghi = (unsigned)(gv >> 32);
                    const float y0_ = o[dt][4 * k] * inv * fsilu(bflo(glo)), y1_ = o[dt][4 * k + 1] * inv * fsilu(bfhi(glo)), y2_ = o[dt][4 * k + 2] * inv * fsilu(bflo(ghi)), y3_ = o[dt][4 * k + 3] * inv * fsilu(bfhi(ghi));
                    *gp = (unsigned long long)cvtpk(y0_, y1_) | ((unsigned long long)cvtpk(y2_, y3_) << 32); }
            asm volatile("s_waitcnt lgkmcnt(0)" ::: "memory");
            { bf16* op = y0 + (R0 + mrr) * GW + 1024 + hq * 64 + 8 * mch;
#pragma unroll
              for (int i = 0; i < 4; ++i) *(v4u*)(op + (size_t)(8 * i) * GW) = *(const LAS v4u*)(GL + (8 * i + mrr) * AT_RS + 16 * mch); }
        }
    }
#undef AT_LOAD_KV
}


#ifndef WGM_G1
#define WGM_G1 4
#endif
#ifndef WGM_G2
#define WGM_G2 4
#endif
#ifndef WGM_G3
#define WGM_G3 4
#endif
#ifndef WGM_G4
#define WGM_G4 4
#endif
__global__ void __launch_bounds__(NWAVES * 64, 2) mega(Args args) {
    extern __shared__ __attribute__((aligned(16))) unsigned char lds[];
    Frame F;
    F.lds = (LAS unsigned char*)lds;
    F.MISC = (volatile LAS unsigned*)(F.lds + MISC_OFF);
    F.wave = __builtin_amdgcn_readfirstlane((int)threadIdx.x >> 6);
    F.G = gridDim.x; { const int bx = blockIdx.x; F.vcu = (F.G % 8 == 0) ? (bx % 8) * (F.G / 8) + bx / 8 : bx; }
    unsigned char* ws = args.ws;
    F.ctl = (gu32*)(ws + WS_CTL);
    for (int u = threadIdx.x; u < (LDS_BYTES - LDSCTL_OFF) / 4; u += NWAVES * 64) ((LAS unsigned*)(F.lds + LDSCTL_OFF))[u] = 0u;
    __syncthreads();
    const int lo = args.ph_lo, hi = args.ph_hi;
    const bool multi = (hi - lo) > 1;
    XcdBarrier bar; bar.bar = (unsigned*)(F.ctl + CW_BAR); bar.x = 0; bar.st = nullptr;
    if (multi) bar = xcd_barrier_post((unsigned*)(F.ctl + CW_BAR), F.MISC + 8);
    bar.wave = F.wave;
#define IN(k) (lo <= (k) && (k) < hi)
#define BOTH(k) (IN(k) && IN((k) + 1))
#define GRID_BAR() xcd_barrier(bar)
#define WSP(T, off) ((T*)(args.ws + (off)))
#define GDUMMY WSP(unsigned, WS_CTL + 512 * 1024)

    if (IN(0)) { p0_prologue(F, args, ws); if (BOTH(0)) GRID_BAR(); }
    if (IN(1)) {
        pg8::Gemm g{(const bf16*)args.out, WSP(bf16, WS_WAT), M, NA, D, GDUMMY}; pg8::StaticOrder So; So.init(M, NA, F.G, (int)blockIdx.x, WGM_G1);
        pg8::EpiZ0 E{WSP(bf16, WS_Z0), NA};
        { const int nun = (M / 256) * (NA / 256), full = nun / F.G, rem = nun - full * F.G;
          if (rem > 0 && (int)blockIdx.x >= rem) { p0_layer1_weights(F, args, ws, (int)blockIdx.x - rem, F.G - rem); __syncthreads(); }
          else if (rem == 0) { p0_layer1_weights(F, args, ws, (int)blockIdx.x, F.G); __syncthreads(); } }
        pg8::gemm_phase<pg8::EpiZ0, pg8::StaticOrder, true, true>(F.lds + RING_OFF, g, So, E, F.wave);
        if (BOTH(1)) GRID_BAR();
    }
#ifndef REPS_LRU
#define REPS_LRU 1
#endif
#ifndef REPS_ATT
#define REPS_ATT 1
#endif
    if (IN(2)) { for (int rp = 0; rp < REPS_LRU; ++rp) { p2_lru(F, args, ws); if (rp + 1 < REPS_LRU) __syncthreads(); } for (int rp = 0; rp < REPS_ATT; ++rp) { p2_attn(F, args, ws); if (rp + 1 < REPS_ATT) __syncthreads(); } if (BOTH(2)) GRID_BAR(); }
    if (IN(3)) {
        pg8::Gemm g{WSP(bf16, WS_Y0), WSP(bf16, WS_WOAT), M, D, GW, GDUMMY}; pg8::StaticOrder So; So.init(M, D, F.G, (int)blockIdx.x, WGM_G2);
        pg8::EpiRes1 E{args.in[0], WSP(bf16, WS_X1B), WSP(float, WS_SSQ)};
        pg8::gemm_phase<pg8::EpiRes1, pg8::StaticOrder, true, true>(F.lds + RING_OFF, g, So, E, F.wave);
        if (BOTH(3)) GRID_BAR();
    }
    if (IN(4)) {
        pg8::Gemm g{WSP(bf16, WS_X1B), WSP(bf16, WS_WCT), M, NC, D, GDUMMY}; pg8::StaticOrder So; So.init(M, NC, F.G, (int)blockIdx.x, WGM_G3);
        pg8::EpiZ1 E{WSP(bf16, WS_U), (size_t)(WS_V - WS_U) / 2, WSP(float, WS_VST)};
        pg8::gemm_phase<pg8::EpiZ1, pg8::StaticOrder, true, true>(F.lds + RING_OFF, g, So, E, F.wave);
        if (BOTH(4)) GRID_BAR();
    }
    if (IN(5)) { p5_gate(F, args, ws); if (BOTH(5)) GRID_BAR(); }
    if (IN(6)) {
        pg8::Gemm g{WSP(bf16, WS_U), WSP(bf16, WS_WOCT), M, D, GW, GDUMMY}; pg8::StaticOrder So; So.init(M, D, F.G, (int)blockIdx.x, WGM_G4);
        pg8::EpiRes3 E{WSP(bf16, WS_X1B), args.out};
        pg8::gemm_phase<pg8::EpiRes3, pg8::StaticOrder, true, true>(F.lds + RING_OFF, g, So, E, F.wave);
    }
#undef WSP
#undef GDUMMY
#undef IN
#undef BOTH
}


static void launch_mega(const Args& a0, int lo, int hi, int grid, hipStream_t stream) {
    Args a = a0; a.ph_lo = lo; a.ph_hi = hi;
    hipLaunchKernelGGL(mega, dim3(grid), dim3(NWAVES * 64), LDS_BYTES, stream, a);
    const hipError_t le = hipPeekAtLastError();
    if (le != hipSuccess) fprintf(stderr, "kernel_launch: mega launch [%d,%d) failed: %s\n", lo, hi, hipGetErrorName(le));
}

extern "C" void kernel_launch(void* const* d_in, const int* in_sizes, int n_in, void* d_out, int out_size, void* d_ws, size_t ws_size, hipStream_t stream) {
    static int grid = 0;
    if (grid == 0) {
        if (n_in != 22 || in_sizes[0] != M * D || out_size != M * D || ws_size < WS_END) {
            fprintf(stderr, "kernel_launch: unexpected shapes: n_in %d in0 %d out %d ws %zu\n", n_in, n_in > 0 ? in_sizes[0] : -1, out_size, ws_size); grid = -1; return; }
        int dev = 0, cus = 0, per_cu = 0;
        if (hipGetDevice(&dev) != hipSuccess || hipDeviceGetAttribute(&cus, hipDeviceAttributeMultiprocessorCount, dev) != hipSuccess) { fprintf(stderr, "kernel_launch: device query failed\n"); grid = -1; return; }
        if (hipFuncSetAttribute((const void*)mega, hipFuncAttributeMaxDynamicSharedMemorySize, LDS_BYTES) != hipSuccess) { fprintf(stderr, "kernel_launch: hipFuncSetAttribute failed\n"); grid = -1; return; }
        if (hipOccupancyMaxActiveBlocksPerMultiprocessor(&per_cu, (const void*)mega, NWAVES * 64, LDS_BYTES) != hipSuccess || per_cu < 1)
            fprintf(stderr, "kernel_launch: note: occupancy query reports %d workgroups per CU\n", per_cu);
        (void)hipGetLastError();
        grid = cus;
    }
    if (grid < 0) return;
    unsigned char* ws = (unsigned char*)d_ws; float* out = (float*)d_out;
    if (hipMemsetAsync(ws + WS_CTL, 0, CTL_ZERO_BYTES, stream) != hipSuccess) { fprintf(stderr, "kernel_launch: memset failed\n"); return; }
    Args a{};
    for (int i = 0; i < 22; ++i) a.in[i] = (const float*)d_in[i];
    a.out = out; a.ws = ws;

#ifndef N_LAUNCHES
#define N_LAUNCHES 1
#endif
#ifndef PROBE_DUP
#define PROBE_DUP 0
#endif
#if N_LAUNCHES == 1
    launch_mega(a, 0, 7, grid, stream);
#else
    for (int ph = 0; ph < 7; ++ph) { launch_mega(a, ph, ph + 1, grid, stream); if ((PROBE_DUP >> ph) & 1) launch_mega(a, ph, ph + 1, grid, stream); }
#endif
}
```

```cpp
#include <hip/hip_runtime.h>
#include <cstdint>
#include <cstdio>

typedef unsigned short bf16;
constexpr int D = 1024, NB = 16, S = 2048, M = NB * S;
constexpr int NA = 4352, NC = 6144, GW = 2048;
constexpr float EPS = 1e-6f;
constexpr size_t MiB = 1u << 20;
constexpr size_t WS_CTL = 0, CTL_ZERO_BYTES = 1 * MiB;
constexpr size_t WS_BIAS = 1 * MiB;
constexpr size_t WS_WAT = 2 * MiB;
constexpr size_t WS_WOAT = 11 * MiB;
constexpr size_t WS_WCT = 15 * MiB;
constexpr size_t WS_WOCT = 27 * MiB;
constexpr size_t WS_WG = 31 * MiB;
constexpr size_t WS_WS = 31 * MiB + 512 * 1024;
constexpr size_t WS_SSQ = 32 * MiB;
constexpr size_t WS_VST = 34 * MiB;
constexpr size_t WS_Z0 = 48 * MiB;
constexpr size_t WS_Y0 = 320 * MiB;
constexpr size_t WS_X1B = 448 * MiB;
constexpr size_t WS_U = 48 * MiB, WS_V = 176 * MiB, WS_G = 304 * MiB;
constexpr size_t WS_END = 512 * MiB;

__device__ __forceinline__ unsigned f2bf(float f) { unsigned u = __builtin_bit_cast(unsigned, f); return (u + 0x7fffu + ((u >> 16) & 1u)) >> 16; }
__device__ __forceinline__ float bf2f(unsigned h) { return __builtin_bit_cast(float, h << 16); }

namespace pg8 {
#define PG8_LAS __attribute__((address_space(3)))
typedef unsigned short bf16_t;
typedef short bf16x8 __attribute__((ext_vector_type(8)));
typedef float f32x4 __attribute__((ext_vector_type(4)));
typedef unsigned u32x4 __attribute__((ext_vector_type(4)));
constexpr int BM = 256, BK = 64, HALF = 128, HTB = HALF * BK * 2  , STAGE_BYTES = 8 * HTB, NXCD = 8, WGM = 4;

__host__ __device__ __forceinline__ int lds_byte(int r, int c) { const int st = (r >> 4) * 2 + (c >> 5), rr = r & 15, cc = c & 31, ob = rr * 64 + cc * 2; return st * 1024 + (ob ^ (((ob >> 9) & 1) << 5)); }
__host__ __device__ __forceinline__ void stage_rc(int b, int& R, int& C) { const int st = b / 1024, sb = b % 1024, swz = sb ^ (((sb >> 9) & 1) << 5); R = (st >> 1) * 16 + swz / 64; C = (st & 1) * 32 + (swz % 64) / 2; }
__host__ __device__ __forceinline__ int perm32(int rho) { const int n = rho >> 4, i = rho & 15; return 8 * (i >> 2) + 4 * n + (i & 3); }

struct Unit { int pm, pn; };
struct Gemm { const bf16_t* A; const bf16_t* Bt; int M, N, K; unsigned* dummy; };

struct StaticOrder {
    int nM, nN, nwg, G, c, wgm;
    __host__ __device__ void init(int M, int N, int G_, int c_, int wgm_ = WGM) { nM = M / BM; nN = N / BM; nwg = nM * nN; G = G_; c = c_; wgm = wgm_; }
    __host__ __device__ bool next(int i, Unit& u) const {
        const long L = (long)i * G + c; if (L >= nwg) return false;
        int wgid = (int)L; { const int q = nwg / NXCD, r = nwg % NXCD, xcd = wgid % NXCD, off = wgid / NXCD; wgid = (xcd < r ? xcd * (q + 1) : r * (q + 1) + (xcd - r) * q) + off; }
        const int nig = wgm * nN, gid = wgid / nig, fm = gid * wgm, gsz = (nM - fm) < wgm ? (nM - fm) : wgm;
        u.pm = fm + ((wgid % nig) % gsz); u.pn = (wgid % nig) / gsz; return true;
    }
    __device__ __forceinline__ void a_ready(const Unit&) const {}
    __device__ __forceinline__ void done(const Unit&) const {}
};
__device__ __forceinline__ unsigned cvt_pk_bf16(float lo, float hi) { unsigned r; asm volatile("v_cvt_pk_bf16_f32 %0, %1, %2" : "=v"(r) : "v"(lo), "v"(hi)); return r; }
typedef float f32x2 __attribute__((ext_vector_type(2)));
typedef unsigned u32x2 __attribute__((ext_vector_type(2)));
#ifndef REPS_Z0
#define REPS_Z0 1
#endif
#ifndef REPS_R1
#define REPS_R1 1
#endif
#ifndef REPS_Z1
#define REPS_Z1 1
#endif
struct EpiZ0 {
    static constexpr bool PERM = true, AFTER_DRAIN = false; static constexpr int REPS = REPS_Z0, NST = 16;
    bf16_t* O; int ldc;
    __device__ __forceinline__ void operator()(const f32x4 (&acc)[2][2][4][2], const Unit& u, int wr, int wc, int fr, int fq) const {
        const int row0 = u.pm * BM + wr * 64 + fr, col0 = u.pn * BM + wc * 32 + 8 * fq;
#pragma unroll
        for (int ai = 0; ai < 2; ++ai)
#pragma unroll
            for (int m = 0; m < 4; ++m) { bf16_t* rowp = O + (size_t)(row0 + ai * HALF + m * 16) * ldc + col0;
#pragma unroll
                for (int bj = 0; bj < 2; ++bj) { const f32x4 v0 = acc[ai][bj][m][0], v1 = acc[ai][bj][m][1];
                    u32x4 w; w.x = cvt_pk_bf16(v0[0], v0[1]); w.y = cvt_pk_bf16(v0[2], v0[3]); w.z = cvt_pk_bf16(v1[0], v1[1]); w.w = cvt_pk_bf16(v1[2], v1[3]);
                    *(u32x4*)(rowp + bj * HALF) = w; } }
    }
};
struct EpiRes1 {
    static constexpr bool PERM = true, AFTER_DRAIN = false; static constexpr int REPS = REPS_R1, NST = 24;
    const float* resid; bf16_t* x1b; float* ssq;
    __device__ __forceinline__ void operator()(const f32x4 (&acc)[2][2][4][2], const Unit& u, int wr, int wc, int fr, int fq) const {
        const int row0 = u.pm * BM + wr * 64 + fr, col0 = u.pn * BM + wc * 32 + 8 * fq;
#pragma unroll
        for (int ai = 0; ai < 2; ++ai)
#pragma unroll
            for (int m = 0; m < 4; ++m) { const int row = row0 + ai * HALF + m * 16; const size_t off = (size_t)row * 1024 + col0; float s = 0.f;
#pragma unroll
                for (int bj = 0; bj < 2; ++bj) {
                    const f32x4 r0 = __builtin_nontemporal_load((const f32x4*)(resid + off + bj * HALF)), r1 = __builtin_nontemporal_load((const f32x4*)(resid + off + bj * HALF + 4));
                    const f32x4 v0 = acc[ai][bj][m][0] + r0, v1 = acc[ai][bj][m][1] + r1;
                    u32x4 w; w.x = cvt_pk_bf16(v0[0], v0[1]); w.y = cvt_pk_bf16(v0[2], v0[3]); w.z = cvt_pk_bf16(v1[0], v1[1]); w.w = cvt_pk_bf16(v1[2], v1[3]);
                    *(u32x4*)(x1b + off + bj * HALF) = w;
                    s += (v0[0] * v0[0] + v0[1] * v0[1]) + (v0[2] * v0[2] + v0[3] * v0[3]) + (v1[0] * v1[0] + v1[1] * v1[1]) + (v1[2] * v1[2] + v1[3] * v1[3]); }
                s += __shfl_xor(s, 16); s += __shfl_xor(s, 32);
                if (fq == 0) ssq[(size_t)row * 16 + u.pn * 4 + wc] = s; }
    }
};
struct EpiZ1 {
    static constexpr bool PERM = true, AFTER_DRAIN = false; static constexpr int REPS = REPS_Z1, NST = 16;
    bf16_t* O; size_t split_stride; float* vst;
    __device__ __forceinline__ void operator()(const f32x4 (&acc)[2][2][4][2], const Unit& u, int wr, int wc, int fr, int fq) const {
        const int row0 = u.pm * BM + wr * 64 + fr; const int t = u.pn >> 3, colt = (u.pn & 7) * BM;
        bf16_t* base = O + (size_t)t * split_stride; const int col0 = colt + wc * 32 + 8 * fq;
#pragma unroll
        for (int ai = 0; ai < 2; ++ai)
#pragma unroll
            for (int m = 0; m < 4; ++m) { const int row = row0 + ai * HALF + m * 16;
                bf16_t* rowp = base + (size_t)row * 2048 + col0; float s1 = 0.f, s2 = 0.f;
#pragma unroll
                for (int bj = 0; bj < 2; ++bj) { const f32x4 v0 = acc[ai][bj][m][0], v1 = acc[ai][bj][m][1];
                    u32x4 w; w.x = cvt_pk_bf16(v0[0], v0[1]); w.y = cvt_pk_bf16(v0[2], v0[3]); w.z = cvt_pk_bf16(v1[0], v1[1]); w.w = cvt_pk_bf16(v1[2], v1[3]);
                    *(u32x4*)(rowp + bj * HALF) = w;
                    if (t == 1) { s1 += ((v0[0] + v0[1]) + (v0[2] + v0[3])) + ((v1[0] + v1[1]) + (v1[2] + v1[3]));
                        s2 += (v0[0] * v0[0] + v0[1] * v0[1]) + (v0[2] * v0[2] + v0[3] * v0[3]) + (v1[0] * v1[0] + v1[1] * v1[1]) + (v1[2] * v1[2] + v1[3] * v1[3]); } }
                if (t == 1) { s1 += __shfl_xor(s1, 16); s1 += __shfl_xor(s1, 32); s2 += __shfl_xor(s2, 16); s2 += __shfl_xor(s2, 32);
                    if (fq == 0) { f32x2 o; o.x = s1; o.y = s2; *(f32x2*)(vst + ((size_t)row * 32 + (u.pn & 7) * 4 + wc) * 2) = o; } } }
    }
};
struct EpiRes3 {
    static constexpr bool PERM = true, AFTER_DRAIN = false; static constexpr int REPS = 1, NST = 32;
    const bf16_t* x1b; float* out;
    __device__ __forceinline__ void operator()(const f32x4 (&acc)[2][2][4][2], const Unit& u, int wr, int wc, int fr, int fq) const {
        const int row0 = u.pm * BM + wr * 64 + fr, col0 = u.pn * BM + wc * 32 + 8 * fq;
#pragma unroll
        for (int ai = 0; ai < 2; ++ai)
#pragma unroll
            for (int m = 0; m < 4; ++m) { const size_t off = (size_t)(row0 + ai * HALF + m * 16) * 1024 + col0;
#pragma unroll
                for (int bj = 0; bj < 2; ++bj) { const u32x4 xb = *(const u32x4*)(x1b + off + bj * HALF);
                    f32x4 r0, r1; r0[0] = __builtin_bit_cast(float, xb.x << 16); r0[1] = __builtin_bit_cast(float, xb.x & 0xffff0000u); r0[2] = __builtin_bit_cast(float, xb.y << 16); r0[3] = __builtin_bit_cast(float, xb.y & 0xffff0000u);
                    r1[0] = __builtin_bit_cast(float, xb.z << 16); r1[1] = __builtin_bit_cast(float, xb.z & 0xffff0000u); r1[2] = __builtin_bit_cast(float, xb.w << 16); r1[3] = __builtin_bit_cast(float, xb.w & 0xffff0000u);
                    __builtin_nontemporal_store(acc[ai][bj][m][0] + r0, (f32x4*)(out + off + bj * HALF)); __builtin_nontemporal_store(acc[ai][bj][m][1] + r1, (f32x4*)(out + off + bj * HALF + 4)); } }
    }
};
#ifndef PROBE_KDUP
#define PROBE_KDUP 0
#endif
template <class Epi, class Sched, bool ALIGN_EPI = false, bool SP2 = false>
__device__ __forceinline__ void gemm_phase(PG8_LAS unsigned char* lds, const Gemm g, const Sched& S, const Epi& E, const int wave_in) {
    const int wid = wave_in; int lane = (int)__builtin_amdgcn_mbcnt_hi(~0u, __builtin_amdgcn_mbcnt_lo(~0u, 0u)); asm volatile("" : "+v"(lane));
    const int tid = wid * 64 + lane, wr = wid >> 2, wc = wid & 3, fr = lane & 15, fq = lane >> 4;
    const int K = g.K, nt = K / BK;
    unsigned voffA[2], voffB[2];
#pragma unroll
    for (int i = 0; i < 2; ++i) { int R, C; stage_rc(tid * 16 + i * 8192, R, C); const int Rb = Epi::PERM ? ((R & ~31) + perm32(R & 31)) : R;
        voffA[i] = (unsigned)(R * K + C) * 2u; voffB[i] = (unsigned)(Rb * K + C) * 2u; }
    const size_t kstep = (size_t)(BK * 2);
    const size_t hstep = (size_t)HALF * K * 2;
    const size_t tstep = 2 * hstep;
    const unsigned ldsw = (unsigned)wid * 1024u;
    const int aoff = lds_byte(wr * 64 + fr, fq * 8); int boff = lds_byte(wc * 32 + fr, fq * 8) + 4 * HTB; asm volatile("" : "+v"(boff));
#define PG8_SA(b, h) (((b) * 2 + (h)) * HTB)
#define PG8_SB(b, h) ((4 + (b) * 2 + (h)) * HTB)
#define PG8_SBR(b, h) (((b) * 2 + (h)) * HTB)
#define PG8_STAGE(bufoff, gbase, voff) do { _Pragma("unroll") for (int _i = 0; _i < 2; ++_i) \
        __builtin_amdgcn_global_load_lds((const unsigned*)((const char*)(gbase) + (voff)[_i]), (PG8_LAS unsigned*)(lds + (bufoff) + ldsw + _i * 8192), 16, 0, 0); } while (0)
#define PG8_LDA(dst, b, h) do { _Pragma("unroll") for (int m = 0; m < 4; ++m) _Pragma("unroll") for (int k = 0; k < 2; ++k) dst[m][k] = *(const PG8_LAS bf16x8*)(lds + PG8_SA(b, h) + aoff + m * 2048 + k * 1024); } while (0)
#define PG8_LDB(dst, b, h) do { _Pragma("unroll") for (int n = 0; n < 2; ++n) _Pragma("unroll") for (int k = 0; k < 2; ++k) dst[n][k] = *(const PG8_LAS bf16x8*)(lds + boff + (PG8_SBR(b, h) + n * 2048 + k * 1024)); } while (0)
#define PG8_MMA(ai, bj, At, Bt) do { __builtin_amdgcn_s_setprio(1); _Pragma("unroll") for (int m = 0; m < 4; ++m) _Pragma("unroll") for (int n = 0; n < 2; ++n) _Pragma("unroll") for (int k = 0; k < 2; ++k) \
        acc[ai][bj][m][n] = __builtin_amdgcn_mfma_f32_16x16x32_bf16(Bt[n][k], At[m][k], acc[ai][bj][m][n], 0, 0, 0); __builtin_amdgcn_s_setprio(0); } while (0)
#define PG8_WAIT_V(n) asm volatile("s_waitcnt vmcnt(" #n ")" ::: "memory")
#define PG8_WAIT_VX(n) asm volatile("s_waitcnt vmcnt(%0)" :: "i"(n) : "memory")
#define PG8_WAIT_L(n) asm volatile("s_waitcnt lgkmcnt(" #n ")" ::: "memory")
#define PG8_BAR __builtin_amdgcn_s_barrier()
#define PG8_SCHED __builtin_amdgcn_sched_barrier(0)
#define PG8_SP2_BODY(W01) do { \
            PG8_LDB(B0, 0, 0); PG8_LDB(B1, 0, 1); PG8_SCHED; PG8_LDA(At, 0, 0); PG8_STAGE(PG8_SA(1, 1), a1 + hstep, voffA); \
            W01; PG8_WAIT_L(0); PG8_BAR; PG8_MMA(0, 0, At, B0); PG8_MMA(0, 1, At, B1); PG8_BAR; PG8_SCHED; \
            PG8_LDA(At, 0, 1); PG8_STAGE(PG8_SB(0, 0), b2, voffB); PG8_STAGE(PG8_SB(0, 1), b2 + hstep, voffB); PG8_STAGE(PG8_SA(0, 0), a2, voffA); \
            W01; PG8_WAIT_L(0); PG8_BAR; PG8_MMA(1, 0, At, B0); PG8_MMA(1, 1, At, B1); PG8_BAR; PG8_SCHED; \
            PG8_LDB(B0, 1, 0); PG8_LDB(B1, 1, 1); PG8_SCHED; PG8_LDA(At, 1, 0); PG8_STAGE(PG8_SA(0, 1), a2 + hstep, voffA); \
            PG8_WAIT_V(8); PG8_WAIT_L(0); PG8_BAR; PG8_MMA(0, 0, At, B0); PG8_MMA(0, 1, At, B1); PG8_BAR; PG8_SCHED; \
            PG8_LDA(At, 1, 1); PG8_STAGE(PG8_SB(1, 0), b3, voffB); PG8_STAGE(PG8_SB(1, 1), b3 + hstep, voffB); PG8_STAGE(PG8_SA(1, 0), a3, voffA); \
            PG8_WAIT_V(8); PG8_WAIT_L(0); PG8_BAR; PG8_MMA(1, 0, At, B0); PG8_MMA(1, 1, At, B1); PG8_BAR; PG8_SCHED; \
            } while (0)
    Unit cur, nxt; int ui = 0;
    if (!S.next(0, cur)) return;
    f32x4 acc[2][2][4][2];
#pragma unroll
    for (int a = 0; a < 2; ++a)
#pragma unroll
        for (int b = 0; b < 2; ++b)
#pragma unroll
            for (int m = 0; m < 4; ++m)
#pragma unroll
                for (int n = 0; n < 2; ++n) acc[a][b][m][n] = (f32x4){0.f, 0.f, 0.f, 0.f};
    bf16x8 At[4][2], B0[2][2], B1[2][2];
    const char* cA = (const char*)g.A + (size_t)cur.pm * tstep; const char* cB = (const char*)g.Bt + (size_t)cur.pn * tstep;
    S.a_ready(cur);
    if constexpr (SP2) {
        PG8_STAGE(PG8_SB(0, 0), cB, voffB); PG8_STAGE(PG8_SB(0, 1), cB + hstep, voffB); PG8_STAGE(PG8_SA(0, 0), cA, voffA); PG8_STAGE(PG8_SA(0, 1), cA + hstep, voffA);
        if (wr == 1) PG8_BAR;
        PG8_WAIT_V(2); PG8_BAR;
        PG8_STAGE(PG8_SB(1, 0), cB + kstep, voffB); PG8_STAGE(PG8_SA(1, 0), cA + kstep, voffA); PG8_STAGE(PG8_SB(1, 1), cB + hstep + kstep, voffB);
        PG8_WAIT_V(6); PG8_BAR;
    } else {
        PG8_STAGE(PG8_SB(0, 0), cB, voffB); PG8_STAGE(PG8_SA(0, 0), cA, voffA); PG8_STAGE(PG8_SB(0, 1), cB + hstep, voffB); PG8_STAGE(PG8_SA(0, 1), cA + hstep, voffA);
        if (wr == 1) PG8_BAR;
        PG8_WAIT_V(4); PG8_BAR;
        PG8_STAGE(PG8_SB(1, 0), cB + kstep, voffB); PG8_STAGE(PG8_SA(1, 0), cA + kstep, voffA); PG8_STAGE(PG8_SB(1, 1), cB + hstep + kstep, voffB);
        PG8_WAIT_V(6); PG8_BAR;
    }
    if constexpr (SP2) {
        const unsigned* dmb = g.dummy + ((size_t)blockIdx.x * 8 + wid) * 64;
        const unsigned dmo = (unsigned)lane * 4u;
#pragma unroll
        for (int i = 0; i < Epi::NST; ++i) asm volatile("global_store_dword %0, %0, %1\n\ts_nop 0" :: "v"(dmo), "s"(dmb) : "memory");
    }
    for (;;) {
        const bool has_next = S.next((ui + 1) >> PROBE_KDUP, nxt);
        const char* nA = has_next ? (const char*)g.A + (size_t)nxt.pm * tstep : cA; const char* nB = has_next ? (const char*)g.Bt + (size_t)nxt.pn * tstep : cB;
        if constexpr (SP2) {
            { const char* a1 = cA + kstep; const char* a2 = cA + 2 * kstep; const char* b2 = cB + 2 * kstep; const char* a3 = a2 + kstep; const char* b3 = b2 + kstep;
              PG8_SP2_BODY(PG8_WAIT_VX(8 + Epi::NST)); }
            for (int t = 2; t < nt; t += 2) {
                const bool last = (t == nt - 2);
                const char* a1 = cA + (size_t)(t + 1) * kstep;
                const char* a2 = last ? nA : cA + (size_t)(t + 2) * kstep; const char* b2 = last ? nB : cB + (size_t)(t + 2) * kstep;
                const char* a3 = a2 + kstep; const char* b3 = b2 + kstep;
                if (last && has_next) S.a_ready(nxt);
                PG8_SP2_BODY(PG8_WAIT_V(8));
            }
        } else {
        for (int t = 0; t < nt; t += 2) {
            const bool last = (t == nt - 2);
            const char* a1 = cA + (size_t)(t + 1) * kstep;
            const char* a2 = last ? nA : cA + (size_t)(t + 2) * kstep; const char* b2 = last ? nB : cB + (size_t)(t + 2) * kstep;
            const char* a3 = a2 + kstep; const char* b3 = b2 + kstep;
            if (last && has_next) S.a_ready(nxt);
            PG8_LDB(B0, 0, 0); PG8_SCHED; PG8_LDA(At, 0, 0); PG8_STAGE(PG8_SA(1, 1), a1 + hstep, voffA);
            PG8_WAIT_L(8); PG8_BAR; PG8_WAIT_L(0); PG8_MMA(0, 0, At, B0); PG8_BAR; PG8_SCHED;
            PG8_LDB(B1, 0, 1); PG8_STAGE(PG8_SB(0, 0), b2, voffB);
            PG8_BAR; PG8_WAIT_L(0); PG8_MMA(0, 1, At, B1); PG8_BAR;
            PG8_LDA(At, 0, 1); PG8_STAGE(PG8_SA(0, 0), a2, voffA);
            PG8_BAR; PG8_WAIT_L(0); PG8_MMA(1, 0, At, B0); PG8_BAR; PG8_SCHED;
            PG8_STAGE(PG8_SB(0, 1), b2 + hstep, voffB);
            PG8_WAIT_V(6); PG8_BAR; PG8_MMA(1, 1, At, B1); PG8_BAR;
            PG8_LDB(B0, 1, 0); PG8_SCHED; PG8_LDA(At, 1, 0); PG8_STAGE(PG8_SA(0, 1), a2 + hstep, voffA);
            PG8_WAIT_L(8); PG8_BAR; PG8_WAIT_L(0); PG8_MMA(0, 0, At, B0); PG8_BAR; PG8_SCHED;
            PG8_LDB(B1, 1, 1); PG8_STAGE(PG8_SB(1, 0), b3, voffB);
            PG8_BAR; PG8_WAIT_L(0); PG8_MMA(0, 1, At, B1); PG8_BAR;
            PG8_LDA(At, 1, 1); PG8_STAGE(PG8_SA(1, 0), a3, voffA);
            PG8_BAR; PG8_WAIT_L(0); PG8_MMA(1, 0, At, B0); PG8_BAR; PG8_SCHED;
            PG8_STAGE(PG8_SB(1, 1), b3 + hstep, voffB);
            PG8_WAIT_V(6); PG8_BAR; PG8_MMA(1, 1, At, B1); PG8_BAR;
        }
        }
        if constexpr (ALIGN_EPI) { if (wr == 0) PG8_BAR; }
        if (PROBE_KDUP && !(ui & 1)) {
            const unsigned* dmb = g.dummy + ((size_t)blockIdx.x * 8 + wid) * 64; unsigned dmo = (unsigned)__builtin_amdgcn_mbcnt_hi(~0u, __builtin_amdgcn_mbcnt_lo(~0u, 0u)) * 4u;
#pragma unroll
            for (int i = 0; i < Epi::NST; ++i) asm volatile("global_store_dword %0, %0, %1\n\ts_nop 0" :: "v"(dmo), "s"(dmb) : "memory");
        } else
        if constexpr (!Epi::AFTER_DRAIN) { int le = (int)__builtin_amdgcn_mbcnt_hi(~0u, __builtin_amdgcn_mbcnt_lo(~0u, 0u)); asm volatile("" : "+v"(le));
            E(acc, cur, wr, wc, le & 15, le >> 4); if constexpr (Epi::REPS > 1) { asm volatile("" ::: "memory"); E(acc, cur, wr, wc, le & 15, le >> 4); } S.done(cur); }
        if (!has_next) break;
#pragma unroll
        for (int a = 0; a < 2; ++a)
#pragma unroll
            for (int b = 0; b < 2; ++b)
#pragma unroll
                for (int m = 0; m < 4; ++m)
#pragma unroll
                    for (int n = 0; n < 2; ++n) acc[a][b][m][n] = (f32x4){0.f, 0.f, 0.f, 0.f};
        cur = nxt; cA = nA; cB = nB; ++ui;
        if constexpr (ALIGN_EPI) { if (wr == 1) PG8_BAR; }
    }
    PG8_WAIT_V(0);
    if constexpr (!ALIGN_EPI) { if (wr == 0) PG8_BAR; }
    PG8_BAR;
    if constexpr (Epi::AFTER_DRAIN) { E.fused(acc, cur, wr, wc, fr, fq, lds, wid, lane); S.done(cur); }
#undef PG8_SA
#undef PG8_SB
#undef PG8_SBR
#undef PG8_STAGE
#undef PG8_LDA
#undef PG8_LDB
#undef PG8_MMA
#undef PG8_WAIT_V
#undef PG8_WAIT_VX
#undef PG8_SP2_BODY
#undef PG8_WAIT_L
#undef PG8_BAR
#undef PG8_SCHED
}
}

constexpr int NWAVES = 8;
constexpr int RING_OFF = 0, RING_BYTES = 155648;
constexpr int LDSCTL_OFF = RING_BYTES, MISC_OFF = LDSCTL_OFF + 320;
constexpr int LDS_BYTES = 163840;
#define GAS __attribute__((address_space(1)))
#define LAS __attribute__((address_space(3)))
typedef unsigned v4u __attribute__((ext_vector_type(4)));
typedef float f32x4 __attribute__((ext_vector_type(4)));
typedef short bf16x8 __attribute__((ext_vector_type(8)));
typedef GAS unsigned gu32;
#define RLX_AGENT __ATOMIC_RELAXED, __HIP_MEMORY_SCOPE_AGENT
constexpr int CW_TMO = 0, CW_CODE = 1, CW_BAR = 4096;

__device__ __forceinline__ int lane_id() { return (int)__builtin_amdgcn_mbcnt_hi(~0u, __builtin_amdgcn_mbcnt_lo(~0u, 0u)); }
struct Args { const float* in[22]; float* out; unsigned char* ws; int ph_lo, ph_hi; };
struct Frame {
    LAS unsigned char* lds; volatile LAS unsigned* MISC; gu32* ctl;
    int wave, vcu, G;
};
#define XB_TMO      128
#define XB_XCNT(j)  (256  + 64 * (j))
#define XB_XSUB(j)  (1280 + 64 * (j))
#define XB_XGEN(j)  (2304 + 64 * (j))
#define XB_TOP      3328
#define XB_TOPGEN   3392
#define XCD_BAR_WORDS 3456
#define XB_SPIN_CAP (1u << 18)

__device__ __forceinline__ unsigned xb_ld(unsigned* p)              { return __hip_atomic_load(p, __ATOMIC_RELAXED, __HIP_MEMORY_SCOPE_AGENT); }
__device__ __forceinline__ unsigned xb_add(unsigned* p, unsigned v) { return __hip_atomic_fetch_add(p, v, __ATOMIC_RELAXED, __HIP_MEMORY_SCOPE_AGENT); }
__device__ __forceinline__ unsigned xb_xcc_id() { return (unsigned)__builtin_amdgcn_s_getreg((3 << 11) | 20) & 0xFu; }
#define XB_SPIN(cond, bar) do { unsigned _sp = 0; while (cond) { __builtin_amdgcn_s_sleep(1); \
    if ((++_sp & 255u) == 0u) { if (xb_ld(&(bar)[XB_TMO])) break; if (_sp > XB_SPIN_CAP) { atomicAdd(&(bar)[XB_TMO], 1u); break; } } } } while (0)

struct XcdBarrier {
    unsigned* bar; unsigned x; int wave;
    volatile LAS unsigned* st;
};

__device__ __forceinline__ XcdBarrier xcd_barrier_post(unsigned* bar, volatile LAS unsigned* st) {
    XcdBarrier b; b.bar = bar; b.x = xb_xcc_id(); b.st = st;
    if (threadIdx.x == 0) (void)xb_add(&bar[XB_XCNT(b.x)], 1u);
    return b;
}
__device__ __forceinline__ void xcd_barrier_complete(unsigned* bar, unsigned x, unsigned& nloc, unsigned& nx) {
    const unsigned G = gridDim.x * gridDim.y * gridDim.z;
    unsigned sum, cnt, mine, sp = 0u;
    for (;;) {
        sum = 0u; cnt = 0u; mine = 0u;
#pragma unroll
        for (unsigned j = 0; j < 16; ++j) { const unsigned c = xb_ld(&bar[XB_XCNT(j)]); sum += c; cnt += (c > 0u) ? 1u : 0u; mine = (j == x) ? c : mine; }
        if (sum == G) break;
        __builtin_amdgcn_s_sleep(1);
        if ((++sp & 255u) == 0u) { if (xb_ld(&bar[XB_TMO])) break; if (sp > XB_SPIN_CAP) { atomicAdd(&bar[XB_TMO], 1u); break; } }
    }
    nloc = mine > 0u ? mine : 1u; nx = cnt > 0u ? cnt : 1u;
}

__device__ __forceinline__ void xcd_barrier(const XcdBarrier& b) {
    asm volatile("s_waitcnt vmcnt(0)" ::: "memory");
    __syncthreads();
    if (b.wave == 0 && lane_id() == 0) {
        unsigned* bar = b.bar;
        __builtin_amdgcn_s_waitcnt(0);
        __builtin_amdgcn_fence(__ATOMIC_ACQUIRE, "agent");
        unsigned nloc = b.st[0], nx = b.st[1];
        if (nloc == 0u) { xcd_barrier_complete(bar, b.x, nloc, nx); b.st[0] = nloc; b.st[1] = nx; }
        const unsigned old = xb_add(&bar[XB_XSUB(b.x)], 1u);
        const unsigned gen = old / nloc;
        if (old + 1u == (gen + 1u) * nloc) {
            __builtin_amdgcn_fence(__ATOMIC_RELEASE, "agent");
            asm volatile("s_waitcnt vmcnt(0)" ::: "memory");
            const unsigned og = xb_add(&bar[XB_TOP], 1u);
            const unsigned tg = og / nx;
            if (og + 1u == (tg + 1u) * nx) xb_add(&bar[XB_TOPGEN], 1u);
            else XB_SPIN(xb_ld(&bar[XB_TOPGEN]) == tg, bar);
            xb_add(&bar[XB_XGEN(b.x)], 1u);
            asm volatile("s_waitcnt vmcnt(0)" ::: "memory");
        } else {
            XB_SPIN(xb_ld(&bar[XB_XGEN(b.x)]) == gen, bar);
            asm volatile("s_waitcnt vmcnt(0)" ::: "memory");
        }
    }
    __syncthreads();
}

__device__ __forceinline__ float fsigmoid(float x) { return __builtin_amdgcn_rcpf(1.f + __builtin_amdgcn_exp2f(-1.4426950408889634f * x)); }
__device__ __forceinline__ float fsilu(float x) { return x * fsigmoid(x); }
typedef float cvt_f32x2 __attribute__((ext_vector_type(2))); typedef __bf16 cvt_bf16x2 __attribute__((ext_vector_type(2)));
__device__ __forceinline__ unsigned cvtpk(float lo, float hi) { const cvt_f32x2 v = {lo, hi}; const cvt_bf16x2 b = __builtin_convertvector(v, cvt_bf16x2); return __builtin_bit_cast(unsigned, b); }
__device__ __forceinline__ float bflo(unsigned u) { return __builtin_bit_cast(float, u << 16); }
__device__ __forceinline__ float bfhi(unsigned u) { return __builtin_bit_cast(float, u & 0xffff0000u); }


#define LDS_WAIT() asm volatile("s_waitcnt lgkmcnt(0)" ::: "memory")
__device__ __forceinline__ unsigned pk2(float lo, float hi) { return f2bf(lo) | (f2bf(hi) << 16); }
__device__ __forceinline__ void p0_transpose_item(const float* W, int K, int N, bf16* WT, const float* scale, LAS float* scr, int item, int lane, float cs = 1.f) {
    const int nblk = N / 32, kb = item / nblk, nb = item % nblk, k0 = 64 * kb, n0 = 32 * nb;
    const int lr = lane >> 3, lc = 4 * (lane & 7);
    f32x4 v[8];
#pragma unroll
    for (int i = 0; i < 8; ++i) v[i] = *(const GAS f32x4*)(W + (size_t)(k0 + lr + 8 * i) * N + n0 + lc);
#pragma unroll
    for (int i = 0; i < 8; ++i) { const int kk = lr + 8 * i; const float sc = scale ? scale[k0 + kk] : cs; LAS float* d = scr + kk * 33 + lc;
        d[0] = v[i].x * sc; d[1] = v[i].y * sc; d[2] = v[i].z * sc; d[3] = v[i].w * sc; }
    LDS_WAIT(); asm volatile("" ::: "memory");
    const int c = lane & 7;
#pragma unroll
    for (int j = 0; j < 4; ++j) { const int n = (lane >> 3) + 8 * j; const LAS float* s = scr + (8 * c) * 33 + n;
        v4u o; o.x = pk2(s[0 * 33], s[1 * 33]); o.y = pk2(s[2 * 33], s[3 * 33]); o.z = pk2(s[4 * 33], s[5 * 33]); o.w = pk2(s[6 * 33], s[7 * 33]);
        *(GAS v4u*)(WT + (size_t)(n0 + n) * K + k0 + 8 * c) = o; }
    LDS_WAIT(); asm volatile("" ::: "memory");
}
template <int NR> __device__ __forceinline__ void rms_rows_to_bf16(const float* xrow, const float* gain, bf16* orow, int lane) {
    const GAS f32x4* gr = (const GAS f32x4*)gain + lane;
    f32x4 v[NR][4]; float s[NR];
#pragma unroll
    for (int r = 0; r < NR; ++r) { const GAS f32x4* xr = (const GAS f32x4*)(xrow + (size_t)r * D) + lane;
#pragma unroll
        for (int j = 0; j < 4; ++j) v[r][j] = __builtin_nontemporal_load(xr + 64 * j); }
#pragma unroll
    for (int r = 0; r < NR; ++r) { s[r] = 0.f;
#pragma unroll
        for (int j = 0; j < 4; ++j) s[r] += (v[r][j].x * v[r][j].x + v[r][j].y * v[r][j].y) + (v[r][j].z * v[r][j].z + v[r][j].w * v[r][j].w); }
#pragma unroll
    for (int o = 1; o < 64; o <<= 1) {
#pragma unroll
        for (int r = 0; r < NR; ++r) s[r] += __shfl_xor(s[r], o); }
#pragma unroll
    for (int r = 0; r < NR; ++r) { const float rstd = rsqrtf(s[r] * (1.f / D) + EPS);
        GAS unsigned long long* o8 = (GAS unsigned long long*)(orow + (size_t)r * D) + lane;
#pragma unroll
        for (int j = 0; j < 4; ++j) { const f32x4 g = gr[64 * j]; o8[64 * j] = (unsigned long long)pk2(v[r][j].x * rstd * g.x, v[r][j].y * rstd * g.y) | ((unsigned long long)pk2(v[r][j].z * rstd * g.z, v[r][j].w * rstd * g.w) << 32); } }
}
constexpr int I_A = (D / 64) * (NA / 32), I_OA = (GW / 64) * (D / 32), I_C = (D / 64) * (NC / 32), I_OC = I_OA, I_G = 16 * 8;
__device__ __forceinline__ void p0_prologue(const Frame& F, const Args& args, unsigned char* ws) {
    int tid_ = F.wave * 64 + lane_id(); asm volatile("" : "+v"(tid_)); const int lane_ = tid_ & 63;
    LAS float* scr = (LAS float*)(F.lds + RING_OFF + F.wave * 16384);
    const int gw = F.vcu * NWAVES + F.wave, NGW = F.G * NWAVES;
    bf16* WaT = (bf16*)(ws + WS_WAT);
    for (int it = gw; it < I_A; it += NGW) p0_transpose_item(args.in[2], D, NA, WaT, nullptr, scr, it, lane_);
    bf16* h0 = (bf16*)args.out;
    for (int m = gw * 4; m < M; m += NGW * 4) rms_rows_to_bf16<4>(args.in[0] + (size_t)m * D, args.in[1], h0 + (size_t)m * D, lane_);
}
__device__ __forceinline__ void p0_layer1_weights(const Frame& F, const Args& args, unsigned char* ws, int icu, int ncu) {
    int tid_ = F.wave * 64 + lane_id(); asm volatile("" : "+v"(tid_)); const int lane_ = tid_ & 63;
    LAS float* scr = (LAS float*)(F.lds + RING_OFF + F.wave * 16384);
    const int gw = icu * NWAVES + F.wave, NGW = ncu * NWAVES;
    bf16* WoaT = (bf16*)(ws + WS_WOAT); bf16* WG = (bf16*)(ws + WS_WG); bf16* WcT = (bf16*)(ws + WS_WCT); bf16* WocT = (bf16*)(ws + WS_WOCT);
    for (int it = gw; it < I_OA + I_G + I_C + I_OC; it += NGW) {
        int r = it;
        if (r < I_OA) { p0_transpose_item(args.in[13], GW, D, WoaT, nullptr, scr, r, lane_); continue; } r -= I_OA;
        if (r < I_G) { const int mat = r >> 3, sub = r & 7, n = mat >> 1, gate = mat & 1;
            p0_transpose_item((gate ? args.in[7] : args.in[5]) + (size_t)n * 16384, 128, 128, WG + (size_t)mat * 16384, nullptr, scr, sub, lane_, -1.4426950408889634f); continue; } r -= I_G;
        if (r < I_C) { p0_transpose_item(args.in[16], D, NC, WcT, args.in[15], scr, r, lane_); continue; } r -= I_C;
        p0_transpose_item(args.in[21], GW, D, WocT, nullptr, scr, r, lane_);
    }
    { float* btab = (float*)(ws + WS_BIAS);
      for (int gt = icu * (NWAVES * 64) + tid_; gt < 16 * 128; gt += ncu * NWAVES * 64) { const int d = gt & 127, h = gt >> 7; int bk;
          if (d < 16) bk = d; else { bk = 16 + (int)(logf((float)d / 16.f) / logf(8.f) * 16.f); if (bk > 31) bk = 31; }
          btab[gt] = args.in[14][bk * 16 + h]; } }
    { bf16* WS = (bf16*)(ws + WS_WS);
      for (int gt = icu * (NWAVES * 64) + tid_; gt < 8 * 128 * 16; gt += ncu * NWAVES * 64) { const int s8 = gt & 15, t = (gt >> 4) & 127; const float* src = args.in[19] + (size_t)gt * 8;
          const f32x4 a = *(const f32x4*)src, b = *(const f32x4*)(src + 4); const float wv[8] = {a.x, a.y, a.z, a.w, b.x, b.y, b.z, b.w}; float o[8];
#pragma unroll
          for (int e = 0; e < 8; ++e) o[e] = (8 * s8 + e <= t) ? wv[e] : 0.f;
          v4u pk; pk.x = pk2(o[0], o[1]); pk.y = pk2(o[2], o[3]); pk.z = pk2(o[4], o[5]); pk.w = pk2(o[6], o[7]);
          *(GAS v4u*)(WS + (size_t)gt * 8) = pk; } }
}

typedef float f32x16 __attribute__((ext_vector_type(16)));
constexpr int P5_VSTRIDE = 272;
constexpr int P5_VT = 0, P5_W0 = 256 * P5_VSTRIDE, P5_ST = P5_W0 + 128 * P5_VSTRIDE, P5_GB = P5_ST + (384 + 1024) * 4;
static_assert(P5_GB + 4096 * 4 <= RING_BYTES, "P5 LDS map");
__device__ __forceinline__ void p5_gate(const Frame& F, const Args& args, unsigned char* ws) {
    LAS unsigned char* L = F.lds + RING_OFF;
    LAS float* mu = (LAS float*)(L + P5_ST); LAS float* rs = mu + 128; LAS float* rx = mu + 256; LAS float* bb = mu + 384;
    bf16* U = (bf16*)(ws + WS_U); const bf16* V = (const bf16*)(ws + WS_V); const bf16* G = (const bf16*)(ws + WS_G); const float* vst = (const float*)(ws + WS_VST);
    const bf16* WS = (const bf16*)(ws + WS_WS);
    const float* lg = args.in[17]; const float* lb = args.in[18]; const float* sb = args.in[20]; const float* ssq = (const float*)(ws + WS_SSQ);
    const int w = F.wave;
    const int NCH = M / 128, nitem = 2 * NCH;
    const int nmine = (nitem - F.vcu + F.G - 1) / F.G;
    for (int idx = 0; idx < nmine; ++idx) {
        const int it = F.vcu + ((2 * F.vcu >= F.G) ? (nmine - 1 - idx) : idx) * F.G;
        const int ch = (it < NCH) ? (NCH - 1 - it) : (it - NCH);
        const int g0 = (it < NCH) ? ((ch >= NCH / 2) ? 0 : 4) : ((ch >= NCH / 2) ? 4 : 0), g1 = g0 + 4;
        const int r0 = ch * 128;
        int tid = F.wave * 64 + lane_id(); asm volatile("" : "+v"(tid));
        const int lane0 = tid & 63, spl0 = lane0 & 15, cgl0 = lane0 >> 4;
        v4u vreg[4][2], wreg[4];
        { const int spl = spl0, cgl = cgl0;
#define P5_LOAD(g_) do { \
        const char* vb_ = (const char*)(V + (size_t)r0 * GW + (g_) * 256); const char* wb_ = (const char*)(WS + (size_t)(g_) * 16384); \
        _Pragma("unroll") for (int i = 0; i < 4; ++i) { const unsigned vo_ = (unsigned)((2 * (16 * i + spl)) * GW + 32 * w + 8 * cgl) * 2u; vreg[i][0] = *(const v4u*)(vb_ + vo_); vreg[i][1] = *(const v4u*)(vb_ + vo_ + GW * 2); } \
        _Pragma("unroll") for (int i = 0; i < 4; ++i) wreg[i] = *(const v4u*)(wb_ + (unsigned)(tid + 512 * i) * 16u); \
        } while (0)
        P5_LOAD(g0); }
        __syncthreads();
        { const int row = tid >> 2, part = tid & 3;
          const f32x4* p = (const f32x4*)(vst + ((size_t)(r0 + row) * 32 + part * 8) * 2);
          const f32x4 a = p[0], b = p[1], c = p[2], d = p[3];
          float s1 = ((a.x + a.z) + (b.x + b.z)) + ((c.x + c.z) + (d.x + d.z));
          float s2 = ((a.y + a.w) + (b.y + b.w)) + ((c.y + c.w) + (d.y + d.w));
          s1 += __shfl_xor(s1, 1); s1 += __shfl_xor(s1, 2); s2 += __shfl_xor(s2, 1); s2 += __shfl_xor(s2, 2);
          const f32x4 sq = *(const f32x4*)(ssq + (size_t)(r0 + row) * 16 + 4 * part); float sx = (sq.x + sq.y) + (sq.z + sq.w); sx += __shfl_xor(sx, 1); sx += __shfl_xor(sx, 2);
          const float rxx = rsqrtf(sx * (1.f / D) + EPS);
          const float mean = s1 * (1.f / GW), var = fmaxf(s2 * (1.f / GW) - mean * mean, 0.f);
          if (part == 0) { mu[row] = mean; rs[row] = rxx * rsqrtf(rxx * rxx * var + EPS); rx[row] = rxx; }
          bb[tid] = sb[tid]; bb[tid + 512] = sb[tid + 512];
          LAS f32x4* gbt = (LAS f32x4*)(L + P5_GB); gbt[tid] = *(const f32x4*)(lg + 4 * tid); gbt[512 + tid] = *(const f32x4*)(lb + 4 * tid); }
        __syncthreads();
        v4u ug[4][4];
        { const int lane = lane0, l31 = lane & 31, hi = lane >> 5; const char* ub0 = (const char*)(U + (size_t)r0 * GW); const char* gb0 = (const char*)(G + (size_t)r0 * GW);
#pragma unroll
          for (int j = 0; j < 4; ++j) { const unsigned off = (unsigned)((32 * j + l31) * GW + g0 * 256 + 32 * w + 16 * hi) * 2u;
              ug[j][0] = *(const v4u*)(ub0 + off); ug[j][1] = *(const v4u*)(ub0 + off + 16); ug[j][2] = *(const v4u*)(gb0 + off); ug[j][3] = *(const v4u*)(gb0 + off + 16); } }
#pragma unroll 1
        for (int g = g0; g < g1; ++g) {
            int tg = tid; asm volatile("" : "+v"(tg));
            const int lane = tg & 63, l31 = lane & 31, hi = lane >> 5, cgl = lane >> 4, spl = lane & 15;
            { const LAS f32x4* gp = (const LAS f32x4*)(L + P5_GB) + (g * 256 + 32 * w + 8 * cgl) / 4; const f32x4 ga0 = gp[0], ga1 = gp[1], be0 = gp[512], be1 = gp[513];
              const float gam[8] = {ga0.x, ga0.y, ga0.z, ga0.w, ga1.x, ga1.y, ga1.z, ga1.w}, bet[8] = {be0.x, be0.y, be0.z, be0.w, be1.x, be1.y, be1.z, be1.w};
#pragma unroll
              for (int i = 0; i < 4; ++i) { const int sp = 16 * i + spl; const float m0 = mu[2 * sp], m1 = mu[2 * sp + 1], q0 = rs[2 * sp], q1 = rs[2 * sp + 1];
                  const unsigned a0[4] = {vreg[i][0].x, vreg[i][0].y, vreg[i][0].z, vreg[i][0].w}, a1[4] = {vreg[i][1].x, vreg[i][1].y, vreg[i][1].z, vreg[i][1].w};
#pragma unroll
                  for (int e = 0; e < 8; ++e) { const float x0 = (e & 1) ? bfhi(a0[e >> 1]) : bflo(a0[e >> 1]), x1 = (e & 1) ? bfhi(a1[e >> 1]) : bflo(a1[e >> 1]);
                      const float n0 = (x0 - m0) * q0 * gam[e] + bet[e], n1 = (x1 - m1) * q1 * gam[e] + bet[e];
                      *(LAS unsigned*)(L + P5_VT + (32 * w + 8 * cgl + e) * P5_VSTRIDE + sp * 4) = cvtpk(n0, n1); } } }
            __syncthreads();
            { LAS unsigned char* wb = L + P5_W0;
#pragma unroll
              for (int i = 0; i < 4; ++i) { const int idx = tid + 512 * i; *(LAS v4u*)(wb + (idx >> 4) * P5_VSTRIDE + (idx & 15) * 16) = wreg[i]; } }
            if (g + 1 < g1) P5_LOAD(g + 1);
            char* ub = (char*)(U + (size_t)r0 * GW + g * 256); const char* gb = (const char*)(G + (size_t)r0 * GW + g * 256);
            __syncthreads();
            const int prow = 16 * ((l31 >> 2) & 1) + 4 * (l31 >> 3) + (l31 & 3);
            const LAS unsigned char* ap = L + P5_VT + (32 * w + prow) * P5_VSTRIDE + hi * 16;
            const LAS unsigned char* bp = L + P5_W0 + l31 * P5_VSTRIDE + hi * 16;
#pragma unroll
            for (int jp = 0; jp < 2; ++jp) {
                f32x16 acc[2];
#pragma unroll
                for (int jj = 0; jj < 2; ++jj) { const int j = 2 * jp + jj; f32x16 a = {0.f, 0.f, 0.f, 0.f, 0.f, 0.f, 0.f, 0.f, 0.f, 0.f, 0.f, 0.f, 0.f, 0.f, 0.f, 0.f};
#pragma unroll
                    for (int ks = 0; ks < 2 * j + 2; ++ks) { const bf16x8 af = *(const LAS bf16x8*)(ap + ks * 32), bfr_ = *(const LAS bf16x8*)(bp + j * 32 * P5_VSTRIDE + ks * 32);
                        a = __builtin_amdgcn_mfma_f32_32x32x16_bf16(af, bfr_, a, 0, 0, 0); }
                    acc[jj] = a; }
#pragma unroll
                for (int jj = 0; jj < 2; ++jj) { const int j = 2 * jp + jj; const int t = 32 * j + l31; const float b0 = bb[g * 128 + t], rxt = rx[t];
                    const unsigned off = (unsigned)(t * GW + 32 * w + 16 * hi) * 2u;
                    const unsigned uu[8] = {ug[j][0].x, ug[j][0].y, ug[j][0].z, ug[j][0].w, ug[j][1].x, ug[j][1].y, ug[j][1].z, ug[j][1].w};
                    const unsigned gg[8] = {ug[j][2].x, ug[j][2].y, ug[j][2].z, ug[j][2].w, ug[j][3].x, ug[j][3].y, ug[j][3].z, ug[j][3].w};
                    unsigned o[8];
#pragma unroll
                    for (int q = 0; q < 8; ++q) { const float y0_ = rxt * bflo(uu[q]) * (acc[jj][2 * q] + b0) * fsilu(rxt * bflo(gg[q])), y1_ = rxt * bfhi(uu[q]) * (acc[jj][2 * q + 1] + b0) * fsilu(rxt * bfhi(gg[q])); o[q] = cvtpk(y0_, y1_); }
                    v4u o0, o1; o0.x = o[0]; o0.y = o[1]; o0.z = o[2]; o0.w = o[3]; o1.x = o[4]; o1.y = o[5]; o1.z = o[6]; o1.w = o[7];
                    *(v4u*)(ub + off) = o0; *(v4u*)(ub + off + 16) = o1;
                    if (g + 1 < g1) { ug[j][0] = *(const v4u*)(ub + 512 + off); ug[j][1] = *(const v4u*)(ub + 512 + off + 16); ug[j][2] = *(const v4u*)(gb + 512 + off); ug[j][3] = *(const v4u*)(gb + 512 + off + 16); } } }
        }
#undef P5_LOAD
    }
}

constexpr int LR_XA = 0;
constexpr int LR_XF = 32768, LR_XFS = 68;
constexpr int LR_GA = LR_XF + 128 * LR_XFS * 4;
constexpr int LR_GAS = 144;
constexpr int LR_Y = LR_GA + 128 * LR_GAS;
constexpr int LR_TOT = LR_Y + 128 * LR_GAS;
static_assert(LR_TOT + 8 * 16 * 2 * 4 <= RING_BYTES, "LRU LDS map");
__device__ __forceinline__ void p2_lru(const Frame& F, const Args& args, unsigned char* ws) {
    LAS unsigned char* L = F.lds + RING_OFF;
    const bf16* z0 = (const bf16*)(ws + WS_Z0); bf16* y0 = (bf16*)(ws + WS_Y0); const bf16* WG = (const bf16*)(ws + WS_WG);
    const float* conv_w = args.in[3]; const float* conv_b = args.in[4]; const float* gab = args.in[6]; const float* gxb = args.in[8]; const float* lam = args.in[9];
    int tid = F.wave * 64 + lane_id(); asm volatile("" : "+v"(tid));
    const int lane = tid & 63, w = F.wave, q = lane >> 4, cc = lane & 15, th = w >> 2, ct = w & 3;
    for (int unit = F.vcu; unit < NB * 16; unit += F.G) {
        const int b = unit >> 4, n = (unit >> 1) & 7, hf = unit & 1;
        const size_t row0 = (size_t)b * S;
        bf16x8 bfrag[2][4];
#pragma unroll
        for (int g2 = 0; g2 < 2; ++g2)
#pragma unroll
            for (int ks = 0; ks < 4; ++ks) bfrag[g2][ks] = *(const bf16x8*)(WG + ((size_t)(n * 2 + g2) * 128 + 64 * hf + 16 * ct + cc) * 128 + 32 * ks + 8 * q);
        const int cg = tid & 15, tq = tid >> 4, chc = n * 128 + 8 * cg;
        float cw[4][8], cb[8];
#pragma unroll
        for (int k = 0; k < 4; ++k) { const f32x4 a = *(const f32x4*)(conv_w + k * 1024 + chc), c2 = *(const f32x4*)(conv_w + k * 1024 + chc + 4);
            cw[k][0] = a.x; cw[k][1] = a.y; cw[k][2] = a.z; cw[k][3] = a.w; cw[k][4] = c2.x; cw[k][5] = c2.y; cw[k][6] = c2.z; cw[k][7] = c2.w; }
        { const f32x4 a = *(const f32x4*)(conv_b + chc), c2 = *(const f32x4*)(conv_b + chc + 4); cb[0] = a.x; cb[1] = a.y; cb[2] = a.z; cb[3] = a.w; cb[4] = c2.x; cb[5] = c2.y; cb[6] = c2.z; cb[7] = c2.w; }
        const int chl = n * 128 + 64 * hf + 16 * ct + cc;
        const float ba = -1.4426950408889634f * gab[chl], bx = -1.4426950408889634f * gxb[chl], sp = 8.f * 1.4426950408889634f * log1pf(expf(-lam[chl]));
        float hprev = 0.f;
        const int mt = tid >> 2, mp = tid & 3;
        v4u zr[7], gr[2];
#pragma unroll
        for (int i = 0; i < 7; ++i) { const int t = 4 * tq - 3 + i; zr[i] = (t >= 0) ? *(const v4u*)(z0 + (row0 + t) * NA + chc) : (v4u){0u, 0u, 0u, 0u}; }
#pragma unroll
        for (int i = 0; i < 2; ++i) gr[i] = *(const v4u*)(z0 + (row0 + mt) * NA + 1024 + n * 128 + 64 * hf + 8 * (mp + 4 * i));
        for (int chunk = 0; chunk < 16; ++chunk) {
            const int t0 = chunk * 128; const size_t rowb = row0 + t0;
            __syncthreads();
            { float zf[7][8];
#pragma unroll
              for (int i = 0; i < 7; ++i) { const unsigned u4[4] = {zr[i].x, zr[i].y, zr[i].z, zr[i].w};
#pragma unroll
                  for (int e = 0; e < 4; ++e) { zf[i][2 * e] = bflo(u4[e]); zf[i][2 * e + 1] = bfhi(u4[e]); } }
#pragma unroll
              for (int r = 0; r < 4; ++r) { const int tok = 4 * tq + r; float xa[8];
#pragma unroll
                  for (int e = 0; e < 8; ++e) xa[e] = cb[e] + cw[0][e] * zf[r][e] + cw[1][e] * zf[r + 1][e] + cw[2][e] * zf[r + 2][e] + cw[3][e] * zf[r + 3][e];
                  v4u pk; pk.x = cvtpk(xa[0], xa[1]); pk.y = cvtpk(xa[2], xa[3]); pk.z = cvtpk(xa[4], xa[5]); pk.w = cvtpk(xa[6], xa[7]);
                  *(LAS v4u*)(L + LR_XA + tok * 256 + ((cg ^ ((tok & 3) | ((tok >> 2) & 12))) << 4)) = pk;
                  if ((cg >> 3) == hf) { LAS float* xf = (LAS float*)(L + LR_XF) + tok * LR_XFS + 8 * (cg & 7);
                      *(LAS f32x4*)xf = (f32x4){xa[0], xa[1], xa[2], xa[3]}; *(LAS f32x4*)(xf + 4) = (f32x4){xa[4], xa[5], xa[6], xa[7]}; } } }
#pragma unroll
            for (int i = 0; i < 2; ++i) *(LAS v4u*)(L + LR_GA + mt * LR_GAS + 16 * (mp + 4 * i)) = gr[i];
            if (chunk < 15) {
#pragma unroll
                for (int i = 0; i < 7; ++i) zr[i] = *(const v4u*)(z0 + (rowb + 128 + 4 * tq - 3 + i) * NA + chc);
#pragma unroll
                for (int i = 0; i < 2; ++i) gr[i] = *(const v4u*)(z0 + (rowb + 128 + mt) * NA + 1024 + n * 128 + 64 * hf + 8 * (mp + 4 * i));
            }
            __syncthreads();
            f32x4 acc[2][4];
#define LR_GATES(tt) do { acc[0][tt] = (f32x4){0.f, 0.f, 0.f, 0.f}; acc[1][tt] = (f32x4){0.f, 0.f, 0.f, 0.f}; \
                const int tokg = 64 * th + 16 * (cc >> 2) + 4 * (tt) + (cc & 3);     \
                _Pragma("unroll") for (int ks = 0; ks < 4; ++ks) { const int ck = 4 * ks + q; \
                    const bf16x8 af = *(const LAS bf16x8*)(L + LR_XA + tokg * 256 + ((ck ^ ((tokg & 3) | ((tokg >> 2) & 12))) << 4)); \
                    acc[0][tt] = __builtin_amdgcn_mfma_f32_16x16x32_bf16(af, bfrag[0][ks], acc[0][tt], 0, 0, 0); \
                    acc[1][tt] = __builtin_amdgcn_mfma_f32_16x16x32_bf16(af, bfrag[1][ks], acc[1][tt], 0, 0, 0); } } while (0)
            float Ai[4][4], Hi[4][4];
            float ap = 1.f, hp = 0.f;
            LR_GATES(0);
#pragma unroll
            for (int tt = 0; tt < 4; ++tt) {
                if (tt == 0) LR_GATES(1); else if (tt == 1) LR_GATES(2); else if (tt == 2) LR_GATES(3);
#pragma unroll
                for (int r = 0; r < 4; r += 2) { const int tok = 64 * th + 16 * q + 4 * tt + r;
                    typedef float f32p __attribute__((ext_vector_type(2)));
                    const f32p xr = (f32p){acc[0][tt][r], acc[0][tt][r + 1]} + (f32p){ba, ba}, xi = (f32p){acc[1][tt][r], acc[1][tt][r + 1]} + (f32p){bx, bx};
                    const f32p dr = (f32p){__builtin_amdgcn_exp2f(xr.x), __builtin_amdgcn_exp2f(xr.y)} + (f32p){1.f, 1.f}, di = (f32p){__builtin_amdgcn_exp2f(xi.x), __builtin_amdgcn_exp2f(xi.y)} + (f32p){1.f, 1.f};
                    const f32p rg = (f32p){__builtin_amdgcn_rcpf(dr.x), __builtin_amdgcn_rcpf(dr.y)}, ig = (f32p){__builtin_amdgcn_rcpf(di.x), __builtin_amdgcn_rcpf(di.y)};
                    const f32p la = rg * (f32p){-sp, -sp};
                    const f32p a = (f32p){__builtin_amdgcn_exp2f(la.x), __builtin_amdgcn_exp2f(la.y)};
                    const f32p om = (f32p){1.f, 1.f} - a * a;
                    const f32p xav = (f32p){((const LAS float*)(L + LR_XF))[tok * LR_XFS + 16 * ct + cc], ((const LAS float*)(L + LR_XF))[(tok + 1) * LR_XFS + 16 * ct + cc]};
                    const f32p bt = (f32p){__builtin_amdgcn_sqrtf(fmaxf(om.x, 0.f)), __builtin_amdgcn_sqrtf(fmaxf(om.y, 0.f))} * (ig * xav);
                    ap *= a.x; hp = a.x * hp + bt.x; Ai[tt][r] = ap; Hi[tt][r] = hp;
                    ap *= a.y; hp = a.y * hp + bt.y; Ai[tt][r + 1] = ap; Hi[tt][r + 1] = hp; }
                __builtin_amdgcn_sched_barrier(0); }
#undef LR_GATES
            float pa = 1.f, ph = 0.f, ra = 1.f, rh = 0.f;
#pragma unroll
            for (int qq = 0; qq < 4; ++qq) { const float ta = __shfl(ap, qq * 16 + cc), tb = __shfl(hp, qq * 16 + cc);
                if (qq < q) { ph = ta * ph + tb; pa = ta * pa; }
                rh = ta * rh + tb; ra = ta * ra; }
            if (q == 0) { LAS float* tp = (LAS float*)(L + LR_TOT) + (w * 16 + cc) * 2; tp[0] = ra; tp[1] = rh; }
            __syncthreads();
            { const LAS float* t0p = (const LAS float*)(L + LR_TOT) + (ct * 16 + cc) * 2; const LAS float* t1p = (const LAS float*)(L + LR_TOT) + ((4 + ct) * 16 + cc) * 2;
              const float a0 = t0p[0], h0_ = t0p[1], a1 = t1p[0], h1 = t1p[1];
              const float hmid = a0 * hprev + h0_;
              const float hin = th ? hmid : hprev;
              hprev = a1 * hmid + h1;
              const float hl = pa * hin + ph;
#pragma unroll
              for (int tt = 0; tt < 4; ++tt)
#pragma unroll
                  for (int r = 0; r < 4; ++r) { const int tok = 64 * th + 16 * q + 4 * tt + r; const float h = Ai[tt][r] * hl + Hi[tt][r];
                      const float gv = bf2f(*(const LAS unsigned short*)(L + LR_GA + tok * LR_GAS + (16 * ct + cc) * 2));
                      *(LAS unsigned short*)(L + LR_Y + tok * LR_GAS + (16 * ct + cc) * 2) = (unsigned short)cvtpk(h * fsilu(gv), 0.f); } }
            __syncthreads();
#pragma unroll
            for (int i = 0; i < 2; ++i) *(v4u*)(y0 + (rowb + mt) * GW + n * 128 + 64 * hf + 8 * (mp + 4 * i)) = *(const LAS v4u*)(L + LR_Y + mt * LR_GAS + 16 * (mp + 4 * i));
        }
    }
}

constexpr int AT_KS = 0, AT_VT = 32768, AT_VSTRIDE = 520, AT_BL = AT_VT + 64 * AT_VSTRIDE, AT_QL = AT_BL + 9 * 192 * 4, AT_RS = 144, AT_WAVE = 2 * 32 * AT_RS;
constexpr int AT_QG = AT_QL + 8 * AT_WAVE, AT_SK = AT_QG + 256;
constexpr int AT_REF = AT_SK + 64;
static_assert(AT_REF + 16 <= RING_BYTES, "attention LDS map");
__device__ __forceinline__ void p2_attn(const Frame& F, const Args& args, unsigned char* ws) {
    LAS unsigned char* L = F.lds + RING_OFF;
    const bf16* z0 = (const bf16*)(ws + WS_Z0); bf16* y0 = (bf16*)(ws + WS_Y0); const float* btab = (const float*)(ws + WS_BIAS);
    const float* qg = args.in[10]; const float* kg = args.in[11]; const float* sinks = args.in[12];
    int tid = F.wave * 64 + lane_id(); asm volatile("" : "+v"(tid));
    const int lane = tid & 63, w = F.wave, l31 = lane & 31, hi = lane >> 5;
    const int qt = w & 3, cl = lane >> 4, jl = lane & 15;
    v4u pr[8];
#define AT_LOAD_KV(unit_) do { const int kh_ = (unit_) & 1, qb_ = ((unit_) >> 1) & 15, b_ = (unit_) >> 5; const long tk0_ = (long)qb_ * 128 - 128; \
        _Pragma("unroll") for (int i = 0; i < 4; ++i) { const int idx = tid + 512 * i, c = idx & 7, j = idx >> 3; const long tk = tk0_ + j; \
            pr[i] = (tk >= 0) ? *(const v4u*)(z0 + ((size_t)b_ * S + tk) * NA + 3072 + kh_ * 64 + 8 * c) : (v4u){0u, 0u, 0u, 0u}; } \
        _Pragma("unroll") for (int i = 0; i < 2; ++i) { const int jp = 16 * w + jl, c = 4 * i + cl; const long tk = tk0_ + 2 * jp; \
            if (tk >= 0) { const bf16* vp = z0 + ((size_t)b_ * S + tk) * NA + 3200 + kh_ * 64 + 8 * c; pr[4 + 2 * i] = *(const v4u*)vp; pr[5 + 2 * i] = *(const v4u*)(vp + NA); } \
            else { pr[4 + 2 * i] = (v4u){0u, 0u, 0u, 0u}; pr[5 + 2 * i] = (v4u){0u, 0u, 0u, 0u}; } } } while (0)
    if (F.vcu < NB * 32) AT_LOAD_KV(F.vcu);
    if (tid < 64) ((LAS float*)(L + AT_QG))[tid] = qg[tid]; else if (tid < 80) ((LAS float*)(L + AT_SK))[tid - 64] = sinks[tid - 64] * 1.4426950408889634f;
    if (w == 0) { float gq = fabsf(qg[lane]), gk = fabsf(kg[lane]);
#pragma unroll
        for (int off = 32; off >= 1; off >>= 1) { gq = fmaxf(gq, __shfl_xor(gq, off)); gk = fmaxf(gk, __shfl_xor(gk, off)); }
        if (lane == 0) *(LAS float*)(L + AT_REF) = fminf(8.f * 1.4426950408889634f * 1.01f * gq * gk, 60.f); }
    for (int unit = F.vcu; unit < NB * 16 * 2; unit += F.G) {
        const int kh = unit & 1, qb = (unit >> 1) & 15, b = unit >> 5;
        __syncthreads();
        const size_t R0 = (size_t)b * S + qb * 128 + 32 * qt;
        LAS unsigned char* QL = L + AT_QL + w * AT_WAVE; LAS unsigned char* GL = QL + 32 * AT_RS;
        const int mrr = lane >> 3, mch = lane & 7;
        const f32x4 kg0 = *(const f32x4*)(kg + 8 * (tid & 7)), kg1 = *(const f32x4*)(kg + 8 * (tid & 7) + 4);
        v4u t0[8];
        { const bf16* qp = z0 + (R0 + mrr) * NA + 2048 + (kh * 8 + (w >> 2)) * 64 + 8 * mch;
#pragma unroll
          for (int i = 0; i < 4; ++i) { t0[i] = *(const v4u*)(qp + (size_t)(8 * i) * NA); t0[4 + i] = *(const v4u*)(qp + (size_t)(8 * i) * NA + 1280); } }
        __builtin_amdgcn_sched_barrier(0);
#pragma unroll
        for (int i = 0; i < 4; ++i) { const int idx = tid + 512 * i, c = idx & 7, j = idx >> 3;
            const unsigned u4[4] = {pr[i].x, pr[i].y, pr[i].z, pr[i].w}; float kf[8], ss = 0.f;
#pragma unroll
            for (int e = 0; e < 4; ++e) { kf[2 * e] = bflo(u4[e]); kf[2 * e + 1] = bfhi(u4[e]); ss += kf[2 * e] * kf[2 * e] + kf[2 * e + 1] * kf[2 * e + 1]; }
            ss += __shfl_xor(ss, 1); ss += __shfl_xor(ss, 2); ss += __shfl_xor(ss, 4);
            const float rk = rsqrtf(ss * (1.f / 64.f) + EPS);
            v4u pk; pk.x = cvtpk(kf[0] * rk * kg0.x, kf[1] * rk * kg0.y); pk.y = cvtpk(kf[2] * rk * kg0.z, kf[3] * rk * kg0.w); pk.z = cvtpk(kf[4] * rk * kg1.x, kf[5] * rk * kg1.y); pk.w = cvtpk(kf[6] * rk * kg1.z, kf[7] * rk * kg1.w);
            *(LAS v4u*)(L + AT_KS + c * 4096 + j * 16) = pk; }
#pragma unroll
        for (int i = 0; i < 2; ++i) { const int jp = 16 * w + jl, c = 4 * i + cl;
            const unsigned a0[4] = {pr[4 + 2 * i].x, pr[4 + 2 * i].y, pr[4 + 2 * i].z, pr[4 + 2 * i].w}, a1[4] = {pr[5 + 2 * i].x, pr[5 + 2 * i].y, pr[5 + 2 * i].z, pr[5 + 2 * i].w};
#pragma unroll
            for (int e = 0; e < 8; ++e) { const unsigned lo = (e & 1) ? (a0[e >> 1] >> 16) : (a0[e >> 1] & 0xffffu), hi2 = (e & 1) ? (a1[e >> 1] & 0xffff0000u) : (a1[e >> 1] << 16);
                *(LAS unsigned*)(L + AT_VT + (8 * c + e) * AT_VSTRIDE + jp * 4) = lo | hi2; } }
        const float sref = *(const LAS float*)(L + AT_REF);
#pragma unroll
        for (int i = 0; i < 3; ++i) { const int idx = tid + 512 * i, hh = idx / 192, e = idx - hh * 192, dist = 159 - e;
            const float bv = btab[(kh * 8 + hh) * 128 + min(max(dist, 0), 127)];
            ((LAS float*)(L + AT_BL))[idx] = (dist >= 0 && dist < 128) ? bv * 1.4426950408889634f - sref : -INFINITY; }
        if (tid < 192) ((LAS float*)(L + AT_BL))[8 * 192 + tid] = -INFINITY;
#pragma unroll
        for (int i = 0; i < 4; ++i) { *(LAS v4u*)(QL + (8 * i + mrr) * AT_RS + 16 * mch) = t0[i]; *(LAS v4u*)(GL + (8 * i + mrr) * AT_RS + 16 * mch) = t0[4 + i]; }
        __syncthreads();
#pragma unroll 1
        for (int ti = 0; ti < 4; ++ti) {
            int lt = lane; asm volatile("" : "+v"(lt));
            const int l31 = lt & 31, hi = lt >> 5;
            const int g = (w >> 2) + 2 * ti, hq = kh * 8 + g;
            if (ti > 0) {
#pragma unroll
                for (int i = 0; i < 4; ++i) { *(LAS v4u*)(QL + (8 * i + mrr) * AT_RS + 16 * mch) = pr[i]; *(LAS v4u*)(GL + (8 * i + mrr) * AT_RS + 16 * mch) = pr[4 + i]; } }
            if (ti < 3) { const bf16* qp = z0 + (R0 + mrr) * NA + 2048 + (hq + 2) * 64 + 8 * mch;
#pragma unroll
                for (int i = 0; i < 4; ++i) { pr[i] = *(const v4u*)(qp + (size_t)(8 * i) * NA); pr[4 + i] = *(const v4u*)(qp + (size_t)(8 * i) * NA + 1280); } }
            else if (unit + F.G < NB * 32) AT_LOAD_KV(unit + F.G);
            asm volatile("s_waitcnt lgkmcnt(0)" ::: "memory");
            bf16x8 qf[4];
            { float ss = 0.f; float qv[4][8];
#pragma unroll
              for (int ds = 0; ds < 4; ++ds) { const v4u qr = *(const LAS v4u*)(QL + l31 * AT_RS + (16 * ds + 8 * hi) * 2); const unsigned u4[4] = {qr.x, qr.y, qr.z, qr.w};
#pragma unroll
                  for (int e = 0; e < 4; ++e) { qv[ds][2 * e] = bflo(u4[e]); qv[ds][2 * e + 1] = bfhi(u4[e]); ss += qv[ds][2 * e] * qv[ds][2 * e] + qv[ds][2 * e + 1] * qv[ds][2 * e + 1]; } }
              ss += __shfl_xor(ss, 32);
              const float rq = rsqrtf(ss * (1.f / 64.f) + EPS) * (0.125f * 1.4426950408889634f);
#pragma unroll
              for (int ds = 0; ds < 4; ++ds) { const f32x4 g0 = *(const LAS f32x4*)(L + AT_QG + (16 * ds + 8 * hi) * 4), g1 = *(const LAS f32x4*)(L + AT_QG + (16 * ds + 8 * hi + 4) * 4);
                  v4u pk; pk.x = cvtpk(qv[ds][0] * rq * g0.x, qv[ds][1] * rq * g0.y); pk.y = cvtpk(qv[ds][2] * rq * g0.z, qv[ds][3] * rq * g0.w);
                  pk.z = cvtpk(qv[ds][4] * rq * g1.x, qv[ds][5] * rq * g1.y); pk.w = cvtpk(qv[ds][6] * rq * g1.z, qv[ds][7] * rq * g1.w);
                  qf[ds] = __builtin_bit_cast(bf16x8, pk); } }
            const float sinkr = ((const LAS float*)(L + AT_SK))[hq] - *(const LAS float*)(L + AT_REF);
            const LAS float* bl = (const LAS float*)(L + AT_BL) + g * 192 - (l31 - 4 * hi);
            const LAS float* blinf = (const LAS float*)(L + AT_BL) + 8 * 192 - (l31 - 4 * hi);
            f32x16 o[3];
            const f32x16 zero16 = (f32x16){0.f, 0.f, 0.f, 0.f, 0.f, 0.f, 0.f, 0.f, 0.f, 0.f, 0.f, 0.f, 0.f, 0.f, 0.f, 0.f};
            v4u onesv; onesv.x = onesv.y = onesv.z = onesv.w = (l31 == 0) ? 0x3f803f80u : 0u; const bf16x8 onesf = __builtin_bit_cast(bf16x8, onesv);
#pragma unroll
            for (int kk = 0; kk < 5; ++kk) {
                f32x16 a;
#pragma unroll
                for (int r = 0; r < 16; ++r) a[r] = ((qb == 0 && qt + kk < 4) ? blinf : bl)[31 + 32 * kk + (r & 3) + 8 * (r >> 2)];
#pragma unroll
                for (int ds = 0; ds < 4; ++ds) { const bf16x8 kf = *(const LAS bf16x8*)(L + AT_KS + (2 * ds + hi) * 4096 + (32 * (qt + kk) + l31) * 16);
                    a = __builtin_amdgcn_mfma_f32_32x32x16_bf16(kf, qf[ds], a, 0, 0, 0); }
#pragma unroll
                for (int r = 0; r < 16; ++r) a[r] = __builtin_amdgcn_exp2f(a[r]);
#pragma unroll
                for (int s = 0; s < 2; ++s) { v4u pk; pk.x = cvtpk(a[8 * s], a[8 * s + 1]); pk.y = cvtpk(a[8 * s + 2], a[8 * s + 3]); pk.z = cvtpk(a[8 * s + 4], a[8 * s + 5]); pk.w = cvtpk(a[8 * s + 6], a[8 * s + 7]);
                    const bf16x8 pf = __builtin_bit_cast(bf16x8, pk);
#pragma unroll
                    for (int dt = 0; dt < 2; ++dt) { const LAS unsigned char* vp = L + AT_VT + (32 * dt + l31) * AT_VSTRIDE + (32 * (qt + kk) + 16 * s + 4 * hi) * 2;
                        const unsigned long long lo = *(const LAS unsigned long long*)vp, hi8 = *(const LAS unsigned long long*)(vp + 16);
                        v4u vv; vv.x = (unsigned)lo; vv.y = (unsigned)(lo >> 32); vv.z = (unsigned)hi8; vv.w = (unsigned)(hi8 >> 32);
                        o[dt] = __builtin_amdgcn_mfma_f32_32x32x16_bf16(__builtin_bit_cast(bf16x8, vv), pf, (kk == 0 && s == 0) ? zero16 : o[dt], 0, 0, 0); }
                    o[2] = __builtin_amdgcn_mfma_f32_32x32x16_bf16(onesf, pf, (kk == 0 && s == 0) ? zero16 : o[2], 0, 0, 0); }
 }
            const float sum = __shfl(o[2][0], l31);
            const float inv = __builtin_amdgcn_rcpf(sum + __builtin_amdgcn_exp2f(sinkr));
#pragma unroll
            for (int dt = 0; dt < 2; ++dt)
#pragma unroll
                for (int k = 0; k < 4; ++k) { LAS unsigned long long* gp = (LAS unsigned long long*)(GL + l31 * AT_RS + (32 * dt + 8 * k + 4 * hi) * 2); const unsigned long long gv = *gp;
                    const unsigned glo = (unsigned)gv, ghi = (unsigned)(gv >> 32);
                    const float y0_ = o[dt][4 * k] * inv * fsilu(bflo(glo)), y1_ = o[dt][4 * k + 1] * inv * fsilu(bfhi(glo)), y2_ = o[dt][4 * k + 2] * inv * fsilu(bflo(ghi)), y3_ = o[dt][4 * k + 3] * inv * fsilu(bfhi(ghi));
                    *gp = (unsigned long long)cvtpk(y0_, y1_) | ((unsigned long long)cvtpk(y2_, y3_) << 32); }
            asm volatile("s_waitcnt lgkmcnt(0)" ::: "memory");
            { bf16* op = y0 + (R0 + mrr) * GW + 1024 + hq * 64 + 8 * mch;
#pragma unroll
              for (int i = 0; i < 4; ++i) *(v4u*)(op + (size_t)(8 * i) * GW) = *(const LAS v4u*)(GL + (8 * i + mrr) * AT_RS + 16 * mch); }
        }
    }
#undef AT_LOAD_KV
}


#ifndef WGM_G1
#define WGM_G1 4
#endif
#ifndef WGM_G2
#define WGM_G2 4
#endif
#ifndef WGM_G3
#define WGM_G3 4
#endif
#ifndef WGM_G4
#define WGM_G4 4
#endif
__global__ void __launch_bounds__(NWAVES * 64, 2) mega(Args args) {
    extern __shared__ __attribute__((aligned(16))) unsigned char lds[];
    Frame F;
    F.lds = (LAS unsigned char*)lds;
    F.MISC = (volatile LAS unsigned*)(F.lds + MISC_OFF);
    F.wave = __builtin_amdgcn_readfirstlane((int)threadIdx.x >> 6);
    F.G = gridDim.x; { const int bx = blockIdx.x; F.vcu = (F.G % 8 == 0) ? (bx % 8) * (F.G / 8) + bx / 8 : bx; }
    unsigned char* ws = args.ws;
    F.ctl = (gu32*)(ws + WS_CTL);
    for (int u = threadIdx.x; u < (LDS_BYTES - LDSCTL_OFF) / 4; u += NWAVES * 64) ((LAS unsigned*)(F.lds + LDSCTL_OFF))[u] = 0u;
    __syncthreads();
    const int lo = args.ph_lo, hi = args.ph_hi;
    const bool multi = (hi - lo) > 1;
    XcdBarrier bar; bar.bar = (unsigned*)(F.ctl + CW_BAR); bar.x = 0; bar.st = nullptr;
    if (multi) bar = xcd_barrier_post((unsigned*)(F.ctl + CW_BAR), F.MISC + 8);
    bar.wave = F.wave;
#define IN(k) (lo <= (k) && (k) < hi)
#define BOTH(k) (IN(k) && IN((k) + 1))
#define GRID_BAR() xcd_barrier(bar)
#ifndef PROBE_PH
#define PROBE_PH (-1)
#endif
#define PH_T0(k) unsigned long long pt0_ = 0; if (PROBE_PH == (k)) pt0_ = __builtin_amdgcn_s_memrealtime()
#define PH_T1(k) do { if (PROBE_PH == (k)) { const unsigned long long t1_ = __builtin_amdgcn_s_memrealtime(), end_ = t1_ + (t1_ - pt0_); while (__builtin_amdgcn_s_memrealtime() < end_) __builtin_amdgcn_s_sleep(8); } } while (0)
#define WSP(T, off) ((T*)(args.ws + (off)))
#define GDUMMY WSP(unsigned, WS_CTL + 512 * 1024)

    if (IN(0)) { PH_T0(0); p0_prologue(F, args, ws); if (BOTH(0)) GRID_BAR(); PH_T1(0); }
    if (IN(1)) { PH_T0(1);
        pg8::Gemm g{(const bf16*)args.out, WSP(bf16, WS_WAT), M, NA, D, GDUMMY}; pg8::StaticOrder So; So.init(M, NA, F.G, (int)blockIdx.x, WGM_G1);
        pg8::EpiZ0 E{WSP(bf16, WS_Z0), NA};
        { const int nun = (M / 256) * (NA / 256), full = nun / F.G, rem = nun - full * F.G;
          if (rem > 0 && (int)blockIdx.x >= rem) { p0_layer1_weights(F, args, ws, (int)blockIdx.x - rem, F.G - rem); __syncthreads(); }
          else if (rem == 0) { p0_layer1_weights(F, args, ws, (int)blockIdx.x, F.G); __syncthreads(); } }
        pg8::gemm_phase<pg8::EpiZ0, pg8::StaticOrder, true, true>(F.lds + RING_OFF, g, So, E, F.wave);
        if (BOTH(1)) GRID_BAR(); PH_T1(1);
    }
#ifndef REPS_LRU
#define REPS_LRU 1
#endif
#ifndef REPS_ATT
#define REPS_ATT 1
#endif
    if (IN(2)) { PH_T0(2); for (int rp = 0; rp < REPS_LRU; ++rp) { p2_lru(F, args, ws); if (rp + 1 < REPS_LRU) __syncthreads(); } for (int rp = 0; rp < REPS_ATT; ++rp) { p2_attn(F, args, ws); if (rp + 1 < REPS_ATT) __syncthreads(); } if (BOTH(2)) GRID_BAR(); PH_T1(2); }
    if (IN(3)) { PH_T0(3);
#ifdef PROBE_SKEW3
        if (((int)blockIdx.x >> 3) & 1) { const unsigned long long te_ = __builtin_amdgcn_s_memrealtime() + PROBE_SKEW3; while (__builtin_amdgcn_s_memrealtime() < te_) __builtin_amdgcn_s_sleep(8); }
#endif
        pg8::Gemm g{WSP(bf16, WS_Y0), WSP(bf16, WS_WOAT), M, D, GW, GDUMMY}; pg8::StaticOrder So; So.init(M, D, F.G, (int)blockIdx.x, WGM_G2);
        pg8::EpiRes1 E{args.in[0], WSP(bf16, WS_X1B), WSP(float, WS_SSQ)};
        pg8::gemm_phase<pg8::EpiRes1, pg8::StaticOrder, true, true>(F.lds + RING_OFF, g, So, E, F.wave);
        if (BOTH(3)) GRID_BAR(); PH_T1(3);
    }
    if (IN(4)) { PH_T0(4);
#ifdef PROBE_SKEW4
        if (((int)blockIdx.x >> 3) & 1) { const unsigned long long te_ = __builtin_amdgcn_s_memrealtime() + PROBE_SKEW4; while (__builtin_amdgcn_s_memrealtime() < te_) __builtin_amdgcn_s_sleep(8); }
#endif
        pg8::Gemm g{WSP(bf16, WS_X1B), WSP(bf16, WS_WCT), M, NC, D, GDUMMY}; pg8::StaticOrder So; So.init(M, NC, F.G, (int)blockIdx.x, WGM_G3);
        pg8::EpiZ1 E{WSP(bf16, WS_U), (size_t)(WS_V - WS_U) / 2, WSP(float, WS_VST)};
        pg8::gemm_phase<pg8::EpiZ1, pg8::StaticOrder, true, true>(F.lds + RING_OFF, g, So, E, F.wave);
        if (BOTH(4)) GRID_BAR(); PH_T1(4);
    }
    if (IN(5)) { PH_T0(5); p5_gate(F, args, ws); if (BOTH(5)) GRID_BAR(); PH_T1(5); }
    if (IN(6)) { PH_T0(6);
#ifdef PROBE_SKEW6
        if (((int)blockIdx.x >> 3) & 1) { const unsigned long long te_ = __builtin_amdgcn_s_memrealtime() + PROBE_SKEW6; while (__builtin_amdgcn_s_memrealtime() < te_) __builtin_amdgcn_s_sleep(8); }
#endif
        pg8::Gemm g{WSP(bf16, WS_U), WSP(bf16, WS_WOCT), M, D, GW, GDUMMY}; pg8::StaticOrder So; So.init(M, D, F.G, (int)blockIdx.x, WGM_G4);
        pg8::EpiRes3 E{WSP(bf16, WS_X1B), args.out};
        pg8::gemm_phase<pg8::EpiRes3, pg8::StaticOrder, true, true>(F.lds + RING_OFF, g, So, E, F.wave); PH_T1(6);
    }
#undef PH_T0
#undef PH_T1
#undef WSP
#undef GDUMMY
#undef IN
#undef BOTH
}


static void launch_mega(const Args& a0, int lo, int hi, int grid, hipStream_t stream) {
    Args a = a0; a.ph_lo = lo; a.ph_hi = hi;
    hipLaunchKernelGGL(mega, dim3(grid), dim3(NWAVES * 64), LDS_BYTES, stream, a);
    const hipError_t le = hipPeekAtLastError();
    if (le != hipSuccess) fprintf(stderr, "kernel_launch: mega launch [%d,%d) failed: %s\n", lo, hi, hipGetErrorName(le));
}

extern "C" void kernel_launch(void* const* d_in, const int* in_sizes, int n_in, void* d_out, int out_size, void* d_ws, size_t ws_size, hipStream_t stream) {
    static int grid = 0;
    if (grid == 0) {
        if (n_in != 22 || in_sizes[0] != M * D || out_size != M * D || ws_size < WS_END) {
            fprintf(stderr, "kernel_launch: unexpected shapes: n_in %d in0 %d out %d ws %zu\n", n_in, n_in > 0 ? in_sizes[0] : -1, out_size, ws_size); grid = -1; return; }
        int dev = 0, cus = 0, per_cu = 0;
        if (hipGetDevice(&dev) != hipSuccess || hipDeviceGetAttribute(&cus, hipDeviceAttributeMultiprocessorCount, dev) != hipSuccess) { fprintf(stderr, "kernel_launch: device query failed\n"); grid = -1; return; }
        if (hipFuncSetAttribute((const void*)mega, hipFuncAttributeMaxDynamicSharedMemorySize, LDS_BYTES) != hipSuccess) { fprintf(stderr, "kernel_launch: hipFuncSetAttribute failed\n"); grid = -1; return; }
        if (hipOccupancyMaxActiveBlocksPerMultiprocessor(&per_cu, (const void*)mega, NWAVES * 64, LDS_BYTES) != hipSuccess || per_cu < 1)
            fprintf(stderr, "kernel_launch: note: occupancy query reports %d workgroups per CU\n", per_cu);
        (void)hipGetLastError();
        grid = cus;
    }
    if (grid < 0) return;
    unsigned char* ws = (unsigned char*)d_ws; float* out = (float*)d_out;
    if (hipMemsetAsync(ws + WS_CTL, 0, CTL_ZERO_BYTES, stream) != hipSuccess) { fprintf(stderr, "kernel_launch: memset failed\n"); return; }
    Args a{};
    for (int i = 0; i < 22; ++i) a.in[i] = (const float*)d_in[i];
    a.out = out; a.ws = ws;

#ifndef N_LAUNCHES
#define N_LAUNCHES 1
#endif
#ifndef PROBE_DUP
#define PROBE_DUP 0
#endif
#if N_LAUNCHES == 1
    launch_mega(a, 0, 7, grid, stream);
#else
    for (int ph = 0; ph < 7; ++ph) { launch_mega(a, ph, ph + 1, grid, stream); if ((PROBE_DUP >> ph) & 1) launch_mega(a, ph, ph + 1, grid, stream); }
#endif
}
```

```cpp
#include <hip/hip_runtime.h>
#include <cstdint>
#include <cstdio>

typedef unsigned short bf16;
constexpr int D = 1024, NB = 16, S = 2048, M = NB * S;
constexpr int NA = 4352, NC = 6144, GW = 2048;
constexpr float EPS = 1e-6f;
constexpr size_t MiB = 1u << 20;
constexpr size_t WS_CTL = 0, CTL_ZERO_BYTES = 32 * 1024;
constexpr size_t WS_BIAS = 1 * MiB;
constexpr size_t WS_WAT = 2 * MiB;
constexpr size_t WS_WOAT = 11 * MiB;
constexpr size_t WS_WCT = 15 * MiB;
constexpr size_t WS_WOCT = 27 * MiB;
constexpr size_t WS_WG = 31 * MiB;
constexpr size_t WS_WS = 31 * MiB + 512 * 1024;
constexpr size_t WS_SSQ = 32 * MiB;
constexpr size_t WS_RMS0 = 42 * MiB;
constexpr size_t WS_VST = 34 * MiB;
constexpr size_t WS_Z0 = 48 * MiB;
constexpr size_t WS_Y0 = 320 * MiB;
constexpr size_t WS_X1B = 448 * MiB;
constexpr size_t WS_U = 48 * MiB, WS_V = 176 * MiB;
constexpr size_t WS_END = 512 * MiB;

__device__ __forceinline__ unsigned f2bf(float f) { unsigned u = __builtin_bit_cast(unsigned, f); return (u + 0x7fffu + ((u >> 16) & 1u)) >> 16; }
__device__ __forceinline__ float bf2f(unsigned h) { return __builtin_bit_cast(float, h << 16); }

namespace pg8 {
#define PG8_LAS __attribute__((address_space(3)))
typedef unsigned short bf16_t;
typedef short bf16x8 __attribute__((ext_vector_type(8)));
typedef float f32x4 __attribute__((ext_vector_type(4)));
typedef unsigned u32x4 __attribute__((ext_vector_type(4)));
constexpr int BM = 256, BK = 64, HALF = 128, HTB = HALF * BK * 2  , STAGE_BYTES = 8 * HTB, NXCD = 8, WGM = 4;

__host__ __device__ __forceinline__ int lds_byte(int r, int c) { const int st = (r >> 4) * 2 + (c >> 5), rr = r & 15, cc = c & 31, ob = rr * 64 + cc * 2; return st * 1024 + (ob ^ (((ob >> 9) & 1) << 5)); }
__host__ __device__ __forceinline__ void stage_rc(int b, int& R, int& C) { const int st = b / 1024, sb = b % 1024, swz = sb ^ (((sb >> 9) & 1) << 5); R = (st >> 1) * 16 + swz / 64; C = (st & 1) * 32 + (swz % 64) / 2; }
__host__ __device__ __forceinline__ int perm32(int rho) { const int n = rho >> 4, i = rho & 15; return 8 * (i >> 2) + 4 * n + (i & 3); }

struct Unit { int pm, pn, idx; };
struct Gemm { const bf16_t* A; const bf16_t* Bt; int M, N, K; unsigned* dummy; };

struct StaticOrder {
    int nM, nN, nwg, G, c, wgm;
    __host__ __device__ void init(int M, int N, int G_, int c_, int wgm_ = WGM) { nM = M / BM; nN = N / BM; nwg = nM * nN; G = G_; c = c_; wgm = wgm_; }
    __host__ __device__ bool next(int i, Unit& u) const {
        const long L = (long)i * G + c; if (L >= nwg) return false;
        int wgid = (int)L; { const int q = nwg / NXCD, r = nwg % NXCD, xcd = wgid % NXCD, off = wgid / NXCD; wgid = (xcd < r ? xcd * (q + 1) : r * (q + 1) + (xcd - r) * q) + off; }
        const int nig = wgm * nN, gid = wgid / nig, fm = gid * wgm, gsz = (nM - fm) < wgm ? (nM - fm) : wgm;
        u.pm = fm + ((wgid % nig) % gsz); u.pn = (wgid % nig) / gsz; u.idx = i; return true;
    }
    __device__ __forceinline__ void a_ready(const Unit&) const {}
    __device__ __forceinline__ void done(const Unit&) const {}
};
struct SplitOrder {
    StaticOrder a, b; int na, ia;
    __host__ __device__ void init(int M, int NAcols, int NBcols, int G_, int c_, int wgm_) { a.init(M, NAcols, G_, c_, wgm_); b.init(M, NBcols, G_, c_, wgm_); na = NAcols / BM; ia = (a.nwg - c_ + G_ - 1) / G_; if (ia < 0) ia = 0; }
    __host__ __device__ bool next(int i, Unit& u) const {
        if (i < ia) { const bool ok = a.next(i, u); u.idx = i; return ok; }
        const bool ok = b.next(i - ia, u); if (ok) { u.pn += na; u.idx = i; } return ok;
    }
    __device__ __forceinline__ void a_ready(const Unit&) const {}
    __device__ __forceinline__ void done(const Unit&) const {}
};
__device__ __forceinline__ unsigned cvt_pk_bf16(float lo, float hi) { unsigned r; asm volatile("v_cvt_pk_bf16_f32 %0, %1, %2" : "=v"(r) : "v"(lo), "v"(hi)); return r; }
typedef float f32x2 __attribute__((ext_vector_type(2)));
typedef unsigned u32x2 __attribute__((ext_vector_type(2)));
#ifndef REPS_Z0
#define REPS_Z0 1
#endif
#ifndef REPS_R1
#define REPS_R1 1
#endif
#ifndef REPS_Z1
#define REPS_Z1 1
#endif
__device__ __forceinline__ unsigned cvt_pk_bf16_c(float lo, float hi) { typedef float f2_ __attribute__((ext_vector_type(2))); typedef __bf16 b2_ __attribute__((ext_vector_type(2)));
    const f2_ v = {lo, hi}; return __builtin_bit_cast(unsigned, __builtin_convertvector(v, b2_)); }
struct EpiZ0 {
    static constexpr bool PERM = true, AFTER_DRAIN = false, ADJ = true; static constexpr int REPS = REPS_Z0, NST = 16;
    bf16_t* O; int ldc; const float* qg; const float* kg;
    __device__ __forceinline__ void operator()(const f32x4 (&acc)[2][2][4][2], const Unit& u, int wr, int wc, int fr, int fq) const {
        const int row0 = u.pm * BM + wr * 64 + fr, col0 = u.pn * BM + wc * 64 + 8 * fq;
        if ((u.pn >= 4 && u.pn < 8) || u.pn >= 13) {
#pragma unroll
            for (int ai = 0; ai < 2; ++ai)
#pragma unroll
                for (int m = 0; m < 4; ++m) { bf16_t* rowp = O + (size_t)(row0 + ai * HALF + m * 16) * ldc + col0;
#pragma unroll
                    for (int bj = 0; bj < 2; ++bj) { float s[8];
#pragma unroll
                        for (int e = 0; e < 8; ++e) { const float x = acc[ai][bj][m][e >> 2][e & 3]; s[e] = x * __builtin_amdgcn_rcpf(1.f + __builtin_amdgcn_exp2f(-1.4426950408889634f * x)); }
                        u32x4 w; w.x = cvt_pk_bf16_c(s[0], s[1]); w.y = cvt_pk_bf16_c(s[2], s[3]); w.z = cvt_pk_bf16_c(s[4], s[5]); w.w = cvt_pk_bf16_c(s[6], s[7]);
                        *(u32x4*)(rowp + bj * 32) = w; } }
        } else if ((u.pn >= 8 && u.pn < 12) || (u.pn == 12 && wc < 2)) {
            const bool isq = u.pn < 12; const float* gp = (isq ? qg : kg) + 8 * fq; const float sc = isq ? 0.125f * 1.4426950408889634f : 1.f;
            const f32x4 g00 = *(const f32x4*)gp, g01 = *(const f32x4*)(gp + 4), g10 = *(const f32x4*)(gp + 32), g11 = *(const f32x4*)(gp + 36);
#pragma unroll
            for (int ai = 0; ai < 2; ++ai)
#pragma unroll
                for (int m = 0; m < 4; ++m) { bf16_t* rowp = O + (size_t)(row0 + ai * HALF + m * 16) * ldc + col0; float ss = 0.f;
#pragma unroll
                    for (int bj = 0; bj < 2; ++bj)
#pragma unroll
                        for (int e = 0; e < 8; ++e) { const float x = acc[ai][bj][m][e >> 2][e & 3]; ss += x * x; }
                    ss += __shfl_xor(ss, 16); ss += __shfl_xor(ss, 32);
                    const float r = rsqrtf(ss * (1.f / 64.f) + 1e-6f) * sc;
#pragma unroll
                    for (int bj = 0; bj < 2; ++bj) { const f32x4 ga = bj ? g10 : g00, gb = bj ? g11 : g01; const f32x4 v0 = acc[ai][bj][m][0], v1 = acc[ai][bj][m][1];
                        u32x4 w; w.x = cvt_pk_bf16_c(v0[0] * r * ga[0], v0[1] * r * ga[1]); w.y = cvt_pk_bf16_c(v0[2] * r * ga[2], v0[3] * r * ga[3]);
                        w.z = cvt_pk_bf16_c(v1[0] * r * gb[0], v1[1] * r * gb[1]); w.w = cvt_pk_bf16_c(v1[2] * r * gb[2], v1[3] * r * gb[3]);
                        *(u32x4*)(rowp + bj * 32) = w; } }
        } else {
#pragma unroll
        for (int ai = 0; ai < 2; ++ai)
#pragma unroll
            for (int m = 0; m < 4; ++m) { bf16_t* rowp = O + (size_t)(row0 + ai * HALF + m * 16) * ldc + col0;
#pragma unroll
                for (int bj = 0; bj < 2; ++bj) { const f32x4 v0 = acc[ai][bj][m][0], v1 = acc[ai][bj][m][1];
                    u32x4 w; w.x = cvt_pk_bf16(v0[0], v0[1]); w.y = cvt_pk_bf16(v0[2], v0[3]); w.z = cvt_pk_bf16(v1[0], v1[1]); w.w = cvt_pk_bf16(v1[2], v1[3]);
                    *(u32x4*)(rowp + bj * 32) = w; } }
        }
    }
};
struct EpiRes1 {
    static constexpr bool PERM = true, AFTER_DRAIN = false, ADJ = false; static constexpr int REPS = REPS_R1, NST = 24;
    const bf16_t* h0; const float* rms0; bf16_t* x1b; float* ssq;
    __device__ __forceinline__ void operator()(const f32x4 (&acc)[2][2][4][2], const Unit& u, int wr, int wc, int fr, int fq) const {
        const int row0 = u.pm * BM + wr * 64 + fr, col0 = u.pn * BM + wc * 32 + 8 * fq;
        float rm[8];
#pragma unroll
        for (int st = 0; st < 8; ++st) rm[st] = rms0[row0 + (st >> 2) * HALF + (st & 3) * 16];
        u32x4 rr[3][2];
#define E1_LOAD(s_) do { const size_t off_ = (size_t)(row0 + ((s_) >> 2) * HALF + ((s_) & 3) * 16) * 1024 + col0; rr[(s_) % 3][0] = __builtin_nontemporal_load((const u32x4*)(h0 + off_)); rr[(s_) % 3][1] = __builtin_nontemporal_load((const u32x4*)(h0 + off_ + HALF)); } while (0)
        E1_LOAD(0); E1_LOAD(1);
#pragma unroll
        for (int st = 0; st < 8; ++st) { const int ai = st >> 2, m = st & 3; const int row = row0 + ai * HALF + m * 16; const size_t off = (size_t)row * 1024 + col0; float s = 0.f;
            if (st == 0) E1_LOAD(2); else if (st == 1) E1_LOAD(3); else if (st == 2) E1_LOAD(4); else if (st == 3) E1_LOAD(5); else if (st == 4) E1_LOAD(6); else if (st == 5) E1_LOAD(7);
            __builtin_amdgcn_sched_barrier(0);
#pragma unroll
            for (int bj = 0; bj < 2; ++bj) { const u32x4 xb = rr[st % 3][bj]; const float rmr = rm[st];
                f32x4 r0, r1; r0[0] = __builtin_bit_cast(float, xb.x << 16); r0[1] = __builtin_bit_cast(float, xb.x & 0xffff0000u); r0[2] = __builtin_bit_cast(float, xb.y << 16); r0[3] = __builtin_bit_cast(float, xb.y & 0xffff0000u);
                r1[0] = __builtin_bit_cast(float, xb.z << 16); r1[1] = __builtin_bit_cast(float, xb.z & 0xffff0000u); r1[2] = __builtin_bit_cast(float, xb.w << 16); r1[3] = __builtin_bit_cast(float, xb.w & 0xffff0000u);
                const f32x4 v0 = acc[ai][bj][m][0] + r0 * rmr, v1 = acc[ai][bj][m][1] + r1 * rmr;
                u32x4 w; w.x = cvt_pk_bf16(v0[0], v0[1]); w.y = cvt_pk_bf16(v0[2], v0[3]); w.z = cvt_pk_bf16(v1[0], v1[1]); w.w = cvt_pk_bf16(v1[2], v1[3]);
                *(u32x4*)(x1b + off + bj * HALF) = w;
                s += (v0[0] * v0[0] + v0[1] * v0[1]) + (v0[2] * v0[2] + v0[3] * v0[3]) + (v1[0] * v1[0] + v1[1] * v1[1]) + (v1[2] * v1[2] + v1[3] * v1[3]); }
            s += __shfl_xor(s, 16); s += __shfl_xor(s, 32);
            if (fq == 0) ssq[(size_t)row * 16 + u.pn * 4 + wc] = s;
            __builtin_amdgcn_sched_barrier(0); }
#undef E1_LOAD
    }
};
struct EpiZ1 {
    static constexpr bool PERM = true, AFTER_DRAIN = false, ADJ = false; static constexpr int REPS = REPS_Z1, NST = 8;
    bf16_t* UG; bf16_t* V; float* vst; const PG8_LAS float* rxl;
    __device__ __forceinline__ void operator()(const f32x4 (&acc)[2][2][4][2], const Unit& u, int wr, int wc, int fr, int fq) const {
        const int rl0 = wr * 64 + fr, row0 = u.pm * BM + rl0;
        if (u.pn < 16) {
            const PG8_LAS float* rxp = rxl + u.idx * 256 + rl0;
            bf16_t* base = UG + (size_t)row0 * 2048 + u.pn * 128 + wc * 32 + 8 * fq;
#pragma unroll
            for (int ai = 0; ai < 2; ++ai)
#pragma unroll
                for (int m = 0; m < 4; ++m) { const float rx = rxp[ai * HALF + m * 16]; float y[8];
#pragma unroll
                    for (int n = 0; n < 2; ++n)
#pragma unroll
                        for (int e = 0; e < 4; ++e) { const float uu = rx * acc[ai][0][m][n][e], gg = rx * acc[ai][1][m][n][e];
                            y[4 * n + e] = uu * gg * __builtin_amdgcn_rcpf(1.f + __builtin_amdgcn_exp2f(-1.4426950408889634f * gg)); }
                    u32x4 w; w.x = cvt_pk_bf16_c(y[0], y[1]); w.y = cvt_pk_bf16_c(y[2], y[3]); w.z = cvt_pk_bf16_c(y[4], y[5]); w.w = cvt_pk_bf16_c(y[6], y[7]);
                    __builtin_nontemporal_store(w, (u32x4*)(base + (size_t)(ai * HALF + m * 16) * 2048)); }
        } else {
            const int pv = u.pn - 16; const int col0 = pv * BM + wc * 32 + 8 * fq;
#pragma unroll
            for (int ai = 0; ai < 2; ++ai)
#pragma unroll
                for (int m = 0; m < 4; ++m) { const int row = row0 + ai * HALF + m * 16;
                    bf16_t* rowp = V + (size_t)row * 2048 + col0; float s1 = 0.f, s2 = 0.f;
#pragma unroll
                    for (int bj = 0; bj < 2; ++bj) { const f32x4 v0 = acc[ai][bj][m][0], v1 = acc[ai][bj][m][1];
                        u32x4 w; w.x = cvt_pk_bf16(v0[0], v0[1]); w.y = cvt_pk_bf16(v0[2], v0[3]); w.z = cvt_pk_bf16(v1[0], v1[1]); w.w = cvt_pk_bf16(v1[2], v1[3]);
                        __builtin_nontemporal_store(w, (u32x4*)(rowp + bj * HALF));
                        s1 += ((v0[0] + v0[1]) + (v0[2] + v0[3])) + ((v1[0] + v1[1]) + (v1[2] + v1[3]));
                        s2 += (v0[0] * v0[0] + v0[1] * v0[1]) + (v0[2] * v0[2] + v0[3] * v0[3]) + (v1[0] * v1[0] + v1[1] * v1[1]) + (v1[2] * v1[2] + v1[3] * v1[3]); }
                    s1 += __shfl_xor(s1, 16); s1 += __shfl_xor(s1, 32); s2 += __shfl_xor(s2, 16); s2 += __shfl_xor(s2, 32);
                    if (fq == 0) { f32x2 o; o.x = s1; o.y = s2; *(f32x2*)(vst + ((size_t)row * 32 + pv * 4 + wc) * 2) = o; } }
        }
    }
};
struct EpiRes3 {
    static constexpr bool PERM = true, AFTER_DRAIN = false, ADJ = false; static constexpr int REPS = 1, NST = 32;
    const bf16_t* x1b; float* out;
    __device__ __forceinline__ void operator()(const f32x4 (&acc)[2][2][4][2], const Unit& u, int wr, int wc, int fr, int fq) const {
        const int row0 = u.pm * BM + wr * 64 + fr, col0 = u.pn * BM + wc * 32 + 8 * fq;
        u32x4 xr[3][2];
#define E3_LOAD(s_) do { const size_t off_ = (size_t)(row0 + ((s_) >> 2) * HALF + ((s_) & 3) * 16) * 1024 + col0; xr[(s_) % 3][0] = __builtin_nontemporal_load((const u32x4*)(x1b + off_)); xr[(s_) % 3][1] = __builtin_nontemporal_load((const u32x4*)(x1b + off_ + HALF)); } while (0)
        E3_LOAD(0); E3_LOAD(1);
#pragma unroll
        for (int st = 0; st < 8; ++st) { const int ai = st >> 2, m = st & 3; const size_t off = (size_t)(row0 + ai * HALF + m * 16) * 1024 + col0;
            if (st == 0) E3_LOAD(2); else if (st == 1) E3_LOAD(3); else if (st == 2) E3_LOAD(4); else if (st == 3) E3_LOAD(5); else if (st == 4) E3_LOAD(6); else if (st == 5) E3_LOAD(7);
            __builtin_amdgcn_sched_barrier(0);
#pragma unroll
            for (int bj = 0; bj < 2; ++bj) { const u32x4 xb = xr[st % 3][bj];
                f32x4 r0, r1; r0[0] = __builtin_bit_cast(float, xb.x << 16); r0[1] = __builtin_bit_cast(float, xb.x & 0xffff0000u); r0[2] = __builtin_bit_cast(float, xb.y << 16); r0[3] = __builtin_bit_cast(float, xb.y & 0xffff0000u);
                r1[0] = __builtin_bit_cast(float, xb.z << 16); r1[1] = __builtin_bit_cast(float, xb.z & 0xffff0000u); r1[2] = __builtin_bit_cast(float, xb.w << 16); r1[3] = __builtin_bit_cast(float, xb.w & 0xffff0000u);
                __builtin_nontemporal_store(acc[ai][bj][m][0] + r0, (f32x4*)(out + off + bj * HALF)); __builtin_nontemporal_store(acc[ai][bj][m][1] + r1, (f32x4*)(out + off + bj * HALF + 4)); }
            __builtin_amdgcn_sched_barrier(0); }
#undef E3_LOAD
    }
};
#ifndef PROBE_KDUP
#define PROBE_KDUP 0
#endif
template <class Epi, class Sched, bool ALIGN_EPI = false, bool SP2 = false>
__device__ __forceinline__ void gemm_phase(PG8_LAS unsigned char* lds, const Gemm g, const Sched& S, const Epi& E, const int wave_in) {
    const int wid = wave_in; int lane = (int)__builtin_amdgcn_mbcnt_hi(~0u, __builtin_amdgcn_mbcnt_lo(~0u, 0u)); asm volatile("" : "+v"(lane));
    const int tid = wid * 64 + lane, wr = wid >> 2, wc = wid & 3, fr = lane & 15, fq = lane >> 4;
    const int K = g.K, nt = K / BK;
    unsigned voffA[2], voffB[2];
#pragma unroll
    for (int i = 0; i < 2; ++i) { int R, C; stage_rc(tid * 16 + i * 8192, R, C); const int Rb = Epi::PERM ? ((R & ~31) + perm32(R & 31)) : R;
        const int Rg = Epi::ADJ ? ((R >> 5) * 64 + (Rb & 31)) : Rb;
        voffA[i] = (unsigned)(R * K + C) * 2u; voffB[i] = (unsigned)(Rg * K + C) * 2u; }
    const size_t kstep = (size_t)(BK * 2);
    const size_t hstep = (size_t)HALF * K * 2;
    const size_t tstep = 2 * hstep;
    const size_t hstepB = Epi::ADJ ? (size_t)32 * K * 2 : hstep;
    const unsigned ldsw = (unsigned)wid * 1024u;
    const int aoff = lds_byte(wr * 64 + fr, fq * 8); int boff = lds_byte(wc * 32 + fr, fq * 8) + 4 * HTB; asm volatile("" : "+v"(boff));
#define PG8_SA(b, h) (((b) * 2 + (h)) * HTB)
#define PG8_SB(b, h) ((4 + (b) * 2 + (h)) * HTB)
#define PG8_SBR(b, h) (((b) * 2 + (h)) * HTB)
#define PG8_STAGE(bufoff, gbase, voff) do { _Pragma("unroll") for (int _i = 0; _i < 2; ++_i) \
        __builtin_amdgcn_global_load_lds((const unsigned*)((const char*)(gbase) + (voff)[_i]), (PG8_LAS unsigned*)(lds + (bufoff) + ldsw + _i * 8192), 16, 0, 0); } while (0)
#define PG8_LDA(dst, b, h) do { _Pragma("unroll") for (int m = 0; m < 4; ++m) _Pragma("unroll") for (int k = 0; k < 2; ++k) dst[m][k] = *(const PG8_LAS bf16x8*)(lds + PG8_SA(b, h) + aoff + m * 2048 + k * 1024); } while (0)
#define PG8_LDB(dst, b, h) do { _Pragma("unroll") for (int n = 0; n < 2; ++n) _Pragma("unroll") for (int k = 0; k < 2; ++k) dst[n][k] = *(const PG8_LAS bf16x8*)(lds + boff + (PG8_SBR(b, h) + n * 2048 + k * 1024)); } while (0)
#define PG8_MMA(ai, bj, At, Bt) do { __builtin_amdgcn_s_setprio(1); _Pragma("unroll") for (int m = 0; m < 4; ++m) _Pragma("unroll") for (int n = 0; n < 2; ++n) _Pragma("unroll") for (int k = 0; k < 2; ++k) \
        acc[ai][bj][m][n] = __builtin_amdgcn_mfma_f32_16x16x32_bf16(Bt[n][k], At[m][k], acc[ai][bj][m][n], 0, 0, 0); __builtin_amdgcn_s_setprio(0); } while (0)
#define PG8_WAIT_V(n) asm volatile("s_waitcnt vmcnt(" #n ")" ::: "memory")
#define PG8_WAIT_VX(n) asm volatile("s_waitcnt vmcnt(%0)" :: "i"(n) : "memory")
#define PG8_WAIT_L(n) asm volatile("s_waitcnt lgkmcnt(" #n ")" ::: "memory")
#define PG8_BAR __builtin_amdgcn_s_barrier()
#define PG8_SCHED __builtin_amdgcn_sched_barrier(0)
#define PG8_SP2_BODY(W01) do { \
            PG8_LDB(B0, 0, 0); PG8_LDB(B1, 0, 1); PG8_SCHED; PG8_LDA(At, 0, 0); PG8_STAGE(PG8_SA(1, 1), a1 + hstep, voffA); \
            W01; PG8_WAIT_L(0); PG8_BAR; PG8_MMA(0, 0, At, B0); PG8_MMA(0, 1, At, B1); PG8_BAR; PG8_SCHED; \
            PG8_LDA(At, 0, 1); PG8_STAGE(PG8_SB(0, 0), b2, voffB); PG8_STAGE(PG8_SB(0, 1), b2 + hstepB, voffB); PG8_STAGE(PG8_SA(0, 0), a2, voffA); \
            W01; PG8_WAIT_L(0); PG8_BAR; PG8_MMA(1, 0, At, B0); PG8_MMA(1, 1, At, B1); PG8_BAR; PG8_SCHED; \
            PG8_LDB(B0, 1, 0); PG8_LDB(B1, 1, 1); PG8_SCHED; PG8_LDA(At, 1, 0); PG8_STAGE(PG8_SA(0, 1), a2 + hstep, voffA); \
            PG8_WAIT_V(8); PG8_WAIT_L(0); PG8_BAR; PG8_MMA(0, 0, At, B0); PG8_MMA(0, 1, At, B1); PG8_BAR; PG8_SCHED; \
            PG8_LDA(At, 1, 1); PG8_STAGE(PG8_SB(1, 0), b3, voffB); PG8_STAGE(PG8_SB(1, 1), b3 + hstepB, voffB); PG8_STAGE(PG8_SA(1, 0), a3, voffA); \
            PG8_WAIT_V(8); PG8_WAIT_L(0); PG8_BAR; PG8_MMA(1, 0, At, B0); PG8_MMA(1, 1, At, B1); PG8_BAR; PG8_SCHED; \
            } while (0)
    Unit cur, nxt; int ui = 0;
    if (!S.next(0, cur)) return;
    f32x4 acc[2][2][4][2];
#pragma unroll
    for (int a = 0; a < 2; ++a)
#pragma unroll
        for (int b = 0; b < 2; ++b)
#pragma unroll
            for (int m = 0; m < 4; ++m)
#pragma unroll
                for (int n = 0; n < 2; ++n) acc[a][b][m][n] = (f32x4){0.f, 0.f, 0.f, 0.f};
    bf16x8 At[4][2], B0[2][2], B1[2][2];
    const char* cA = (const char*)g.A + (size_t)cur.pm * tstep; const char* cB = (const char*)g.Bt + (size_t)cur.pn * tstep;
    S.a_ready(cur);
    if constexpr (SP2) {
        PG8_STAGE(PG8_SB(0, 0), cB, voffB); PG8_STAGE(PG8_SB(0, 1), cB + hstepB, voffB); PG8_STAGE(PG8_SA(0, 0), cA, voffA); PG8_STAGE(PG8_SA(0, 1), cA + hstep, voffA);
        if (wr == 1) PG8_BAR;
        PG8_WAIT_V(2); PG8_BAR;
        PG8_STAGE(PG8_SB(1, 0), cB + kstep, voffB); PG8_STAGE(PG8_SA(1, 0), cA + kstep, voffA); PG8_STAGE(PG8_SB(1, 1), cB + hstepB + kstep, voffB);
        PG8_WAIT_V(6); PG8_BAR;
    } else {
        PG8_STAGE(PG8_SB(0, 0), cB, voffB); PG8_STAGE(PG8_SA(0, 0), cA, voffA); PG8_STAGE(PG8_SB(0, 1), cB + hstepB, voffB); PG8_STAGE(PG8_SA(0, 1), cA + hstep, voffA);
        if (wr == 1) PG8_BAR;
        PG8_WAIT_V(4); PG8_BAR;
        PG8_STAGE(PG8_SB(1, 0), cB + kstep, voffB); PG8_STAGE(PG8_SA(1, 0), cA + kstep, voffA); PG8_STAGE(PG8_SB(1, 1), cB + hstepB + kstep, voffB);
        PG8_WAIT_V(6); PG8_BAR;
    }
    if constexpr (SP2) {
        const unsigned* dmb = g.dummy + ((size_t)blockIdx.x * 8 + wid) * 64;
        const unsigned dmo = (unsigned)lane * 4u;
#pragma unroll
        for (int i = 0; i < Epi::NST; ++i) asm volatile("global_store_dword %0, %0, %1\n\ts_nop 0" :: "v"(dmo), "s"(dmb) : "memory");
    }
    for (;;) {
        constexpr int KD_ = (PROBE_KDUP == 1 || (PROBE_KDUP > 1 && Epi::NST == PROBE_KDUP)) ? 1 : 0;
        const bool has_next = S.next((ui + 1) >> KD_, nxt);
        const char* nA = has_next ? (const char*)g.A + (size_t)nxt.pm * tstep : cA; const char* nB = has_next ? (const char*)g.Bt + (size_t)nxt.pn * tstep : cB;
        if constexpr (SP2) {
            { const char* a1 = cA + kstep; const char* a2 = cA + 2 * kstep; const char* b2 = cB + 2 * kstep; const char* a3 = a2 + kstep; const char* b3 = b2 + kstep;
              PG8_SP2_BODY(PG8_WAIT_VX(8 + Epi::NST)); }
            for (int t = 2; t < nt; t += 2) {
                const bool last = (t == nt - 2);
                const char* a1 = cA + (size_t)(t + 1) * kstep;
                const char* a2 = last ? nA : cA + (size_t)(t + 2) * kstep; const char* b2 = last ? nB : cB + (size_t)(t + 2) * kstep;
                const char* a3 = a2 + kstep; const char* b3 = b2 + kstep;
                if (last && has_next) S.a_ready(nxt);
                PG8_SP2_BODY(PG8_WAIT_V(8));
            }
        } else {
        for (int t = 0; t < nt; t += 2) {
            const bool last = (t == nt - 2);
            const char* a1 = cA + (size_t)(t + 1) * kstep;
            const char* a2 = last ? nA : cA + (size_t)(t + 2) * kstep; const char* b2 = last ? nB : cB + (size_t)(t + 2) * kstep;
            const char* a3 = a2 + kstep; const char* b3 = b2 + kstep;
            if (last && has_next) S.a_ready(nxt);
            PG8_LDB(B0, 0, 0); PG8_SCHED; PG8_LDA(At, 0, 0); PG8_STAGE(PG8_SA(1, 1), a1 + hstep, voffA);
            PG8_WAIT_L(8); PG8_BAR; PG8_WAIT_L(0); PG8_MMA(0, 0, At, B0); PG8_BAR; PG8_SCHED;
            PG8_LDB(B1, 0, 1); PG8_STAGE(PG8_SB(0, 0), b2, voffB);
            PG8_BAR; PG8_WAIT_L(0); PG8_MMA(0, 1, At, B1); PG8_BAR;
            PG8_LDA(At, 0, 1); PG8_STAGE(PG8_SA(0, 0), a2, voffA);
            PG8_BAR; PG8_WAIT_L(0); PG8_MMA(1, 0, At, B0); PG8_BAR; PG8_SCHED;
            PG8_STAGE(PG8_SB(0, 1), b2 + hstepB, voffB);
            PG8_WAIT_V(6); PG8_BAR; PG8_MMA(1, 1, At, B1); PG8_BAR;
            PG8_LDB(B0, 1, 0); PG8_SCHED; PG8_LDA(At, 1, 0); PG8_STAGE(PG8_SA(0, 1), a2 + hstep, voffA);
            PG8_WAIT_L(8); PG8_BAR; PG8_WAIT_L(0); PG8_MMA(0, 0, At, B0); PG8_BAR; PG8_SCHED;
            PG8_LDB(B1, 1, 1); PG8_STAGE(PG8_SB(1, 0), b3, voffB);
            PG8_BAR; PG8_WAIT_L(0); PG8_MMA(0, 1, At, B1); PG8_BAR;
            PG8_LDA(At, 1, 1); PG8_STAGE(PG8_SA(1, 0), a3, voffA);
            PG8_BAR; PG8_WAIT_L(0); PG8_MMA(1, 0, At, B0); PG8_BAR; PG8_SCHED;
            PG8_STAGE(PG8_SB(1, 1), b3 + hstepB, voffB);
            PG8_WAIT_V(6); PG8_BAR; PG8_MMA(1, 1, At, B1); PG8_BAR;
        }
        }
        if constexpr (ALIGN_EPI) { if (wr == 0) PG8_BAR; }
        if (KD_ && !(ui & 1)) {
            const unsigned* dmb = g.dummy + ((size_t)blockIdx.x * 8 + wid) * 64; unsigned dmo = (unsigned)__builtin_amdgcn_mbcnt_hi(~0u, __builtin_amdgcn_mbcnt_lo(~0u, 0u)) * 4u;
#pragma unroll
            for (int i = 0; i < Epi::NST; ++i) asm volatile("global_store_dword %0, %0, %1\n\ts_nop 0" :: "v"(dmo), "s"(dmb) : "memory");
        } else
        if constexpr (!Epi::AFTER_DRAIN) { int le = (int)__builtin_amdgcn_mbcnt_hi(~0u, __builtin_amdgcn_mbcnt_lo(~0u, 0u)); asm volatile("" : "+v"(le));
            E(acc, cur, wr, wc, le & 15, le >> 4); if constexpr (Epi::REPS > 1) { asm volatile("" ::: "memory"); E(acc, cur, wr, wc, le & 15, le >> 4); } S.done(cur); }
        if (!has_next) break;
#pragma unroll
        for (int a = 0; a < 2; ++a)
#pragma unroll
            for (int b = 0; b < 2; ++b)
#pragma unroll
                for (int m = 0; m < 4; ++m)
#pragma unroll
                    for (int n = 0; n < 2; ++n) acc[a][b][m][n] = (f32x4){0.f, 0.f, 0.f, 0.f};
        cur = nxt; cA = nA; cB = nB; ++ui;
        if constexpr (ALIGN_EPI) { if (wr == 1) PG8_BAR; }
    }
    PG8_WAIT_V(0);
    if constexpr (!ALIGN_EPI) { if (wr == 0) PG8_BAR; }
    PG8_BAR;
    if constexpr (Epi::AFTER_DRAIN) { E.fused(acc, cur, wr, wc, fr, fq, lds, wid, lane); S.done(cur); }
#undef PG8_SA
#undef PG8_SB
#undef PG8_SBR
#undef PG8_STAGE
#undef PG8_LDA
#undef PG8_LDB
#undef PG8_MMA
#undef PG8_WAIT_V
#undef PG8_WAIT_VX
#undef PG8_SP2_BODY
#undef PG8_WAIT_L
#undef PG8_BAR
#undef PG8_SCHED
}
}

constexpr int NWAVES = 8;
constexpr int RING_OFF = 0, RING_BYTES = 155648;
constexpr int LDSCTL_OFF = RING_BYTES, MISC_OFF = LDSCTL_OFF + 320;
constexpr int LDS_BYTES = 163840;
#define GAS __attribute__((address_space(1)))
#define LAS __attribute__((address_space(3)))
typedef unsigned v4u __attribute__((ext_vector_type(4)));
typedef float f32x4 __attribute__((ext_vector_type(4)));
typedef short bf16x8 __attribute__((ext_vector_type(8)));
typedef GAS unsigned gu32;
#define RLX_AGENT __ATOMIC_RELAXED, __HIP_MEMORY_SCOPE_AGENT
constexpr int CW_TMO = 0, CW_CODE = 1, CW_BAR = 4096;

__device__ __forceinline__ int lane_id() { return (int)__builtin_amdgcn_mbcnt_hi(~0u, __builtin_amdgcn_mbcnt_lo(~0u, 0u)); }
struct Args { const float* in[22]; float* out; unsigned char* ws; int ph_lo, ph_hi; };
struct Frame {
    LAS unsigned char* lds; volatile LAS unsigned* MISC; gu32* ctl;
    int wave, vcu, G;
};
#define XB_TMO      128
#define XB_XCNT(j)  (256  + 64 * (j))
#define XB_XSUB(j)  (1280 + 64 * (j))
#define XB_XGEN(j)  (2304 + 64 * (j))
#define XB_TOP      3328
#define XB_TOPGEN   3392
#define XCD_BAR_WORDS 3456
#define XB_SPIN_CAP (1u << 18)

__device__ __forceinline__ unsigned xb_ld(unsigned* p)              { return __hip_atomic_load(p, __ATOMIC_RELAXED, __HIP_MEMORY_SCOPE_AGENT); }
__device__ __forceinline__ unsigned xb_add(unsigned* p, unsigned v) { return __hip_atomic_fetch_add(p, v, __ATOMIC_RELAXED, __HIP_MEMORY_SCOPE_AGENT); }
__device__ __forceinline__ unsigned xb_xcc_id() { return (unsigned)__builtin_amdgcn_s_getreg((3 << 11) | 20) & 0xFu; }
#define XB_SPIN(cond, bar) do { unsigned _sp = 0; while (cond) { __builtin_amdgcn_s_sleep(1); \
    if ((++_sp & 255u) == 0u) { if (xb_ld(&(bar)[XB_TMO])) break; if (_sp > XB_SPIN_CAP) { atomicAdd(&(bar)[XB_TMO], 1u); break; } } } } while (0)

struct XcdBarrier {
    unsigned* bar; unsigned x; int wave;
    volatile LAS unsigned* st;
};

__device__ __forceinline__ XcdBarrier xcd_barrier_post(unsigned* bar, volatile LAS unsigned* st) {
    XcdBarrier b; b.bar = bar; b.x = xb_xcc_id(); b.st = st;
    if (threadIdx.x == 0) (void)xb_add(&bar[XB_XCNT(b.x)], 1u);
    return b;
}
__device__ __forceinline__ void xcd_barrier_complete(unsigned* bar, unsigned x, unsigned& nloc, unsigned& nx) {
    const unsigned G = gridDim.x * gridDim.y * gridDim.z;
    unsigned sum, cnt, mine, sp = 0u;
    for (;;) {
        sum = 0u; cnt = 0u; mine = 0u;
#pragma unroll
        for (unsigned j = 0; j < 16; ++j) { const unsigned c = xb_ld(&bar[XB_XCNT(j)]); sum += c; cnt += (c > 0u) ? 1u : 0u; mine = (j == x) ? c : mine; }
        if (sum == G) break;
        __builtin_amdgcn_s_sleep(1);
        if ((++sp & 255u) == 0u) { if (xb_ld(&bar[XB_TMO])) break; if (sp > XB_SPIN_CAP) { atomicAdd(&bar[XB_TMO], 1u); break; } }
    }
    nloc = mine > 0u ? mine : 1u; nx = cnt > 0u ? cnt : 1u;
}

__device__ __forceinline__ void xcd_barrier(const XcdBarrier& b) {
    asm volatile("s_waitcnt vmcnt(0)" ::: "memory");
    __syncthreads();
    if (b.wave == 0 && lane_id() == 0) {
        unsigned* bar = b.bar;
        __builtin_amdgcn_s_waitcnt(0);
        __builtin_amdgcn_fence(__ATOMIC_ACQUIRE, "agent");
        unsigned nloc = b.st[0], nx = b.st[1];
        if (nloc == 0u) { xcd_barrier_complete(bar, b.x, nloc, nx); b.st[0] = nloc; b.st[1] = nx; }
        const unsigned old = xb_add(&bar[XB_XSUB(b.x)], 1u);
        const unsigned gen = old / nloc;
        if (old + 1u == (gen + 1u) * nloc) {
            __builtin_amdgcn_fence(__ATOMIC_RELEASE, "agent");
            asm volatile("s_waitcnt vmcnt(0)" ::: "memory");
            const unsigned og = xb_add(&bar[XB_TOP], 1u);
            const unsigned tg = og / nx;
            if (og + 1u == (tg + 1u) * nx) xb_add(&bar[XB_TOPGEN], 1u);
            else XB_SPIN(xb_ld(&bar[XB_TOPGEN]) == tg, bar);
            xb_add(&bar[XB_XGEN(b.x)], 1u);
            asm volatile("s_waitcnt vmcnt(0)" ::: "memory");
        } else {
            XB_SPIN(xb_ld(&bar[XB_XGEN(b.x)]) == gen, bar);
            asm volatile("s_waitcnt vmcnt(0)" ::: "memory");
        }
    }
    __syncthreads();
}

__device__ __forceinline__ float fsigmoid(float x) { return __builtin_amdgcn_rcpf(1.f + __builtin_amdgcn_exp2f(-1.4426950408889634f * x)); }
__device__ __forceinline__ float fsilu(float x) { return x * fsigmoid(x); }
typedef float cvt_f32x2 __attribute__((ext_vector_type(2))); typedef __bf16 cvt_bf16x2 __attribute__((ext_vector_type(2)));
__device__ __forceinline__ unsigned cvtpk(float lo, float hi) { const cvt_f32x2 v = {lo, hi}; const cvt_bf16x2 b = __builtin_convertvector(v, cvt_bf16x2); return __builtin_bit_cast(unsigned, b); }
__device__ __forceinline__ float bflo(unsigned u) { return __builtin_bit_cast(float, u << 16); }
__device__ __forceinline__ float bfhi(unsigned u) { return __builtin_bit_cast(float, u & 0xffff0000u); }


#define LDS_WAIT() asm volatile("s_waitcnt lgkmcnt(0)" ::: "memory")
__device__ __forceinline__ unsigned pk2(float lo, float hi) { return f2bf(lo) | (f2bf(hi) << 16); }
__device__ __forceinline__ void p0_transpose_item(const float* W, int K, int N, bf16* WT, const float* scale, LAS float* scr, int item, int lane, float cs = 1.f, bool ugmap = false) {
    const int nblk = N / 32, kb = item / nblk, nb = item % nblk, k0 = 64 * kb, n0 = 32 * nb;
    const int n0o = !ugmap ? n0 : (n0 < 2048 ? (n0 >> 7) * 256 + (n0 & 127) : (n0 < 4096 ? n0 + 2048 : ((n0 - 4096) >> 7) * 256 + 128 + ((n0 - 4096) & 127)));
    const int lr = lane >> 3, lc = 4 * (lane & 7);
    f32x4 v[8];
#pragma unroll
    for (int i = 0; i < 8; ++i) v[i] = __builtin_nontemporal_load((const GAS f32x4*)(W + (size_t)(k0 + lr + 8 * i) * N + n0 + lc));
#pragma unroll
    for (int i = 0; i < 8; ++i) { const int kk = lr + 8 * i; const float sc = scale ? scale[k0 + kk] : cs; LAS float* d = scr + kk * 33 + lc;
        d[0] = v[i].x * sc; d[1] = v[i].y * sc; d[2] = v[i].z * sc; d[3] = v[i].w * sc; }
    LDS_WAIT(); asm volatile("" ::: "memory");
    const int c = lane & 7;
#pragma unroll
    for (int j = 0; j < 4; ++j) { const int n = (lane >> 3) + 8 * j; const LAS float* s = scr + (8 * c) * 33 + n;
        v4u o; o.x = pk2(s[0 * 33], s[1 * 33]); o.y = pk2(s[2 * 33], s[3 * 33]); o.z = pk2(s[4 * 33], s[5 * 33]); o.w = pk2(s[6 * 33], s[7 * 33]);
        *(GAS v4u*)(WT + (size_t)(n0o + n) * K + k0 + 8 * c) = o; }
    LDS_WAIT(); asm volatile("" ::: "memory");
}
template <int NR> __device__ __forceinline__ void rms_rows_load(const float* xrow, f32x4 (&v)[NR][4], int lane) {
#pragma unroll
    for (int r = 0; r < NR; ++r) { const GAS f32x4* xr = (const GAS f32x4*)(xrow + (size_t)r * D) + lane;
#pragma unroll
        for (int j = 0; j < 4; ++j) v[r][j] = __builtin_nontemporal_load(xr + 64 * j); }
}
template <int NR> __device__ __forceinline__ void rms_rows_finish(const f32x4 (&v)[NR][4], float* rms_out, bf16* orow, int lane) {
    float s[NR];
#pragma unroll
    for (int r = 0; r < NR; ++r) { s[r] = 0.f;
#pragma unroll
        for (int j = 0; j < 4; ++j) s[r] += (v[r][j].x * v[r][j].x + v[r][j].y * v[r][j].y) + (v[r][j].z * v[r][j].z + v[r][j].w * v[r][j].w); }
#pragma unroll
    for (int o = 1; o < 64; o <<= 1) {
#pragma unroll
        for (int r = 0; r < NR; ++r) s[r] += __shfl_xor(s[r], o); }
#pragma unroll
    for (int r = 0; r < NR; ++r) { const float ms = s[r] * (1.f / D) + EPS, rstd = rsqrtf(ms); if (lane == 0) rms_out[r] = ms * rstd;
        GAS unsigned long long* o8 = (GAS unsigned long long*)(orow + (size_t)r * D) + lane;
#pragma unroll
        for (int j = 0; j < 4; ++j) o8[64 * j] = (unsigned long long)pk2(v[r][j].x * rstd, v[r][j].y * rstd) | ((unsigned long long)pk2(v[r][j].z * rstd, v[r][j].w * rstd) << 32); }
}
constexpr int I_A = (D / 64) * (NA / 32), I_OA = (GW / 64) * (D / 32), I_C = (D / 64) * (NC / 32), I_OC = I_OA, I_G = 16 * 8;
__device__ __forceinline__ void p0_prologue(const Frame& F, const Args& args, unsigned char* ws) {
    int tid_ = F.wave * 64 + lane_id(); asm volatile("" : "+v"(tid_)); const int lane_ = tid_ & 63;
    LAS float* scr = (LAS float*)(F.lds + RING_OFF + F.wave * 16384);
    const int gw = F.vcu * NWAVES + F.wave, NGW = F.G * NWAVES;
    bf16* WaT = (bf16*)(ws + WS_WAT);
    bf16* h0 = (bf16*)args.out; float* rms0 = (float*)(ws + WS_RMS0);
    { const float* x = args.in[0]; const int step = NGW * 4;
      f32x4 va[4][4], vb[4][4], vc[4][4]; int m = gw * 4;
      if (m < M) rms_rows_load<4>(x + (size_t)m * D, va, lane_);
      if (m + step < M) rms_rows_load<4>(x + (size_t)(m + step) * D, vb, lane_);
      for (int it = gw; it < I_A; it += NGW) p0_transpose_item(args.in[2], D, NA, WaT, args.in[1], scr, it, lane_);
      while (m < M) {
          if (m + 2 * step < M) rms_rows_load<4>(x + (size_t)(m + 2 * step) * D, vc, lane_);
          rms_rows_finish<4>(va, rms0 + m, h0 + (size_t)m * D, lane_); m += step; if (m >= M) break;
          if (m + 2 * step < M) rms_rows_load<4>(x + (size_t)(m + 2 * step) * D, va, lane_);
          rms_rows_finish<4>(vb, rms0 + m, h0 + (size_t)m * D, lane_); m += step; if (m >= M) break;
          if (m + 2 * step < M) rms_rows_load<4>(x + (size_t)(m + 2 * step) * D, vb, lane_);
          rms_rows_finish<4>(vc, rms0 + m, h0 + (size_t)m * D, lane_); m += step; } }
}
__device__ __forceinline__ void p0_layer1_weights(const Frame& F, const Args& args, unsigned char* ws, int icu, int ncu) {
    int tid_ = F.wave * 64 + lane_id(); asm volatile("" : "+v"(tid_)); const int lane_ = tid_ & 63;
    LAS float* scr = (LAS float*)(F.lds + RING_OFF + F.wave * 16384);
    const int gw = icu * NWAVES + F.wave, NGW = ncu * NWAVES;
    bf16* WoaT = (bf16*)(ws + WS_WOAT); bf16* WG = (bf16*)(ws + WS_WG); bf16* WcT = (bf16*)(ws + WS_WCT); bf16* WocT = (bf16*)(ws + WS_WOCT);
    for (int it = gw; it < I_OA + I_G + I_C + I_OC; it += NGW) {
        int r = it;
        if (r < I_OA) { p0_transpose_item(args.in[13], GW, D, WoaT, nullptr, scr, r, lane_); continue; } r -= I_OA;
        if (r < I_G) { const int mat = r >> 3, sub = r & 7, n = mat >> 1, gate = mat & 1;
            p0_transpose_item((gate ? args.in[7] : args.in[5]) + (size_t)n * 16384, 128, 128, WG + (size_t)mat * 16384, nullptr, scr, sub, lane_, -1.4426950408889634f); continue; } r -= I_G;
        if (r < I_C) { p0_transpose_item(args.in[16], D, NC, WcT, args.in[15], scr, r, lane_, 1.f, true); continue; } r -= I_C;
        p0_transpose_item(args.in[21], GW, D, WocT, nullptr, scr, r, lane_);
    }
    { float* btab = (float*)(ws + WS_BIAS);
      for (int gt = icu * (NWAVES * 64) + tid_; gt < 16 * 128; gt += ncu * NWAVES * 64) { const int d = gt & 127, h = gt >> 7; int bk;
          if (d < 16) bk = d; else { bk = 16 + (int)(logf((float)d / 16.f) / logf(8.f) * 16.f); if (bk > 31) bk = 31; }
          btab[gt] = args.in[14][bk * 16 + h]; } }
    { bf16* WS = (bf16*)(ws + WS_WS);
      for (int gt = icu * (NWAVES * 64) + tid_; gt < 8 * 128 * 16; gt += ncu * NWAVES * 64) { const int s8 = gt & 15, t = (gt >> 4) & 127; const float* src = args.in[19] + (size_t)gt * 8;
          const f32x4 a = *(const f32x4*)src, b = *(const f32x4*)(src + 4); const float wv[8] = {a.x, a.y, a.z, a.w, b.x, b.y, b.z, b.w}; float o[8];
#pragma unroll
          for (int e = 0; e < 8; ++e) o[e] = (8 * s8 + e <= t) ? wv[e] : 0.f;
          v4u pk; pk.x = pk2(o[0], o[1]); pk.y = pk2(o[2], o[3]); pk.z = pk2(o[4], o[5]); pk.w = pk2(o[6], o[7]);
          *(GAS v4u*)(WS + (size_t)gt * 8) = pk; } }
}

typedef float f32x16 __attribute__((ext_vector_type(16)));
constexpr int P5_VSTRIDE = 272;
constexpr int P5_VT = 0, P5_W0 = 256 * P5_VSTRIDE, P5_ST = P5_W0 + 128 * P5_VSTRIDE, P5_GB = P5_ST + (384 + 1024) * 4;
static_assert(P5_GB + 4096 * 4 <= RING_BYTES, "P5 LDS map");
__device__ __forceinline__ void p5_gate(const Frame& F, const Args& args, unsigned char* ws) {
    LAS unsigned char* L = F.lds + RING_OFF;
    LAS float* mu = (LAS float*)(L + P5_ST); LAS float* rs = mu + 128; LAS float* rx = mu + 256; LAS float* bb = mu + 384;
    bf16* U = (bf16*)(ws + WS_U); const bf16* V = (const bf16*)(ws + WS_V); const float* vst = (const float*)(ws + WS_VST);
    const bf16* WS = (const bf16*)(ws + WS_WS);
    const float* lg = args.in[17]; const float* lb = args.in[18]; const float* sb = args.in[20]; const float* ssq = (const float*)(ws + WS_SSQ);
    const int w = F.wave;
    const int NCH = M / 128, nitem = 2 * NCH;
    const int nmine = (nitem - F.vcu + F.G - 1) / F.G;
    for (int idx = 0; idx < nmine; ++idx) {
        const int it = F.vcu + ((2 * F.vcu >= F.G) ? (nmine - 1 - idx) : idx) * F.G;
        const int ch = (it < NCH) ? (NCH - 1 - it) : (it - NCH);
        const int g0 = (it < NCH) ? ((ch >= NCH / 2) ? 0 : 4) : ((ch >= NCH / 2) ? 4 : 0), g1 = g0 + 4;
        const int r0 = ch * 128;
        int tid = F.wave * 64 + lane_id(); asm volatile("" : "+v"(tid));
        const int lane0 = tid & 63, spl0 = lane0 & 15, cgl0 = lane0 >> 4;
        v4u vreg[4][2], wreg[4];
        { const int spl = spl0, cgl = cgl0;
#define P5_LOAD(g_) do { \
        const char* vb_ = (const char*)(V + (size_t)r0 * GW + (g_) * 256); const char* wb_ = (const char*)(WS + (size_t)(g_) * 16384); \
        _Pragma("unroll") for (int i = 0; i < 4; ++i) { const unsigned vo_ = (unsigned)((2 * (16 * i + spl)) * GW + 32 * w + 8 * cgl) * 2u; vreg[i][0] = __builtin_nontemporal_load((const v4u*)(vb_ + vo_)); vreg[i][1] = __builtin_nontemporal_load((const v4u*)(vb_ + vo_ + GW * 2)); }     \
        _Pragma("unroll") for (int i = 0; i < 4; ++i) wreg[i] = *(const v4u*)(wb_ + (unsigned)(tid + 512 * i) * 16u); \
        } while (0)
        P5_LOAD(g0); }
        __syncthreads();
        { const int row = tid >> 2, part = tid & 3;
          const f32x4* p = (const f32x4*)(vst + ((size_t)(r0 + row) * 32 + part * 8) * 2);
          const f32x4 a = p[0], b = p[1], c = p[2], d = p[3];
          float s1 = ((a.x + a.z) + (b.x + b.z)) + ((c.x + c.z) + (d.x + d.z));
          float s2 = ((a.y + a.w) + (b.y + b.w)) + ((c.y + c.w) + (d.y + d.w));
          s1 += __shfl_xor(s1, 1); s1 += __shfl_xor(s1, 2); s2 += __shfl_xor(s2, 1); s2 += __shfl_xor(s2, 2);
          const f32x4 sq = *(const f32x4*)(ssq + (size_t)(r0 + row) * 16 + 4 * part); float sx = (sq.x + sq.y) + (sq.z + sq.w); sx += __shfl_xor(sx, 1); sx += __shfl_xor(sx, 2);
          const float rxx = rsqrtf(sx * (1.f / D) + EPS);
          const float mean = s1 * (1.f / GW), var = fmaxf(s2 * (1.f / GW) - mean * mean, 0.f);
          if (part == 0) { mu[row] = mean; rs[row] = rxx * rsqrtf(rxx * rxx * var + EPS); rx[row] = rxx; }
          bb[tid] = sb[tid]; bb[tid + 512] = sb[tid + 512];
          LAS f32x4* gbt = (LAS f32x4*)(L + P5_GB); gbt[tid] = *(const f32x4*)(lg + 4 * tid); gbt[512 + tid] = *(const f32x4*)(lb + 4 * tid); }
        __syncthreads();
        v4u ug[4][2];
        { const int lane = lane0, l31 = lane & 31, hi = lane >> 5; const char* ub0 = (const char*)(U + (size_t)r0 * GW);
#pragma unroll
          for (int j = 0; j < 4; ++j) { const unsigned off = (unsigned)((32 * j + l31) * GW + g0 * 256 + 32 * w + 16 * hi) * 2u;
              ug[j][0] = *(const v4u*)(ub0 + off); ug[j][1] = *(const v4u*)(ub0 + off + 16); } }
#pragma unroll 1
        for (int g = g0; g < g1; ++g) {
            int tg = tid; asm volatile("" : "+v"(tg));
            const int lane = tg & 63, l31 = lane & 31, hi = lane >> 5, cgl = lane >> 4, spl = lane & 15;
            { const LAS f32x4* gp = (const LAS f32x4*)(L + P5_GB) + (g * 256 + 32 * w + 8 * cgl) / 4; const f32x4 ga0 = gp[0], ga1 = gp[1], be0 = gp[512], be1 = gp[513];
              const float gam[8] = {ga0.x, ga0.y, ga0.z, ga0.w, ga1.x, ga1.y, ga1.z, ga1.w}, bet[8] = {be0.x, be0.y, be0.z, be0.w, be1.x, be1.y, be1.z, be1.w};
#pragma unroll
              for (int i = 0; i < 4; ++i) { const int sp = 16 * i + spl; const float m0 = mu[2 * sp], m1 = mu[2 * sp + 1], q0 = rs[2 * sp], q1 = rs[2 * sp + 1];
                  const unsigned a0[4] = {vreg[i][0].x, vreg[i][0].y, vreg[i][0].z, vreg[i][0].w}, a1[4] = {vreg[i][1].x, vreg[i][1].y, vreg[i][1].z, vreg[i][1].w};
#pragma unroll
                  for (int e = 0; e < 8; ++e) { const float x0 = (e & 1) ? bfhi(a0[e >> 1]) : bflo(a0[e >> 1]), x1 = (e & 1) ? bfhi(a1[e >> 1]) : bflo(a1[e >> 1]);
                      const float n0 = (x0 - m0) * q0 * gam[e] + bet[e], n1 = (x1 - m1) * q1 * gam[e] + bet[e];
                      *(LAS unsigned*)(L + P5_VT + (32 * w + 8 * cgl + e) * P5_VSTRIDE + sp * 4) = cvtpk(n0, n1); } } }
            __syncthreads();
            { LAS unsigned char* wb = L + P5_W0;
#pragma unroll
              for (int i = 0; i < 4; ++i) { const int idx = tid + 512 * i; *(LAS v4u*)(wb + (idx >> 4) * P5_VSTRIDE + (idx & 15) * 16) = wreg[i]; } }
            if (g + 1 < g1) P5_LOAD(g + 1);
            char* ub = (char*)(U + (size_t)r0 * GW + g * 256);
            __syncthreads();
            const int prow = 16 * ((l31 >> 2) & 1) + 4 * (l31 >> 3) + (l31 & 3);
            const LAS unsigned char* ap = L + P5_VT + (32 * w + prow) * P5_VSTRIDE + hi * 16;
            const LAS unsigned char* bp = L + P5_W0 + l31 * P5_VSTRIDE + hi * 16;
#pragma unroll
            for (int jp = 0; jp < 2; ++jp) {
                f32x16 acc[2];
#pragma unroll
                for (int jj = 0; jj < 2; ++jj) { const int j = 2 * jp + jj; f32x16 a = {0.f, 0.f, 0.f, 0.f, 0.f, 0.f, 0.f, 0.f, 0.f, 0.f, 0.f, 0.f, 0.f, 0.f, 0.f, 0.f};
#pragma unroll
                    for (int ks = 0; ks < 2 * j + 2; ++ks) { const bf16x8 af = *(const LAS bf16x8*)(ap + ks * 32), bfr_ = *(const LAS bf16x8*)(bp + j * 32 * P5_VSTRIDE + ks * 32);
                        a = __builtin_amdgcn_mfma_f32_32x32x16_bf16(af, bfr_, a, 0, 0, 0); }
                    acc[jj] = a; }
#pragma unroll
                for (int jj = 0; jj < 2; ++jj) { const int j = 2 * jp + jj; const int t = 32 * j + l31; const float b0 = bb[g * 128 + t];
                    const unsigned off = (unsigned)(t * GW + 32 * w + 16 * hi) * 2u;
                    const unsigned uu[8] = {ug[j][0].x, ug[j][0].y, ug[j][0].z, ug[j][0].w, ug[j][1].x, ug[j][1].y, ug[j][1].z, ug[j][1].w};
                    unsigned o[8];
#pragma unroll
                    for (int q = 0; q < 8; ++q) { const float y0_ = bflo(uu[q]) * (acc[jj][2 * q] + b0), y1_ = bfhi(uu[q]) * (acc[jj][2 * q + 1] + b0); o[q] = cvtpk(y0_, y1_); }
                    v4u o0, o1; o0.x = o[0]; o0.y = o[1]; o0.z = o[2]; o0.w = o[3]; o1.x = o[4]; o1.y = o[5]; o1.z = o[6]; o1.w = o[7];
                    *(v4u*)(ub + off) = o0; *(v4u*)(ub + off + 16) = o1;
                    if (g + 1 < g1) { ug[j][0] = *(const v4u*)(ub + 512 + off); ug[j][1] = *(const v4u*)(ub + 512 + off + 16); } } }
        }
#undef P5_LOAD
    }
}

constexpr int LR_XA = 0;
constexpr int LR_XF = 32768, LR_XFS = 68;
constexpr int LR_GA = LR_XF + 128 * LR_XFS * 4;
constexpr int LR_GAS = 144;
constexpr int LR_Y = LR_GA + 128 * LR_GAS;
constexpr int LR_TOT = LR_Y + 128 * LR_GAS;
static_assert(LR_TOT + 8 * 16 * 2 * 4 <= RING_BYTES, "LRU LDS map");
__device__ __forceinline__ void p2_lru(const Frame& F, const Args& args, unsigned char* ws) {
    LAS unsigned char* L = F.lds + RING_OFF;
    const bf16* z0 = (const bf16*)(ws + WS_Z0); bf16* y0 = (bf16*)(ws + WS_Y0); const bf16* WG = (const bf16*)(ws + WS_WG);
    const float* conv_w = args.in[3]; const float* conv_b = args.in[4]; const float* gab = args.in[6]; const float* gxb = args.in[8]; const float* lam = args.in[9];
    int tid = F.wave * 64 + lane_id(); asm volatile("" : "+v"(tid));
    const int lane = tid & 63, w = F.wave, q = lane >> 4, cc = lane & 15, th = w >> 2, ct = w & 3;
    for (int unit = F.vcu; unit < NB * 16; unit += F.G) {
        const int b = unit >> 4, n = (unit >> 1) & 7, hf = unit & 1;
        const size_t row0 = (size_t)b * S;
        bf16x8 bfrag[2][4];
#pragma unroll
        for (int g2 = 0; g2 < 2; ++g2)
#pragma unroll
            for (int ks = 0; ks < 4; ++ks) bfrag[g2][ks] = *(const bf16x8*)(WG + ((size_t)(n * 2 + g2) * 128 + 64 * hf + 16 * ct + cc) * 128 + 32 * ks + 8 * q);
        const int cg = tid & 15, tq = tid >> 4, chc = n * 128 + 8 * cg;
        float cw[4][8], cb[8];
#pragma unroll
        for (int k = 0; k < 4; ++k) { const f32x4 a = *(const f32x4*)(conv_w + k * 1024 + chc), c2 = *(const f32x4*)(conv_w + k * 1024 + chc + 4);
            cw[k][0] = a.x; cw[k][1] = a.y; cw[k][2] = a.z; cw[k][3] = a.w; cw[k][4] = c2.x; cw[k][5] = c2.y; cw[k][6] = c2.z; cw[k][7] = c2.w; }
        { const f32x4 a = *(const f32x4*)(conv_b + chc), c2 = *(const f32x4*)(conv_b + chc + 4); cb[0] = a.x; cb[1] = a.y; cb[2] = a.z; cb[3] = a.w; cb[4] = c2.x; cb[5] = c2.y; cb[6] = c2.z; cb[7] = c2.w; }
        const int chl = n * 128 + 64 * hf + 16 * ct + cc;
        const float ba = -1.4426950408889634f * gab[chl], bx = -1.4426950408889634f * gxb[chl], sp = 8.f * 1.4426950408889634f * log1pf(expf(-lam[chl]));
        float hprev = 0.f;
        const int mt = tid >> 2, mp = tid & 3;
        v4u zr[7], gr[2];
#pragma unroll
        for (int i = 0; i < 7; ++i) { const int t = 4 * tq - 3 + i; zr[i] = (t >= 0) ? *(const v4u*)(z0 + (row0 + t) * NA + chc) : (v4u){0u, 0u, 0u, 0u}; }
#pragma unroll
        for (int i = 0; i < 2; ++i) gr[i] = *(const v4u*)(z0 + (row0 + mt) * NA + 1024 + n * 128 + 64 * hf + 8 * (mp + 4 * i));
        for (int chunk = 0; chunk < 16; ++chunk) {
            const int t0 = chunk * 128; const size_t rowb = row0 + t0;
            __syncthreads();
            { float zf[7][8];
#pragma unroll
              for (int i = 0; i < 7; ++i) { const unsigned u4[4] = {zr[i].x, zr[i].y, zr[i].z, zr[i].w};
#pragma unroll
                  for (int e = 0; e < 4; ++e) { zf[i][2 * e] = bflo(u4[e]); zf[i][2 * e + 1] = bfhi(u4[e]); } }
#pragma unroll
              for (int r = 0; r < 4; ++r) { const int tok = 4 * tq + r; float xa[8];
#pragma unroll
                  for (int e = 0; e < 8; ++e) xa[e] = cb[e] + cw[0][e] * zf[r][e] + cw[1][e] * zf[r + 1][e] + cw[2][e] * zf[r + 2][e] + cw[3][e] * zf[r + 3][e];
                  v4u pk; pk.x = cvtpk(xa[0], xa[1]); pk.y = cvtpk(xa[2], xa[3]); pk.z = cvtpk(xa[4], xa[5]); pk.w = cvtpk(xa[6], xa[7]);
                  *(LAS v4u*)(L + LR_XA + tok * 256 + ((cg ^ ((tok & 3) | ((tok >> 2) & 12))) << 4)) = pk;
                  if ((cg >> 3) == hf) { LAS float* xf = (LAS float*)(L + LR_XF) + tok * LR_XFS + 8 * (cg & 7);
                      *(LAS f32x4*)xf = (f32x4){xa[0], xa[1], xa[2], xa[3]}; *(LAS f32x4*)(xf + 4) = (f32x4){xa[4], xa[5], xa[6], xa[7]}; } } }
#pragma unroll
            for (int i = 0; i < 2; ++i) *(LAS v4u*)(L + LR_GA + mt * LR_GAS + 16 * (mp + 4 * i)) = gr[i];
            if (chunk < 15) {
#pragma unroll
                for (int i = 0; i < 7; ++i) zr[i] = *(const v4u*)(z0 + (rowb + 128 + 4 * tq - 3 + i) * NA + chc);
#pragma unroll
                for (int i = 0; i < 2; ++i) gr[i] = *(const v4u*)(z0 + (rowb + 128 + mt) * NA + 1024 + n * 128 + 64 * hf + 8 * (mp + 4 * i));
            }
            __syncthreads();
            f32x4 acc[2][4];
#define LR_GATES(tt) do { acc[0][tt] = (f32x4){0.f, 0.f, 0.f, 0.f}; acc[1][tt] = (f32x4){0.f, 0.f, 0.f, 0.f}; \
                const int tokg = 64 * th + 16 * (cc >> 2) + 4 * (tt) + (cc & 3);     \
                _Pragma("unroll") for (int ks = 0; ks < 4; ++ks) { const int ck = 4 * ks + q; \
                    const bf16x8 af = *(const LAS bf16x8*)(L + LR_XA + tokg * 256 + ((ck ^ ((tokg & 3) | ((tokg >> 2) & 12))) << 4)); \
                    acc[0][tt] = __builtin_amdgcn_mfma_f32_16x16x32_bf16(af, bfrag[0][ks], acc[0][tt], 0, 0, 0); \
                    acc[1][tt] = __builtin_amdgcn_mfma_f32_16x16x32_bf16(af, bfrag[1][ks], acc[1][tt], 0, 0, 0); } } while (0)
            float Ai[4][4], Hi[4][4];
            float ap = 1.f, hp = 0.f;
            LR_GATES(0);
#pragma unroll
            for (int tt = 0; tt < 4; ++tt) {
                if (tt == 0) LR_GATES(1); else if (tt == 1) LR_GATES(2); else if (tt == 2) LR_GATES(3);
#pragma unroll
                for (int r = 0; r < 4; r += 2) { const int tok = 64 * th + 16 * q + 4 * tt + r;
                    typedef float f32p __attribute__((ext_vector_type(2)));
                    const f32p xr = (f32p){acc[0][tt][r], acc[0][tt][r + 1]} + (f32p){ba, ba}, xi = (f32p){acc[1][tt][r], acc[1][tt][r + 1]} + (f32p){bx, bx};
                    const f32p dr = (f32p){__builtin_amdgcn_exp2f(xr.x), __builtin_amdgcn_exp2f(xr.y)} + (f32p){1.f, 1.f}, di = (f32p){__builtin_amdgcn_exp2f(xi.x), __builtin_amdgcn_exp2f(xi.y)} + (f32p){1.f, 1.f};
                    const f32p rg = (f32p){__builtin_amdgcn_rcpf(dr.x), __builtin_amdgcn_rcpf(dr.y)}, ig = (f32p){__builtin_amdgcn_rcpf(di.x), __builtin_amdgcn_rcpf(di.y)};
                    const f32p la = rg * (f32p){-sp, -sp};
                    const f32p a = (f32p){__builtin_amdgcn_exp2f(la.x), __builtin_amdgcn_exp2f(la.y)};
                    const f32p om = (f32p){1.f, 1.f} - a * a;
                    const f32p xav = (f32p){((const LAS float*)(L + LR_XF))[tok * LR_XFS + 16 * ct + cc], ((const LAS float*)(L + LR_XF))[(tok + 1) * LR_XFS + 16 * ct + cc]};
                    const f32p bt = (f32p){__builtin_amdgcn_sqrtf(fmaxf(om.x, 0.f)), __builtin_amdgcn_sqrtf(fmaxf(om.y, 0.f))} * (ig * xav);
                    ap *= a.x; hp = a.x * hp + bt.x; Ai[tt][r] = ap; Hi[tt][r] = hp;
                    ap *= a.y; hp = a.y * hp + bt.y; Ai[tt][r + 1] = ap; Hi[tt][r + 1] = hp; }
                __builtin_amdgcn_sched_barrier(0); }
#undef LR_GATES
            float pa = 1.f, ph = 0.f, ra = 1.f, rh = 0.f;
#pragma unroll
            for (int qq = 0; qq < 4; ++qq) { const float ta = __shfl(ap, qq * 16 + cc), tb = __shfl(hp, qq * 16 + cc);
                if (qq < q) { ph = ta * ph + tb; pa = ta * pa; }
                rh = ta * rh + tb; ra = ta * ra; }
            if (q == 0) { LAS float* tp = (LAS float*)(L + LR_TOT) + (w * 16 + cc) * 2; tp[0] = ra; tp[1] = rh; }
            __syncthreads();
            { const LAS float* t0p = (const LAS float*)(L + LR_TOT) + (ct * 16 + cc) * 2; const LAS float* t1p = (const LAS float*)(L + LR_TOT) + ((4 + ct) * 16 + cc) * 2;
              const float a0 = t0p[0], h0_ = t0p[1], a1 = t1p[0], h1 = t1p[1];
              const float hmid = a0 * hprev + h0_;
              const float hin = th ? hmid : hprev;
              hprev = a1 * hmid + h1;
              const float hl = pa * hin + ph;
#pragma unroll
              for (int tt = 0; tt < 4; ++tt)
#pragma unroll
                  for (int r = 0; r < 4; ++r) { const int tok = 64 * th + 16 * q + 4 * tt + r; const float h = Ai[tt][r] * hl + Hi[tt][r];
                      const float gv = bf2f(*(const LAS unsigned short*)(L + LR_GA + tok * LR_GAS + (16 * ct + cc) * 2));
                      *(LAS unsigned short*)(L + LR_Y + tok * LR_GAS + (16 * ct + cc) * 2) = (unsigned short)cvtpk(h * gv, 0.f); } }
            __syncthreads();
#pragma unroll
            for (int i = 0; i < 2; ++i) *(v4u*)(y0 + (rowb + mt) * GW + n * 128 + 64 * hf + 8 * (mp + 4 * i)) = *(const LAS v4u*)(L + LR_Y + mt * LR_GAS + 16 * (mp + 4 * i));
        }
    }
}

constexpr int AT_KS = 0, AT_VT = 32768, AT_VSTRIDE = 520, AT_BL = AT_VT + 64 * AT_VSTRIDE, AT_QL = AT_BL + 9 * 192 * 4, AT_RS = 144, AT_WAVE = 2 * 32 * AT_RS;
constexpr int AT_QG = AT_QL + 8 * AT_WAVE, AT_SK = AT_QG + 256;
constexpr int AT_REF = AT_SK + 64;
static_assert(AT_REF + 16 <= RING_BYTES, "attention LDS map");
__device__ __forceinline__ void p2_attn(const Frame& F, const Args& args, unsigned char* ws) {
    LAS unsigned char* L = F.lds + RING_OFF;
    const bf16* z0 = (const bf16*)(ws + WS_Z0); bf16* y0 = (bf16*)(ws + WS_Y0); const float* btab = (const float*)(ws + WS_BIAS);
    const float* qg = args.in[10]; const float* kg = args.in[11]; const float* sinks = args.in[12];
    int tid = F.wave * 64 + lane_id(); asm volatile("" : "+v"(tid));
    const int lane = tid & 63, w = F.wave, l31 = lane & 31, hi = lane >> 5;
    const int qt = w & 3, cl = lane >> 4, jl = lane & 15;
    v4u pr[8];
#define AT_LOAD_KV(unit_) do { const int kh_ = (unit_) & 1, qb_ = ((unit_) >> 1) & 15, b_ = (unit_) >> 5; const long tk0_ = (long)qb_ * 128 - 128; \
        _Pragma("unroll") for (int i = 0; i < 4; ++i) { const int idx = tid + 512 * i, c = idx & 7, j = idx >> 3; const long tk = tk0_ + j; \
            pr[i] = (tk >= 0) ? *(const v4u*)(z0 + ((size_t)b_ * S + tk) * NA + 3072 + kh_ * 64 + 8 * c) : (v4u){0u, 0u, 0u, 0u}; } \
        _Pragma("unroll") for (int i = 0; i < 2; ++i) { const int jp = 16 * w + jl, c = 4 * i + cl; const long tk = tk0_ + 2 * jp; \
            if (tk >= 0) { const bf16* vp = z0 + ((size_t)b_ * S + tk) * NA + 3200 + kh_ * 64 + 8 * c; pr[4 + 2 * i] = *(const v4u*)vp; pr[5 + 2 * i] = *(const v4u*)(vp + NA); } \
            else { pr[4 + 2 * i] = (v4u){0u, 0u, 0u, 0u}; pr[5 + 2 * i] = (v4u){0u, 0u, 0u, 0u}; } } } while (0)
    if (F.vcu < NB * 32) AT_LOAD_KV(F.vcu);
    if (tid >= 64 && tid < 80) ((LAS float*)(L + AT_SK))[tid - 64] = sinks[tid - 64] * 1.4426950408889634f;
    if (w == 0) { float gq = fabsf(qg[lane]), gk = fabsf(kg[lane]);
#pragma unroll
        for (int off = 32; off >= 1; off >>= 1) { gq = fmaxf(gq, __shfl_xor(gq, off)); gk = fmaxf(gk, __shfl_xor(gk, off)); }
        if (lane == 0) *(LAS float*)(L + AT_REF) = fminf(8.f * 1.4426950408889634f * 1.01f * gq * gk, 60.f); }
    for (int unit = F.vcu; unit < NB * 16 * 2; unit += F.G) {
        const int kh = unit & 1, qb = (unit >> 1) & 15, b = unit >> 5;
        __syncthreads();
        const size_t R0 = (size_t)b * S + qb * 128 + 32 * qt;
        LAS unsigned char* QL = L + AT_QL + w * AT_WAVE; LAS unsigned char* GL = QL + 32 * AT_RS;
        const int mrr = lane >> 3, mch = lane & 7;
        v4u t0[8];
        { const bf16* qp = z0 + (R0 + mrr) * NA + 2048 + (kh * 8 + (w >> 2)) * 64 + 8 * mch;
#pragma unroll
          for (int i = 0; i < 4; ++i) { t0[i] = __builtin_nontemporal_load((const v4u*)(qp + (size_t)(8 * i) * NA)); t0[4 + i] = __builtin_nontemporal_load((const v4u*)(qp + (size_t)(8 * i) * NA + 1280)); } }
        __builtin_amdgcn_sched_barrier(0);
#pragma unroll
        for (int i = 0; i < 4; ++i) { const int idx = tid + 512 * i, c = idx & 7, j = idx >> 3; *(LAS v4u*)(L + AT_KS + c * 4096 + j * 16) = pr[i]; }
#pragma unroll
        for (int i = 0; i < 2; ++i) { const int jp = 16 * w + jl, c = 4 * i + cl;
            const unsigned a0[4] = {pr[4 + 2 * i].x, pr[4 + 2 * i].y, pr[4 + 2 * i].z, pr[4 + 2 * i].w}, a1[4] = {pr[5 + 2 * i].x, pr[5 + 2 * i].y, pr[5 + 2 * i].z, pr[5 + 2 * i].w};
#pragma unroll
            for (int e = 0; e < 8; ++e) { const unsigned lo = (e & 1) ? (a0[e >> 1] >> 16) : (a0[e >> 1] & 0xffffu), hi2 = (e & 1) ? (a1[e >> 1] & 0xffff0000u) : (a1[e >> 1] << 16);
                *(LAS unsigned*)(L + AT_VT + (8 * c + e) * AT_VSTRIDE + jp * 4) = lo | hi2; } }
        const float sref = *(const LAS float*)(L + AT_REF);
#pragma unroll
        for (int i = 0; i < 3; ++i) { const int idx = tid + 512 * i, hh = idx / 192, e = idx - hh * 192, dist = 159 - e;
            const float bv = btab[(kh * 8 + hh) * 128 + min(max(dist, 0), 127)];
            ((LAS float*)(L + AT_BL))[idx] = (dist >= 0 && dist < 128) ? bv * 1.4426950408889634f - sref : -INFINITY; }
        if (tid < 192) ((LAS float*)(L + AT_BL))[8 * 192 + tid] = -INFINITY;
#pragma unroll
        for (int i = 0; i < 4; ++i) { *(LAS v4u*)(QL + (8 * i + mrr) * AT_RS + 16 * mch) = t0[i]; *(LAS v4u*)(GL + (8 * i + mrr) * AT_RS + 16 * mch) = t0[4 + i]; }
        __syncthreads();
#pragma unroll 1
        for (int ti = 0; ti < 4; ++ti) {
            int lt = lane; asm volatile("" : "+v"(lt));
            const int l31 = lt & 31, hi = lt >> 5;
            const int g = (w >> 2) + 2 * ti, hq = kh * 8 + g;
            if (ti > 0) {
#pragma unroll
                for (int i = 0; i < 4; ++i) { *(LAS v4u*)(QL + (8 * i + mrr) * AT_RS + 16 * mch) = pr[i]; *(LAS v4u*)(GL + (8 * i + mrr) * AT_RS + 16 * mch) = pr[4 + i]; } }
            if (ti < 3) { const bf16* qp = z0 + (R0 + mrr) * NA + 2048 + (hq + 2) * 64 + 8 * mch;
#pragma unroll
                for (int i = 0; i < 4; ++i) { pr[i] = __builtin_nontemporal_load((const v4u*)(qp + (size_t)(8 * i) * NA)); pr[4 + i] = __builtin_nontemporal_load((const v4u*)(qp + (size_t)(8 * i) * NA + 1280)); } }
            else if (unit + F.G < NB * 32) AT_LOAD_KV(unit + F.G);
            asm volatile("s_waitcnt lgkmcnt(0)" ::: "memory");
            bf16x8 qf[4];
#pragma unroll
            for (int ds = 0; ds < 4; ++ds) qf[ds] = *(const LAS bf16x8*)(QL + l31 * AT_RS + (16 * ds + 8 * hi) * 2);
            const float sinkr = ((const LAS float*)(L + AT_SK))[hq] - *(const LAS float*)(L + AT_REF);
            const LAS float* bl = (const LAS float*)(L + AT_BL) + g * 192 - (l31 - 4 * hi);
            const LAS float* blinf = (const LAS float*)(L + AT_BL) + 8 * 192 - (l31 - 4 * hi);
            f32x16 o[3];
            const f32x16 zero16 = (f32x16){0.f, 0.f, 0.f, 0.f, 0.f, 0.f, 0.f, 0.f, 0.f, 0.f, 0.f, 0.f, 0.f, 0.f, 0.f, 0.f};
            v4u onesv; onesv.x = onesv.y = onesv.z = onesv.w = (l31 == 0) ? 0x3f803f80u : 0u; const bf16x8 onesf = __builtin_bit_cast(bf16x8, onesv);
#define AT_LOADK(kk_, a_, kf_) do { _Pragma("unroll") for (int r = 0; r < 16; ++r) a_[r] = ((qb == 0 && qt + (kk_) < 4) ? blinf : bl)[31 + 32 * (kk_) + (r & 3) + 8 * (r >> 2)];     \
                _Pragma("unroll") for (int ds = 0; ds < 4; ++ds) kf_[ds] = *(const LAS bf16x8*)(L + AT_KS + (2 * ds + hi) * 4096 + (32 * (qt + (kk_)) + l31) * 16); } while (0)
#define AT_LOADV(kk_, vv_) do { _Pragma("unroll") for (int s = 0; s < 2; ++s) _Pragma("unroll") for (int dt = 0; dt < 2; ++dt) { \
                const LAS unsigned char* vp = L + AT_VT + (32 * dt + l31) * AT_VSTRIDE + (32 * (qt + (kk_)) + 16 * s + 4 * hi) * 2; \
                const unsigned long long lo = *(const LAS unsigned long long*)vp, hi8 = *(const LAS unsigned long long*)(vp + 16); \
                v4u t_; t_.x = (unsigned)lo; t_.y = (unsigned)(lo >> 32); t_.z = (unsigned)hi8; t_.w = (unsigned)(hi8 >> 32); vv_[s][dt] = __builtin_bit_cast(bf16x8, t_); } } while (0)
            f32x16 ac, an; bf16x8 kfn[4], vv[2][2];
            AT_LOADK(0, ac, kfn);
#pragma unroll
            for (int ds = 0; ds < 4; ++ds) ac = __builtin_amdgcn_mfma_f32_32x32x16_bf16(kfn[ds], qf[ds], ac, 0, 0, 0);
            AT_LOADK(1, an, kfn); AT_LOADV(0, vv);
            __builtin_amdgcn_sched_barrier(0);
#pragma unroll
            for (int kk = 0; kk < 5; ++kk) {
                if (kk < 4) {
#pragma unroll
                    for (int ds = 0; ds < 4; ++ds) an = __builtin_amdgcn_mfma_f32_32x32x16_bf16(kfn[ds], qf[ds], an, 0, 0, 0); }
#pragma unroll
                for (int r = 0; r < 16; ++r) ac[r] = __builtin_amdgcn_exp2f(ac[r]);
                bf16x8 pf[2];
#pragma unroll
                for (int s = 0; s < 2; ++s) { v4u pk; pk.x = cvtpk(ac[8 * s], ac[8 * s + 1]); pk.y = cvtpk(ac[8 * s + 2], ac[8 * s + 3]); pk.z = cvtpk(ac[8 * s + 4], ac[8 * s + 5]); pk.w = cvtpk(ac[8 * s + 6], ac[8 * s + 7]);
                    pf[s] = __builtin_bit_cast(bf16x8, pk); }
                __builtin_amdgcn_sched_barrier(0);
#pragma unroll
                for (int s = 0; s < 2; ++s) {
#pragma unroll
                    for (int dt = 0; dt < 2; ++dt) o[dt] = __builtin_amdgcn_mfma_f32_32x32x16_bf16(vv[s][dt], pf[s], (kk == 0 && s == 0) ? zero16 : o[dt], 0, 0, 0);
                    o[2] = __builtin_amdgcn_mfma_f32_32x32x16_bf16(onesf, pf[s], (kk == 0 && s == 0) ? zero16 : o[2], 0, 0, 0); }
                if (kk < 4) { ac = an; AT_LOADV(kk + 1, vv); }
                if (kk < 3) AT_LOADK(kk + 2, an, kfn);
                __builtin_amdgcn_sched_barrier(0);
            }
#undef AT_LOADK
#undef AT_LOADV
            const float sum = __shfl(o[2][0], l31);
            const float inv = __builtin_amdgcn_rcpf(sum + __builtin_amdgcn_exp2f(sinkr));
#pragma unroll
            for (int dt = 0; dt < 2; ++dt)
#pragma unroll
                for (int k = 0; k < 4; ++k) { LAS unsigned long long* gp = (LAS unsigned long long*)(GL + l31 * AT_RS + (32 * dt + 8 * k + 4 * hi) * 2); const unsigned long long gv = *gp;
                    const unsigned glo = (unsigned)gv, ghi = (unsigned)(gv >> 32);
                    const float y0_ = o[dt][4 * k] * inv * bflo(glo), y1_ = o[dt][4 * k + 1] * inv * bfhi(glo), y2_ = o[dt][4 * k + 2] * inv * bflo(ghi), y3_ = o[dt][4 * k + 3] * inv * bfhi(ghi);
                    *gp = (unsigned long long)cvtpk(y0_, y1_) | ((unsigned long long)cvtpk(y2_, y3_) << 32); }
            asm volatile("s_waitcnt lgkmcnt(0)" ::: "memory");
            { bf16* op = y0 + (R0 + mrr) * GW + 1024 + hq * 64 + 8 * mch;
#pragma unroll
              for (int i = 0; i < 4; ++i) *(v4u*)(op + (size_t)(8 * i) * GW) = *(const LAS v4u*)(GL + (8 * i + mrr) * AT_RS + 16 * mch); }
        }
    }
#undef AT_LOAD_KV
}


#ifndef WGM_G1
#define WGM_G1 4
#endif
#ifndef WGM_G2
#define WGM_G2 4
#endif
#ifndef WGM_G3
#define WGM_G3 4
#endif
#ifndef WGM_G4
#define WGM_G4 4
#endif
__global__ void __launch_bounds__(NWAVES * 64, 2) mega(Args args) {
    extern __shared__ __attribute__((aligned(16))) unsigned char lds[];
    Frame F;
    F.lds = (LAS unsigned char*)lds;
    F.MISC = (volatile LAS unsigned*)(F.lds + MISC_OFF);
    F.wave = __builtin_amdgcn_readfirstlane((int)threadIdx.x >> 6);
    F.G = gridDim.x; { const int bx = blockIdx.x; F.vcu = (F.G % 8 == 0) ? (bx % 8) * (F.G / 8) + bx / 8 : bx; }
    unsigned char* ws = args.ws;
    F.ctl = (gu32*)(ws + WS_CTL);
    for (int u = threadIdx.x; u < (LDS_BYTES - LDSCTL_OFF) / 4; u += NWAVES * 64) ((LAS unsigned*)(F.lds + LDSCTL_OFF))[u] = 0u;
    __syncthreads();
    const int lo = args.ph_lo, hi = args.ph_hi;
    const bool multi = (hi - lo) > 1;
    static_assert((size_t)(CW_BAR + XCD_BAR_WORDS) * 4 <= CTL_ZERO_BYTES, "barrier words must lie inside the zeroed control region");
    XcdBarrier bar; bar.bar = (unsigned*)(F.ctl + CW_BAR); bar.x = 0; bar.st = nullptr;
    if (multi) bar = xcd_barrier_post((unsigned*)(F.ctl + CW_BAR), F.MISC + 8);
    bar.wave = F.wave;
#define IN(k) (lo <= (k) && (k) < hi)
#define BOTH(k) (IN(k) && IN((k) + 1))
#define GRID_BAR() xcd_barrier(bar)
#ifndef PROBE_PH
#define PROBE_PH (-1)
#endif
#define PH_T0(k) unsigned long long pt0_ = 0; if (PROBE_PH == (k)) pt0_ = __builtin_amdgcn_s_memrealtime()
#define PH_T1(k) do { if (PROBE_PH == (k)) { const unsigned long long t1_ = __builtin_amdgcn_s_memrealtime(), end_ = t1_ + (t1_ - pt0_); while (__builtin_amdgcn_s_memrealtime() < end_) __builtin_amdgcn_s_sleep(8); } } while (0)
#define WSP(T, off) ((T*)(args.ws + (off)))
#define GDUMMY WSP(unsigned, WS_CTL + 512 * 1024)

    if (IN(0)) { PH_T0(0); p0_prologue(F, args, ws); if (BOTH(0)) GRID_BAR(); PH_T1(0); }
    if (IN(1)) { PH_T0(1);
        pg8::Gemm g{(const bf16*)args.out, WSP(bf16, WS_WAT), M, NA, D, GDUMMY}; pg8::SplitOrder So; So.init(M, 2048, NA - 2048, F.G, (int)blockIdx.x, WGM_G1);
        pg8::EpiZ0 E{WSP(bf16, WS_Z0), NA, args.in[10], args.in[11]};
        { const int nun = (M / 256) * (NA / 256), full = nun / F.G, rem = nun - full * F.G;
          if (rem > 0 && (int)blockIdx.x >= rem) { p0_layer1_weights(F, args, ws, (int)blockIdx.x - rem, F.G - rem); __syncthreads(); }
          else if (rem == 0) { p0_layer1_weights(F, args, ws, (int)blockIdx.x, F.G); __syncthreads(); } }
        pg8::gemm_phase<pg8::EpiZ0, pg8::SplitOrder, true, true>(F.lds + RING_OFF, g, So, E, F.wave);
        if (BOTH(1)) GRID_BAR(); PH_T1(1);
    }
#ifndef REPS_LRU
#define REPS_LRU 1
#endif
#ifndef REPS_ATT
#define REPS_ATT 1
#endif
    if (IN(2)) { PH_T0(2); for (int rp = 0; rp < REPS_ATT; ++rp) { p2_attn(F, args, ws); if (rp + 1 < REPS_ATT) __syncthreads(); } for (int rp = 0; rp < REPS_LRU; ++rp) { p2_lru(F, args, ws); if (rp + 1 < REPS_LRU) __syncthreads(); } if (BOTH(2)) GRID_BAR(); PH_T1(2); }
    if (IN(3)) { PH_T0(3);
#ifdef PROBE_SKEW3
        if (((int)blockIdx.x >> 3) & 1) { const unsigned long long te_ = __builtin_amdgcn_s_memrealtime() + PROBE_SKEW3; while (__builtin_amdgcn_s_memrealtime() < te_) __builtin_amdgcn_s_sleep(8); }
#endif
        pg8::Gemm g{WSP(bf16, WS_Y0), WSP(bf16, WS_WOAT), M, D, GW, GDUMMY}; pg8::StaticOrder So; So.init(M, D, F.G, (int)blockIdx.x, WGM_G2);
        pg8::EpiRes1 E{(const bf16*)args.out, WSP(float, WS_RMS0), WSP(bf16, WS_X1B), WSP(float, WS_SSQ)};
        pg8::gemm_phase<pg8::EpiRes1, pg8::StaticOrder, true, true>(F.lds + RING_OFF, g, So, E, F.wave);
        if (BOTH(3)) GRID_BAR(); PH_T1(3);
    }
    if (IN(4)) { PH_T0(4);
#ifdef PROBE_SKEW4
        if (((int)blockIdx.x >> 3) & 1) { const unsigned long long te_ = __builtin_amdgcn_s_memrealtime() + PROBE_SKEW4; while (__builtin_amdgcn_s_memrealtime() < te_) __builtin_amdgcn_s_sleep(8); }
#endif
        pg8::Gemm g{WSP(bf16, WS_X1B), WSP(bf16, WS_WCT), M, NC, D, GDUMMY}; pg8::StaticOrder So; So.init(M, NC, F.G, (int)blockIdx.x, WGM_G3);
        LAS float* rxl = (LAS float*)(F.lds + RING_OFF + pg8::STAGE_BYTES);
        { const float* ssq = WSP(float, WS_SSQ); const int tid_ = F.wave * 64 + lane_id();
          constexpr int RXN = (RING_BYTES - pg8::STAGE_BYTES) / 1024;
#pragma unroll 1
          for (int i0 = 0; i0 < RXN; i0 += 12) {
              f32x4 a[12], b[12]; bool ok[12];
#pragma unroll
              for (int j = 0; j < 12; ++j) { pg8::Unit uu; ok[j] = So.next(i0 + j, uu); const int pm_ = ok[j] ? uu.pm : 0;
                  const float* p = ssq + ((size_t)(pm_ * 256 + (tid_ >> 1)) * 16 + (tid_ & 1) * 8); a[j] = *(const f32x4*)p; b[j] = *(const f32x4*)(p + 4); }
#pragma unroll
              for (int j = 0; j < 12; ++j) { float s = ((a[j].x + a[j].y) + (a[j].z + a[j].w)) + ((b[j].x + b[j].y) + (b[j].z + b[j].w)); s += __shfl_xor(s, 1);
                  if (ok[j] && (tid_ & 1) == 0) rxl[(i0 + j) * 256 + (tid_ >> 1)] = rsqrtf(s * (1.f / D) + EPS); }
              if (!ok[11]) break; }
          __syncthreads(); }
        pg8::EpiZ1 E{WSP(bf16, WS_U), WSP(bf16, WS_V), WSP(float, WS_VST), (const LAS float*)rxl};
        pg8::gemm_phase<pg8::EpiZ1, pg8::StaticOrder, true, true>(F.lds + RING_OFF, g, So, E, F.wave);
        if (BOTH(4)) GRID_BAR(); PH_T1(4);
    }
    if (IN(5)) { PH_T0(5); p5_gate(F, args, ws); if (BOTH(5)) GRID_BAR(); PH_T1(5); }
    if (IN(6)) { PH_T0(6);
#ifdef PROBE_SKEW6
        if (((int)blockIdx.x >> 3) & 1) { const unsigned long long te_ = __builtin_amdgcn_s_memrealtime() + PROBE_SKEW6; while (__builtin_amdgcn_s_memrealtime() < te_) __builtin_amdgcn_s_sleep(8); }
#endif
        pg8::Gemm g{WSP(bf16, WS_U), WSP(bf16, WS_WOCT), M, D, GW, GDUMMY}; pg8::StaticOrder So; So.init(M, D, F.G, (int)blockIdx.x, WGM_G4);
        pg8::EpiRes3 E{WSP(bf16, WS_X1B), args.out};
        pg8::gemm_phase<pg8::EpiRes3, pg8::StaticOrder, true, true>(F.lds + RING_OFF, g, So, E, F.wave); PH_T1(6);
    }
#undef PH_T0
#undef PH_T1
#undef WSP
#undef GDUMMY
#undef IN
#undef BOTH
}


static void launch_mega(const Args& a0, int lo, int hi, int grid, hipStream_t stream) {
    Args a = a0; a.ph_lo = lo; a.ph_hi = hi;
    hipLaunchKernelGGL(mega, dim3(grid), dim3(NWAVES * 64), LDS_BYTES, stream, a);
    const hipError_t le = hipPeekAtLastError();
    if (le != hipSuccess) fprintf(stderr, "kernel_launch: mega launch [%d,%d) failed: %s\n", lo, hi, hipGetErrorName(le));
}

extern "C" void kernel_launch(void* const* d_in, const int* in_sizes, int n_in, void* d_out, int out_size, void* d_ws, size_t ws_size, hipStream_t stream) {
    static int grid = 0;
    if (grid == 0) {
        if (n_in != 22 || in_sizes[0] != M * D || out_size != M * D || ws_size < WS_END) {
            fprintf(stderr, "kernel_launch: unexpected shapes: n_in %d in0 %d out %d ws %zu\n", n_in, n_in > 0 ? in_sizes[0] : -1, out_size, ws_size); grid = -1; return; }
        int dev = 0, cus = 0, per_cu = 0;
        if (hipGetDevice(&dev) != hipSuccess || hipDeviceGetAttribute(&cus, hipDeviceAttributeMultiprocessorCount, dev) != hipSuccess) { fprintf(stderr, "kernel_launch: device query failed\n"); grid = -1; return; }
        if (hipFuncSetAttribute((const void*)mega, hipFuncAttributeMaxDynamicSharedMemorySize, LDS_BYTES) != hipSuccess) { fprintf(stderr, "kernel_launch: hipFuncSetAttribute failed\n"); grid = -1; return; }
        if (hipOccupancyMaxActiveBlocksPerMultiprocessor(&per_cu, (const void*)mega, NWAVES * 64, LDS_BYTES) != hipSuccess || per_cu < 1)
            fprintf(stderr, "kernel_launch: note: occupancy query reports %d workgroups per CU\n", per_cu);
        (void)hipGetLastError();
        grid = cus;
    }
    if (grid < 0) return;
    unsigned char* ws = (unsigned char*)d_ws; float* out = (float*)d_out;
    if (hipMemsetAsync(ws + WS_CTL, 0, CTL_ZERO_BYTES, stream) != hipSuccess) { fprintf(stderr, "kernel_launch: memset failed\n"); return; }
    Args a{};
    for (int i = 0; i < 22; ++i) a.in[i] = (const float*)d_in[i];
    a.out = out; a.ws = ws;

#ifndef N_LAUNCHES
#define N_LAUNCHES 1
#endif
#ifndef PROBE_DUP
#define PROBE_DUP 0
#endif
#if N_LAUNCHES == 1
    launch_mega(a, 0, 7, grid, stream);
#else
    for (int ph = 0; ph < 7; ++ph) { launch_mega(a, ph, ph + 1, grid, stream); if ((PROBE_DUP >> ph) & 1) launch_mega(a, ph, ph + 1, grid, stream); }
#endif
}
```
